# Optimizing an MI355X kernel written in HIP

```python
import jax, jax.numpy as jnp
from jax import lax
import numpy as np

D_MODEL = 1024
BATCH = 8
SEQ = 2048
DEPTH = 1
DEC_BATCH = 128
DEC_SEQ = 8
PAST_LEN = 16384
PAGE_SIZE = 128

MIX_WIDTH = D_MODEL
A_WIDTH = MIX_WIDTH // 2
B_WIDTH = MIX_WIDTH - A_WIDTH
H_A = 4
DK_A = A_WIDTH // H_A
DV_A = A_WIDTH // H_A
H_B = 4
DK_B = B_WIDTH // H_B
DV_B = B_WIDTH // H_B
IN_WIDTH = 4 * A_WIDTH + 4 * B_WIDTH
D_FF = 2816
CONV_W = 3
CHUNK = 64
ROPE_BASE = 10000.0
EPS = 1e-6

kernel_name = "hgrn2_retention_convffn_hybrid_step"

F32 = jnp.float32


def _rmsnorm(x, w):
    xf = x.astype(F32)
    return xf * lax.rsqrt(jnp.mean(xf * xf, axis=-1, keepdims=True) + EPS) * w.astype(F32)


def _groupnorm(x, w):
    xf = x.astype(F32)
    mu = jnp.mean(xf, axis=-1, keepdims=True)
    xc = xf - mu
    return xc * lax.rsqrt(jnp.mean(xc * xc, axis=-1, keepdims=True) + EPS) * w.astype(F32)


def _heads(a, h):
    return a.reshape(a.shape[0], a.shape[1], h, -1)


def _rope(x, pos):
    half = x.shape[-1] // 2
    inv = 1.0 / (ROPE_BASE ** (jnp.arange(half, dtype=F32) / half))
    ang = pos.astype(F32)[:, None] * inv[None, :]
    cos = jnp.cos(ang)[None, :, None, :]
    sin = jnp.sin(ang)[None, :, None, :]
    x1, x2 = x[..., :half], x[..., half:]
    return jnp.concatenate([x1 * cos - x2 * sin, x1 * sin + x2 * cos], axis=-1)


def _chunk_len(t):
    return CHUNK if t % CHUNK == 0 else t


def _to_chunks(a, c):
    nb, nt, h, d = a.shape
    return a.reshape(nb, nt // c, c, h, d).transpose(1, 0, 3, 2, 4)


def _from_chunks(a):
    n, nb, h, c, d = a.shape
    return a.transpose(1, 0, 3, 2, 4).reshape(nb, n * c, h, d)


def _hgrn2_chunked(q, k, log_f, v, s0):
    c = _chunk_len(q.shape[1])
    mask = jnp.tril(jnp.ones((c, c), dtype=bool))[:, :, None]

    def step(S, inp):
        qq, kk, gg, vv = inp
        b = jnp.cumsum(gg, axis=2)
        rel = b[:, :, :, None, :] - b[:, :, None, :, :]
        dec = jnp.where(mask, jnp.exp(jnp.where(mask, rel, 0.0)), 0.0)
        scores = jnp.einsum('bhtd,bhsd,bhtsd->bhts', qq, kk, dec)
        o = (jnp.einsum('bhts,bhsv->bhtv', scores, vv)
             + jnp.einsum('bhtd,bhdv->bhtv', qq * jnp.exp(b), S))
        b_last = b[:, :, -1:, :]
        S_new = (jnp.exp(b_last[:, :, 0, :])[..., None] * S
                 + jnp.einsum('bhsd,bhsv->bhdv', kk * jnp.exp(b_last - b), vv))
        return S_new, o

    S, o = lax.scan(step, s0, (_to_chunks(q, c), _to_chunks(k, c), _to_chunks(log_f, c), _to_chunks(v, c)))
    return _from_chunks(o), S


def _retention_chunked(q, k, v, s0, log_gamma):
    c = _chunk_len(q.shape[1])
    idx = jnp.arange(c, dtype=F32)
    rel = idx[:, None] - idx[None, :]
    causal = rel >= 0
    lg = log_gamma[:, None, None]
    dec = jnp.where(causal[None], jnp.exp(jnp.where(causal, rel, 0.0)[None] * lg), 0.0)
    inner = jnp.exp((idx + 1.0)[None, :] * log_gamma[:, None])[..., None]
    sdec = jnp.exp((c - 1.0 - idx)[None, :] * log_gamma[:, None])[..., None]
    cdec = jnp.exp(c * log_gamma)[:, None, None]

    def step(S, inp):
        qq, kk, vv = inp
        scores = jnp.einsum('bhtd,bhsd->bhts', qq, kk) * dec
        o = jnp.einsum('bhts,bhsv->bhtv', scores, vv) + jnp.einsum('bhtd,bhdv->bhtv', qq, S) * inner
        S_new = cdec * S + jnp.einsum('bhsd,bhsv->bhdv', kk * sdec, vv)
        return S_new, o

    S, o = lax.scan(step, s0, (_to_chunks(q, c), _to_chunks(k, c), _to_chunks(v, c)))
    return _from_chunks(o), S


def _token_mix(h, pos, s_a, s_b, w_in, lb, norm_a, norm_b, w_out):
    nb, nt, _ = h.shape
    proj = h @ w_in
    A, Bw = A_WIDTH, B_WIDTH
    qa, fa, ia, ga, qb, kb, vb, gb = jnp.split(
        proj, [A, 2 * A, 3 * A, 4 * A, 4 * A + Bw, 4 * A + 2 * Bw, 4 * A + 3 * Bw], axis=-1)
    lbh = lb.reshape(H_A, DK_A)
    f = lbh + (1.0 - lbh) * jax.nn.sigmoid(_heads(fa.astype(F32), H_A))
    oa, s_a_new = _hgrn2_chunked(_heads(qa.astype(F32), H_A), 1.0 - f, jnp.log(f),
                                 _heads(ia.astype(F32), H_A), s_a.astype(F32))
    oa = _rmsnorm(oa, norm_a) * jax.nn.silu(_heads(ga.astype(F32), H_A))
    log_gamma = jnp.log1p(-jnp.exp2(-5.0 - jnp.arange(H_B, dtype=F32)))
    qr = _rope(_heads(qb.astype(F32), H_B), pos)
    kr = _rope(_heads(kb.astype(F32), H_B), pos) * (DK_B ** -0.5)
    ob, s_b_new = _retention_chunked(qr, kr, _heads(vb.astype(F32), H_B), s_b.astype(F32), log_gamma)
    ob = _groupnorm(ob, norm_b) * jax.nn.silu(_heads(gb.astype(F32), H_B))
    o = jnp.concatenate([oa.reshape(nb, nt, A), ob.reshape(nb, nt, Bw)], axis=-1).astype(h.dtype)
    return o @ w_out, s_a_new, s_b_new


def _conv_ffn(h, buf, w_up, conv_w, conv_b, w_down):
    nt = h.shape[1]
    up = h @ w_up
    ext = jnp.concatenate([buf.astype(up.dtype), up], axis=1)
    c = conv_b + sum(ext[:, j:j + nt] * conv_w[j] for j in range(CONV_W))
    u, g = jnp.split(c, 2, axis=-1)
    return (jax.nn.silu(g) * u) @ w_down, ext[:, nt:]


def _trunk(x, pos, s_a, s_b, s_c, w_norm1, w_in, hgrn_lb, hgrn_norm_w, ret_norm_w, w_out,
           w_norm2, w_ffn_in, conv_w, conv_b, w_ffn_out, w_norm_f):
    lb_all = jnp.cumsum(jax.nn.softmax(hgrn_lb.astype(F32), axis=0), axis=0)
    na, nbs, nc = [], [], []
    for l in range(DEPTH):
        h = _rmsnorm(x, w_norm1[l]).astype(x.dtype)
        mix, sa, sb = _token_mix(h, pos, s_a[l], s_b[l], w_in[l], lb_all[l], hgrn_norm_w[l],
                                 ret_norm_w[l], w_out[l])
        x = x + mix
        h = _rmsnorm(x, w_norm2[l]).astype(x.dtype)
        ff, sc = _conv_ffn(h, s_c[l], w_ffn_in[l], conv_w[l], conv_b[l], w_ffn_out[l])
        x = x + ff
        na.append(sa); nbs.append(sb); nc.append(sc)
    y = _rmsnorm(x, w_norm_f).astype(x.dtype)
    return (y, jnp.stack(na).astype(x.dtype), jnp.stack(nbs).astype(x.dtype),
            jnp.stack(nc).astype(x.dtype))


def setup_inputs(seed: int = 0) -> dict:
    key = jax.random.key(seed)
    ks = jax.random.split(key, 20)
    nrm = jax.random.normal
    return {
        "x_prompt": nrm(ks[0], (BATCH, SEQ, D_MODEL), F32),
        "x_sample": nrm(ks[1], (DEC_BATCH, DEC_SEQ, D_MODEL), F32),
        "state_hgrn": 0.3 * nrm(ks[2], (DEPTH, DEC_BATCH, H_A, DK_A, DV_A), F32),
        "state_ret": 0.3 * nrm(ks[3], (DEPTH, DEC_BATCH, H_B, DK_B, DV_B), F32),
        "state_conv": nrm(ks[4], (DEPTH, DEC_BATCH, CONV_W - 1, 2 * D_FF), F32),
        "w_norm1": 1.0 + 0.02 * nrm(ks[5], (DEPTH, D_MODEL), F32),
        "w_in": nrm(ks[6], (DEPTH, D_MODEL, IN_WIDTH), F32) * D_MODEL ** -0.5,
        "hgrn_lb": 0.1 * nrm(ks[7], (DEPTH + 1, A_WIDTH), F32),
        "hgrn_norm_w": 1.0 + 0.02 * nrm(ks[8], (DEPTH, DV_A), F32),
        "ret_norm_w": 1.0 + 0.02 * nrm(ks[9], (DEPTH, DV_B), F32),
        "w_out": nrm(ks[10], (DEPTH, MIX_WIDTH, D_MODEL), F32) * MIX_WIDTH ** -0.5,
        "w_norm2": 1.0 + 0.02 * nrm(ks[11], (DEPTH, D_MODEL), F32),
        "w_ffn_in": nrm(ks[12], (DEPTH, D_MODEL, 2 * D_FF), F32) * D_MODEL ** -0.5,
        "conv_w": nrm(ks[13], (DEPTH, CONV_W, 2 * D_FF), F32) * CONV_W ** -0.5,
        "conv_b": 0.02 * nrm(ks[14], (DEPTH, 2 * D_FF), F32),
        "w_ffn_out": nrm(ks[15], (DEPTH, D_FF, D_MODEL), F32) * D_FF ** -0.5,
        "w_norm_f": 1.0 + 0.02 * nrm(ks[16], (D_MODEL,), F32),
    }


def reference(x_prompt, x_sample, state_hgrn, state_ret, state_conv, w_norm1, w_in, hgrn_lb,
              hgrn_norm_w, ret_norm_w, w_out, w_norm2, w_ffn_in, conv_w, conv_b, w_ffn_out,
              w_norm_f):
    nbp, ntp, _ = x_prompt.shape
    nts = x_sample.shape[1]
    pos_p = jnp.arange(ntp, dtype=jnp.int32)
    pos_s = PAST_LEN + jnp.arange(nts, dtype=jnp.int32)
    z_a = jnp.zeros((DEPTH, nbp, H_A, DK_A, DV_A), F32)
    z_b = jnp.zeros((DEPTH, nbp, H_B, DK_B, DV_B), F32)
    z_c = jnp.zeros((DEPTH, nbp, CONV_W - 1, 2 * D_FF), x_prompt.dtype)
    y_prompt, ha_p, rb_p, cv_p = _trunk(
        x_prompt, pos_p, z_a, z_b, z_c, w_norm1, w_in, hgrn_lb, hgrn_norm_w, ret_norm_w, w_out,
        w_norm2, w_ffn_in, conv_w, conv_b, w_ffn_out, w_norm_f)
    y_sample, ha_s, rb_s, cv_s = _trunk(
        x_sample, pos_s, state_hgrn, state_ret, state_conv, w_norm1, w_in, hgrn_lb, hgrn_norm_w,
        ret_norm_w, w_out, w_norm2, w_ffn_in, conv_w, conv_b, w_ffn_out, w_norm_f)
    return (y_prompt, y_sample, ha_p, rb_p, cv_p, ha_s, rb_s, cv_s)
```

```cpp
#include <hip/hip_runtime.h>
#include <math.h>

namespace ref {
constexpr int D = 1024, NP = 8, TP = 2048, NS = 128, TS = 8, PAST = 16384;
constexpr int INW = 4096, DFF = 2816, UPW = 5632, HD = 128, NH = 4;
constexpr float EPS = 1e-6f;

__device__ inline void sincos_acc(double ang, float& c, float& s) {
    const double TWO_OVER_PI = 0.63661977236758134308, PIO2_HI = 1.57079632679489655800e+00, PIO2_LO = 6.12323399573676603587e-17;
    const double q = rint(ang * TWO_OVER_PI);
    double r = fma(-q, PIO2_HI, ang); r = fma(-q, PIO2_LO, r);
    const int n = ((int)q) & 3;
    const double z = r * r;
    const double S1 = -1.66666666666666324348e-01, S2 = 8.33333333332248946124e-03, S3 = -1.98412698298579493134e-04, S4 = 2.75573137070700676789e-06, S5 = -2.50507602534068634195e-08, S6 = 1.58969099521155010221e-10;
    const double C1 = 4.16666666666666019037e-02, C2 = -1.38888888888741095749e-03, C3 = 2.48015872894767294178e-05, C4 = -2.75573143513906633035e-07, C5 = 2.08757232129817482790e-09, C6 = -1.13596475577881948265e-11;
    const double sn = r + r * z * (S1 + z * (S2 + z * (S3 + z * (S4 + z * (S5 + z * S6)))));
    const double cs = 1.0 - 0.5 * z + z * z * (C1 + z * (C2 + z * (C3 + z * (C4 + z * (C5 + z * C6)))));
    double sv, cv;
    if (n == 0) { sv = sn; cv = cs; } else if (n == 1) { sv = cs; cv = -sn; } else if (n == 2) { sv = -sn; cv = -cs; } else { sv = -cs; cv = sn; }
    c = (float)cv; s = (float)sv;
}
__global__ void rope_tab_k(float2* tab) {
    const int i = blockIdx.x * blockDim.x + threadIdx.x;
    if (i >= 2056 * 64) return;
    const int p = i / 64, j = i % 64;
    const int pos = p < 2048 ? p : PAST + (p - 2048);
    const double inv = exp2(-(double)j * (13.287712379549449 / 64.0));
    float c, s; sincos_acc((double)pos * inv, c, s);
    tab[i] = make_float2(c, s);
}

__global__ __launch_bounds__(256) void rmsnorm_k(const float* __restrict__ x, const float* __restrict__ w, float* __restrict__ y) {
    __shared__ float red[4];
    const size_t row = blockIdx.x;
    const float4 v = ((const float4*)(x + row * D))[threadIdx.x];
    float s = v.x * v.x + v.y * v.y + v.z * v.z + v.w * v.w;
    for (int o = 32; o > 0; o >>= 1) s += __shfl_xor(s, o);
    if ((threadIdx.x & 63) == 0) red[threadIdx.x >> 6] = s;
    __syncthreads();
    s = red[0] + red[1] + red[2] + red[3];
    const float r = 1.0f / sqrtf(s * (1.0f / D) + EPS);
    const float4 wv = ((const float4*)w)[threadIdx.x];
    ((float4*)(y + row * D))[threadIdx.x] = make_float4(v.x * r * wv.x, v.y * r * wv.y, v.z * r * wv.z, v.w * r * wv.w);
}

template <bool RES>
__global__ __launch_bounds__(256) void gemm_k(const float* __restrict__ A, const float* __restrict__ B, float* __restrict__ C, const float* __restrict__ R, int M, int N, int K) {
    __shared__ float As[16][68];
    __shared__ float Bs[16][68];
    const int tx = threadIdx.x & 15, ty = threadIdx.x >> 4;
    const int m0 = blockIdx.y * 64, n0 = blockIdx.x * 64;
    float acc[4][4];
#pragma unroll
    for (int i = 0; i < 4; ++i)
#pragma unroll
        for (int j = 0; j < 4; ++j) acc[i][j] = 0.f;
    for (int k0 = 0; k0 < K; k0 += 16) {
        { const int r = threadIdx.x >> 2, c = (threadIdx.x & 3) * 4; const float4 v = *(const float4*)(A + (size_t)(m0 + r) * K + k0 + c);
          As[c + 0][r] = v.x; As[c + 1][r] = v.y; As[c + 2][r] = v.z; As[c + 3][r] = v.w; }
        { const int r = threadIdx.x >> 4, c = (threadIdx.x & 15) * 4; *(float4*)&Bs[r][c] = *(const float4*)(B + (size_t)(k0 + r) * N + n0 + c); }
        __syncthreads();
#pragma unroll
        for (int kk = 0; kk < 16; ++kk) {
            const float4 a = *(const float4*)&As[kk][ty * 4], b = *(const float4*)&Bs[kk][tx * 4];
            const float av[4] = {a.x, a.y, a.z, a.w}, bv[4] = {b.x, b.y, b.z, b.w};
#pragma unroll
            for (int i = 0; i < 4; ++i)
#pragma unroll
                for (int j = 0; j < 4; ++j) acc[i][j] = fmaf(av[i], bv[j], acc[i][j]);
        }
        __syncthreads();
    }
#pragma unroll
    for (int i = 0; i < 4; ++i) {
        const size_t off = (size_t)(m0 + ty * 4 + i) * N + n0 + tx * 4;
        float4 o = make_float4(acc[i][0], acc[i][1], acc[i][2], acc[i][3]);
        if (RES) { const float4 r = *(const float4*)(R + off); o.x += r.x; o.y += r.y; o.z += r.z; o.w += r.w; }
        *(float4*)(C + off) = o;
    }
}

__device__ inline float silu_f(float x) { return x / (1.0f + expf(-x)); }
__device__ inline float block_sum128(float v, float* red, int tid) {
    for (int o = 32; o > 0; o >>= 1) v += __shfl_xor(v, o);
    __syncthreads();
    if ((tid & 63) == 0) red[tid >> 6] = v;
    __syncthreads();
    return red[0] + red[1];
}

__global__ __launch_bounds__(128) void hgrn_k(const float* __restrict__ proj, const float* __restrict__ lbraw, const float* __restrict__ normw,
                                               const float* __restrict__ s_in, float* __restrict__ s_out, float* __restrict__ ohat, int T) {
    __shared__ float sq[HD], sf[HD], sk[HD], red[2];
    const int b = blockIdx.x >> 2, h = blockIdx.x & 3, d = threadIdx.x;
    float S[HD];
    if (s_in) {
#pragma unroll
        for (int k = 0; k < HD; ++k) S[k] = s_in[((size_t)(b * NH + h) * HD + k) * HD + d];
    } else {
#pragma unroll
        for (int k = 0; k < HD; ++k) S[k] = 0.f;
    }
    const int ch = h * HD + d;
    const float a0 = lbraw[ch], a1 = lbraw[512 + ch];
    const float m = fmaxf(a0, a1), e0 = expf(a0 - m), e1 = expf(a1 - m), lb = e0 / (e0 + e1);
    const float nw = normw[d];
    for (int t = 0; t < T; ++t) {
        const float* pr = proj + (size_t)(b * T + t) * INW;
        const float q = pr[ch], fa = pr[512 + ch], v = pr[1024 + ch], g = pr[1536 + ch];
        const float f = lb + (1.0f - lb) / (1.0f + expf(-fa));
        __syncthreads();
        sq[d] = q; sf[d] = f; sk[d] = 1.0f - f;
        __syncthreads();
        float o = 0.f;
#pragma unroll
        for (int k = 0; k < HD; ++k) { S[k] = fmaf(sf[k], S[k], sk[k] * v); o = fmaf(S[k], sq[k], o); }
        const float ss = block_sum128(o * o, red, d);
        const float r = 1.0f / sqrtf(ss * (1.0f / HD) + EPS);
        ohat[(size_t)(b * T + t) * D + ch] = o * r * nw * silu_f(g);
    }
#pragma unroll
    for (int k = 0; k < HD; ++k) s_out[((size_t)(b * NH + h) * HD + k) * HD + d] = S[k];
}

__global__ __launch_bounds__(128) void ret_k(const float* __restrict__ proj, const float2* __restrict__ tab, const float* __restrict__ normw,
                                              const float* __restrict__ s_in, float* __restrict__ s_out, float* __restrict__ ohat, int T, int p0) {
    __shared__ float sq[HD], sk[HD], red[2];
    const int b = blockIdx.x >> 2, h = blockIdx.x & 3, d = threadIdx.x;
    float S[HD];
    if (s_in) {
#pragma unroll
        for (int k = 0; k < HD; ++k) S[k] = s_in[((size_t)(b * NH + h) * HD + k) * HD + d];
    } else {
#pragma unroll
        for (int k = 0; k < HD; ++k) S[k] = 0.f;
    }
    const int ch = h * HD + d;
    const float gamma = 1.0f - exp2f(-5.0f - (float)h);
    const float nw = normw[d];
    const int j = d & 63; const bool hi = d >= 64;
    for (int t = 0; t < T; ++t) {
        const float* pr = proj + (size_t)(b * T + t) * INW + 2048;
        const float2 cs = tab[(size_t)(p0 + t) * 64 + j];
        const float q1 = pr[h * HD + j], q2 = pr[h * HD + j + 64], k1 = pr[512 + h * HD + j], k2 = pr[512 + h * HD + j + 64];
        const float qr = hi ? (q1 * cs.y + q2 * cs.x) : (q1 * cs.x - q2 * cs.y);
        const float kr = (hi ? (k1 * cs.y + k2 * cs.x) : (k1 * cs.x - k2 * cs.y)) * 0.08838834764831845f;
        const float v = pr[1024 + ch], g = pr[1536 + ch];
        __syncthreads();
        sq[d] = qr; sk[d] = kr;
        __syncthreads();
        float o = 0.f;
#pragma unroll
        for (int k = 0; k < HD; ++k) { S[k] = fmaf(gamma, S[k], sk[k] * v); o = fmaf(S[k], sq[k], o); }
        const float mu = block_sum128(o, red, d) * (1.0f / HD);
        const float xc = o - mu;
        const float var = block_sum128(xc * xc, red, d) * (1.0f / HD);
        const float r = 1.0f / sqrtf(var + EPS);
        ohat[(size_t)(b * T + t) * D + 512 + ch] = xc * r * nw * silu_f(g);
    }
#pragma unroll
    for (int k = 0; k < HD; ++k) s_out[((size_t)(b * NH + h) * HD + k) * HD + d] = S[k];
}

__global__ __launch_bounds__(256) void conv_k(const float* __restrict__ up, const float* __restrict__ cw, const float* __restrict__ cb, const float* __restrict__ buf,
                                               float* __restrict__ act, float* __restrict__ cst, int T, int rows) {
    const size_t i = (size_t)blockIdx.x * blockDim.x + threadIdx.x;
    if (i >= (size_t)rows * DFF) return;
    const int c = (int)(i % DFF); const int row = (int)(i / DFF), b = row / T, t = row % T;
    float cu = cb[c], cg = cb[DFF + c];
#pragma unroll
    for (int j = 0; j < 3; ++j) {
        const int tt = t - 2 + j; float eu, eg;
        if (tt >= 0) { eu = up[(size_t)(b * T + tt) * UPW + c]; eg = up[(size_t)(b * T + tt) * UPW + DFF + c]; }
        else if (buf) { eu = buf[(size_t)(b * 2 + tt + 2) * UPW + c]; eg = buf[(size_t)(b * 2 + tt + 2) * UPW + DFF + c]; }
        else { eu = 0.f; eg = 0.f; }
        cu = fmaf(cw[j * UPW + c], eu, cu); cg = fmaf(cw[j * UPW + DFF + c], eg, cg);
    }
    act[i] = silu_f(cg) * cu;
    if (t >= T - 2) { const int jj = t - (T - 2); cst[(size_t)(b * 2 + jj) * UPW + c] = up[(size_t)row * UPW + c]; cst[(size_t)(b * 2 + jj) * UPW + DFF + c] = up[(size_t)row * UPW + DFF + c]; }
}
}

extern "C" void kernel_launch(void* const* d_in, const int* in_sizes, int n_in, void* d_out, int out_size, void* d_ws, size_t ws_size, hipStream_t stream) {
    using namespace ref;
    const float* x_prompt = (const float*)d_in[0]; const float* x_sample = (const float*)d_in[1];
    const float* state_hgrn = (const float*)d_in[2]; const float* state_ret = (const float*)d_in[3]; const float* state_conv = (const float*)d_in[4];
    const float* w_norm1 = (const float*)d_in[5]; const float* w_in = (const float*)d_in[6]; const float* hgrn_lb = (const float*)d_in[7];
    const float* hgrn_norm_w = (const float*)d_in[8]; const float* ret_norm_w = (const float*)d_in[9]; const float* w_out = (const float*)d_in[10];
    const float* w_norm2 = (const float*)d_in[11]; const float* w_ffn_in = (const float*)d_in[12]; const float* conv_w = (const float*)d_in[13];
    const float* conv_b = (const float*)d_in[14]; const float* w_ffn_out = (const float*)d_in[15]; const float* w_norm_f = (const float*)d_in[16];
    float* out = (float*)d_out;
    float* y_p = out; float* y_s = y_p + (size_t)NP * TP * D; float* hg_p = y_s + (size_t)NS * TS * D; float* rt_p = hg_p + (size_t)NP * NH * HD * HD;
    float* cv_p = rt_p + (size_t)NP * NH * HD * HD; float* hg_s = cv_p + (size_t)NP * 2 * UPW; float* rt_s = hg_s + (size_t)NS * NH * HD * HD; float* cv_s = rt_s + (size_t)NS * NH * HD * HD;
    float* ws = (float*)d_ws; size_t o = 0;
    float2* tab = (float2*)(ws + o); o += 2056 * 64 * 2;
    float* h = ws + o; o += (size_t)2048 * D;
    float* proj = ws + o; o += (size_t)2048 * INW;
    float* ohat = ws + o; o += (size_t)2048 * D;
    float* x1 = ws + o; o += (size_t)2048 * D;
    float* up = ws + o; o += (size_t)2048 * UPW;
    float* act = ws + o; o += (size_t)2048 * DFF;
    float* x2 = ws + o; o += (size_t)2048 * D;
    rope_tab_k<<<(2056 * 64 + 255) / 256, 256, 0, stream>>>(tab);
    for (int c = 0; c < 9; ++c) {
        const bool smp = (c == 8);
        const int R = smp ? NS * TS : TP, T = smp ? TS : TP, nseq = smp ? NS : 1, p0 = smp ? 2048 : 0;
        const float* x = smp ? x_sample : x_prompt + (size_t)c * TP * D;
        float* y = smp ? y_s : y_p + (size_t)c * TP * D;
        const float* sh = smp ? state_hgrn : nullptr; const float* sr = smp ? state_ret : nullptr; const float* sc = smp ? state_conv : nullptr;
        float* oh = smp ? hg_s : hg_p + (size_t)c * NH * HD * HD; float* orr = smp ? rt_s : rt_p + (size_t)c * NH * HD * HD; float* oc = smp ? cv_s : cv_p + (size_t)c * 2 * UPW;
        rmsnorm_k<<<R, 256, 0, stream>>>(x, w_norm1, h);
        gemm_k<false><<<dim3(INW / 64, R / 64), 256, 0, stream>>>(h, w_in, proj, nullptr, R, INW, D);
        hgrn_k<<<nseq * NH, 128, 0, stream>>>(proj, hgrn_lb, hgrn_norm_w, sh, oh, ohat, T);
        ret_k<<<nseq * NH, 128, 0, stream>>>(proj, tab, ret_norm_w, sr, orr, ohat, T, p0);
        gemm_k<true><<<dim3(D / 64, R / 64), 256, 0, stream>>>(ohat, w_out, x1, x, R, D, D);
        rmsnorm_k<<<R, 256, 0, stream>>>(x1, w_norm2, h);
        gemm_k<false><<<dim3(UPW / 64, R / 64), 256, 0, stream>>>(h, w_ffn_in, up, nullptr, R, UPW, D);
        conv_k<<<(int)(((size_t)R * DFF + 255) / 256), 256, 0, stream>>>(up, conv_w, conv_b, sc, act, oc, T, R);
        gemm_k<true><<<dim3(D / 64, R / 64), 256, 0, stream>>>(act, w_ffn_out, x2, x1, R, D, DFF);
        rmsnorm_k<<<R, 256, 0, stream>>>(x2, w_norm_f, y);
    }
}
```

```cpp
#include <hip/hip_runtime.h>
#include <cstdio>
#include <cstdint>
namespace pg8 {
#define PG8_LAS __attribute__((address_space(3)))
typedef unsigned short bf16_t;
typedef short bf16x8 __attribute__((ext_vector_type(8)));
typedef float f32x4 __attribute__((ext_vector_type(4)));
typedef unsigned u32x4 __attribute__((ext_vector_type(4)));
typedef unsigned u32x2 __attribute__((ext_vector_type(2)));
constexpr int BM = 256, BK = 64, HALF = 128, HTB = HALF * BK * 2  , STAGE_BYTES = 8 * HTB, NXCD = 8, WGM = 8;

__host__ __device__ __forceinline__ int lds_byte(int r, int c) { const int st = (r >> 4) * 2 + (c >> 5), rr = r & 15, cc = c & 31, ob = rr * 64 + cc * 2; return st * 1024 + (ob ^ (((ob >> 9) & 1) << 5)); }
__host__ __device__ __forceinline__ void stage_rc(int b, int& R, int& C) { const int st = b / 1024, sb = b % 1024, swz = sb ^ (((sb >> 9) & 1) << 5); R = (st >> 1) * 16 + swz / 64; C = (st & 1) * 32 + (swz % 64) / 2; }
__host__ __device__ __forceinline__ int perm32(int rho) { const int n = rho >> 4, i = rho & 15; return 8 * (i >> 2) + 4 * n + (i & 3); }

struct Unit { int pm, pn; };
struct Gemm { const bf16_t* A; const bf16_t* Bt; int M, N, K; };

struct StaticOrder {
    int nM, nN, nwg, G, c;
    __host__ __device__ void init(int M, int N, int G_, int c_) { nM = M / BM; nN = N / BM; nwg = nM * nN; G = G_; c = c_; }
    __host__ __device__ bool next(int i, Unit& u) const {
        const long L = (long)i * G + c; if (L >= nwg) return false;
        int wgid = (int)L; { const int q = nwg / NXCD, r = nwg % NXCD, xcd = wgid % NXCD, off = wgid / NXCD; wgid = (xcd < r ? xcd * (q + 1) : r * (q + 1) + (xcd - r) * q) + off; }
        const int nig = WGM * nN, gid = wgid / nig, fm = gid * WGM, gsz = (nM - fm) < WGM ? (nM - fm) : WGM;
        u.pm = fm + ((wgid % nig) % gsz); u.pn = (wgid % nig) / gsz; return true;
    }
    __device__ __forceinline__ void a_ready(const Unit&) const {}
    __device__ __forceinline__ void done(const Unit&) const {}
};
__device__ __forceinline__ unsigned cvt_pk_bf16(float lo, float hi) { unsigned r; asm volatile("v_cvt_pk_bf16_f32 %0, %1, %2" : "=v"(r) : "v"(lo), "v"(hi)); return r; }
constexpr float RMS_EPS = 1e-6f;
struct EpiScaleBf16 {
    static constexpr bool PERM = true, AFTER_DRAIN = false;
    bf16_t* O; int ldc; const float* ss;
    __device__ __forceinline__ void operator()(const f32x4 (&acc)[2][2][4][2], const Unit& u, int wr, int wc, int fr, int fq) const {
        const int row0 = u.pm * BM + wr * 64 + fr, col0 = u.pn * BM + wc * 32 + 8 * fq;
#pragma unroll
        for (int ai = 0; ai < 2; ++ai)
#pragma unroll
            for (int m = 0; m < 4; ++m) { const int row = row0 + ai * HALF + m * 16; const float r = 1.0f / sqrtf(ss[row] * (1.0f / 1024.0f) + RMS_EPS);
                bf16_t* rowp = O + (size_t)row * ldc + col0;
#pragma unroll
                for (int bj = 0; bj < 2; ++bj) { const f32x4 v0 = acc[ai][bj][m][0] * r, v1 = acc[ai][bj][m][1] * r;
                    u32x4 w; w.x = cvt_pk_bf16(v0[0], v0[1]); w.y = cvt_pk_bf16(v0[2], v0[3]); w.z = cvt_pk_bf16(v1[0], v1[1]); w.w = cvt_pk_bf16(v1[2], v1[3]);
                    *(u32x4*)(rowp + bj * HALF) = w; } }
    }
};
struct EpiResF32 {
    static constexpr bool PERM = false, AFTER_DRAIN = false;
    const float* Xp; const float* Xs; float* out; bf16_t* xb; float* ss;
    __device__ __forceinline__ void operator()(const f32x4 (&acc)[2][2][4][2], const Unit& u, int wr, int wc, int fr, int fq) const {
        const int row0 = u.pm * BM + wr * 64 + fr, col0 = u.pn * BM + wc * 32 + 4 * fq;
        const float* X = u.pm < 64 ? Xp : Xs - (size_t)16384 * 1024;
#pragma unroll
        for (int ai = 0; ai < 2; ++ai)
#pragma unroll
            for (int m = 0; m < 4; ++m) { const int row = row0 + ai * HALF + m * 16; const size_t off = (size_t)row * 1024 + col0; float sq = 0.f;
#pragma unroll
                for (int bj = 0; bj < 2; ++bj)
#pragma unroll
                    for (int n = 0; n < 2; ++n) { const f32x4 x = *(const f32x4*)(X + off + bj * HALF + n * 16) + acc[ai][bj][m][n];
                        *(f32x4*)(out + off + bj * HALF + n * 16) = x; sq += (x[0] * x[0] + x[1] * x[1]) + (x[2] * x[2] + x[3] * x[3]);
                        if (xb) { u32x2 w; w.x = cvt_pk_bf16(x[0], x[1]); w.y = cvt_pk_bf16(x[2], x[3]); *(u32x2*)(xb + off + bj * HALF + n * 16) = w; } }
                sq += __shfl_xor(sq, 16); sq += __shfl_xor(sq, 32);
                if (fq == 0) atomicAdd(ss + row, sq); }
    }
};
template <class Epi, class Sched, bool ALIGN_EPI = false, bool SP2 = false>
__device__ __forceinline__ void gemm_phase(PG8_LAS unsigned char* lds, const Gemm g, const Sched& S, const Epi& E) {
    int tid = threadIdx.x; asm volatile("" : "+v"(tid));
    const int wid = __builtin_amdgcn_readfirstlane(tid >> 6), lane = tid & 63, wr = wid >> 2, wc = wid & 3, fr = lane & 15, fq = lane >> 4;
    const int K = g.K, nt = K / BK;
    unsigned voffA[2], voffB[2];
#pragma unroll
    for (int i = 0; i < 2; ++i) { int R, C; stage_rc(tid * 16 + i * 8192, R, C); const int Rb = Epi::PERM ? ((R & ~31) + perm32(R & 31)) : R;
        voffA[i] = (unsigned)(R * K + C) * 2u; voffB[i] = (unsigned)(Rb * K + C) * 2u; }
    const size_t kstep = (size_t)(BK * 2);
    const size_t hstep = (size_t)HALF * K * 2;
    const size_t tstep = 2 * hstep;
    const unsigned ldsw = (unsigned)wid * 1024u;
    const int aoff = lds_byte(wr * 64 + fr, fq * 8), boff = lds_byte(wc * 32 + fr, fq * 8);
#define PG8_SA(b, h) (((b) * 2 + (h)) * HTB)
#define PG8_SB(b, h) ((4 + (b) * 2 + (h)) * HTB)
#define PG8_STAGE(bufoff, gbase, voff) do { _Pragma("unroll") for (int _i = 0; _i < 2; ++_i) \
        __builtin_amdgcn_global_load_lds((const unsigned*)((const char*)(gbase) + (voff)[_i]), (PG8_LAS unsigned*)(lds + (bufoff) + ldsw + _i * 8192), 16, 0, 0); } while (0)
#define PG8_LDA(dst, b, h) do { _Pragma("unroll") for (int m = 0; m < 4; ++m) _Pragma("unroll") for (int k = 0; k < 2; ++k) dst[m][k] = *(const PG8_LAS bf16x8*)(lds + PG8_SA(b, h) + aoff + m * 2048 + k * 1024); } while (0)
#define PG8_LDB(dst, b, h) do { _Pragma("unroll") for (int n = 0; n < 2; ++n) _Pragma("unroll") for (int k = 0; k < 2; ++k) dst[n][k] = *(const PG8_LAS bf16x8*)(lds + PG8_SB(b, h) + boff + n * 2048 + k * 1024); } while (0)
#define PG8_MMA(ai, bj, At, Bt) do { __builtin_amdgcn_s_setprio(1); _Pragma("unroll") for (int m = 0; m < 4; ++m) _Pragma("unroll") for (int n = 0; n < 2; ++n) _Pragma("unroll") for (int k = 0; k < 2; ++k) \
        acc[ai][bj][m][n] = __builtin_amdgcn_mfma_f32_16x16x32_bf16(Bt[n][k], At[m][k], acc[ai][bj][m][n], 0, 0, 0); __builtin_amdgcn_s_setprio(0); } while (0)
#define PG8_WAIT_V(n) asm volatile("s_waitcnt vmcnt(" #n ")" ::: "memory")
#define PG8_WAIT_L(n) asm volatile("s_waitcnt lgkmcnt(" #n ")" ::: "memory")
#define PG8_BAR __builtin_amdgcn_s_barrier()
#define PG8_SCHED __builtin_amdgcn_sched_barrier(0)
    Unit cur, nxt; int ui = 0;
    if (!S.next(0, cur)) return;
    f32x4 acc[2][2][4][2];
#pragma unroll
    for (int a = 0; a < 2; ++a)
#pragma unroll
        for (int b = 0; b < 2; ++b)
#pragma unroll
            for (int m = 0; m < 4; ++m)
#pragma unroll
                for (int n = 0; n < 2; ++n) acc[a][b][m][n] = (f32x4){0.f, 0.f, 0.f, 0.f};
    bf16x8 At[4][2], B0[2][2], B1[2][2];
    const char* cA = (const char*)g.A + (size_t)cur.pm * tstep; const char* cB = (const char*)g.Bt + (size_t)cur.pn * tstep;
    S.a_ready(cur);
    if constexpr (SP2) {
        PG8_STAGE(PG8_SB(0, 0), cB, voffB); PG8_STAGE(PG8_SB(0, 1), cB + hstep, voffB); PG8_STAGE(PG8_SA(0, 0), cA, voffA); PG8_STAGE(PG8_SA(0, 1), cA + hstep, voffA);
        if (wr == 1) PG8_BAR;
        PG8_WAIT_V(2); PG8_BAR;
        PG8_STAGE(PG8_SB(1, 0), cB + kstep, voffB); PG8_STAGE(PG8_SA(1, 0), cA + kstep, voffA); PG8_STAGE(PG8_SB(1, 1), cB + hstep + kstep, voffB);
        PG8_WAIT_V(6); PG8_BAR;
    } else {
        PG8_STAGE(PG8_SB(0, 0), cB, voffB); PG8_STAGE(PG8_SA(0, 0), cA, voffA); PG8_STAGE(PG8_SB(0, 1), cB + hstep, voffB); PG8_STAGE(PG8_SA(0, 1), cA + hstep, voffA);
        if (wr == 1) PG8_BAR;
        PG8_WAIT_V(4); PG8_BAR;
        PG8_STAGE(PG8_SB(1, 0), cB + kstep, voffB); PG8_STAGE(PG8_SA(1, 0), cA + kstep, voffA); PG8_STAGE(PG8_SB(1, 1), cB + hstep + kstep, voffB);
        PG8_WAIT_V(6); PG8_BAR;
    }
    for (;;) {
        const bool has_next = S.next(ui + 1, nxt);
        const char* nA = has_next ? (const char*)g.A + (size_t)nxt.pm * tstep : cA; const char* nB = has_next ? (const char*)g.Bt + (size_t)nxt.pn * tstep : cB;
        for (int t = 0; t < nt; t += 2) {
            const bool last = (t == nt - 2);
            const char* a1 = cA + (size_t)(t + 1) * kstep;
            const char* a2 = last ? nA : cA + (size_t)(t + 2) * kstep; const char* b2 = last ? nB : cB + (size_t)(t + 2) * kstep;
            const char* a3 = a2 + kstep; const char* b3 = b2 + kstep;
            if (last && has_next) S.a_ready(nxt);
            if constexpr (SP2) {
            PG8_LDB(B0, 0, 0); PG8_LDB(B1, 0, 1); PG8_SCHED; PG8_LDA(At, 0, 0); PG8_STAGE(PG8_SA(1, 1), a1 + hstep, voffA);
            PG8_WAIT_V(8); PG8_WAIT_L(0); PG8_BAR; PG8_MMA(0, 0, At, B0); PG8_MMA(0, 1, At, B1); PG8_BAR; PG8_SCHED;
            PG8_LDA(At, 0, 1); PG8_STAGE(PG8_SB(0, 0), b2, voffB); PG8_STAGE(PG8_SB(0, 1), b2 + hstep, voffB); PG8_STAGE(PG8_SA(0, 0), a2, voffA);
            PG8_WAIT_V(8); PG8_WAIT_L(0); PG8_BAR; PG8_MMA(1, 0, At, B0); PG8_MMA(1, 1, At, B1); PG8_BAR; PG8_SCHED;
            PG8_LDB(B0, 1, 0); PG8_LDB(B1, 1, 1); PG8_SCHED; PG8_LDA(At, 1, 0); PG8_STAGE(PG8_SA(0, 1), a2 + hstep, voffA);
            PG8_WAIT_V(8); PG8_WAIT_L(0); PG8_BAR; PG8_MMA(0, 0, At, B0); PG8_MMA(0, 1, At, B1); PG8_BAR; PG8_SCHED;
            PG8_LDA(At, 1, 1); PG8_STAGE(PG8_SB(1, 0), b3, voffB); PG8_STAGE(PG8_SB(1, 1), b3 + hstep, voffB); PG8_STAGE(PG8_SA(1, 0), a3, voffA);
            PG8_WAIT_V(8); PG8_WAIT_L(0); PG8_BAR; PG8_MMA(1, 0, At, B0); PG8_MMA(1, 1, At, B1); PG8_BAR; PG8_SCHED;
            } else {
            PG8_LDB(B0, 0, 0); PG8_SCHED; PG8_LDA(At, 0, 0); PG8_STAGE(PG8_SA(1, 1), a1 + hstep, voffA);
            PG8_WAIT_L(8); PG8_BAR; PG8_WAIT_L(0); PG8_MMA(0, 0, At, B0); PG8_BAR; PG8_SCHED;
            PG8_LDB(B1, 0, 1); PG8_STAGE(PG8_SB(0, 0), b2, voffB);
            PG8_BAR; PG8_WAIT_L(0); PG8_MMA(0, 1, At, B1); PG8_BAR;
            PG8_LDA(At, 0, 1); PG8_STAGE(PG8_SA(0, 0), a2, voffA);
            PG8_BAR; PG8_WAIT_L(0); PG8_MMA(1, 0, At, B0); PG8_BAR; PG8_SCHED;
            PG8_STAGE(PG8_SB(0, 1), b2 + hstep, voffB);
            PG8_WAIT_V(6); PG8_BAR; PG8_MMA(1, 1, At, B1); PG8_BAR;
            PG8_LDB(B0, 1, 0); PG8_SCHED; PG8_LDA(At, 1, 0); PG8_STAGE(PG8_SA(0, 1), a2 + hstep, voffA);
            PG8_WAIT_L(8); PG8_BAR; PG8_WAIT_L(0); PG8_MMA(0, 0, At, B0); PG8_BAR; PG8_SCHED;
            PG8_LDB(B1, 1, 1); PG8_STAGE(PG8_SB(1, 0), b3, voffB);
            PG8_BAR; PG8_WAIT_L(0); PG8_MMA(0, 1, At, B1); PG8_BAR;
            PG8_LDA(At, 1, 1); PG8_STAGE(PG8_SA(1, 0), a3, voffA);
            PG8_BAR; PG8_WAIT_L(0); PG8_MMA(1, 0, At, B0); PG8_BAR; PG8_SCHED;
            PG8_STAGE(PG8_SB(1, 1), b3 + hstep, voffB);
            PG8_WAIT_V(6); PG8_BAR; PG8_MMA(1, 1, At, B1); PG8_BAR;
            }
        }
        if constexpr (ALIGN_EPI) { if (wr == 0) PG8_BAR; }
        if constexpr (!Epi::AFTER_DRAIN) { E(acc, cur, wr, wc, fr, fq); S.done(cur); }
        if (!has_next) break;
#pragma unroll
        for (int a = 0; a < 2; ++a)
#pragma unroll
            for (int b = 0; b < 2; ++b)
#pragma unroll
                for (int m = 0; m < 4; ++m)
#pragma unroll
                    for (int n = 0; n < 2; ++n) acc[a][b][m][n] = (f32x4){0.f, 0.f, 0.f, 0.f};
        cur = nxt; cA = nA; cB = nB; ++ui;
        if constexpr (ALIGN_EPI) { if (wr == 1) PG8_BAR; }
    }
    PG8_WAIT_V(0);
    if constexpr (!ALIGN_EPI) { if (wr == 0) PG8_BAR; }
    PG8_BAR;
    if constexpr (Epi::AFTER_DRAIN) { E.fused(acc, cur, wr, wc, fr, fq, lds, wid, lane); S.done(cur); }
#undef PG8_SA
#undef PG8_SB
#undef PG8_STAGE
#undef PG8_LDA
#undef PG8_LDB
#undef PG8_MMA
#undef PG8_WAIT_V
#undef PG8_WAIT_L
#undef PG8_BAR
#undef PG8_SCHED
}
}
constexpr int NWAVES = 8;
constexpr int D = 1024, MP = 16384, MS = 1024, M = MP + MS;
constexpr int TP = 2048, NBP = 8, TS = 8, NBS = 128, PAST = 16384;
constexpr int INW = 4096, DFF = 2816, UPW = 5632, HD = 128, NH = 4;
constexpr int NHALF = 2, UPH_W = UPW / NHALF;
constexpr size_t MiB = 1u << 20, KiB = 1024;
constexpr size_t WS_CTL = 0, CTL_ZERO_BYTES = 320 * KiB;
constexpr size_t WS_SS2 = 64 * KiB, WS_SS3 = 192 * KiB;
constexpr size_t WS_WIN = 1 * MiB, WS_WOUT = 9 * MiB, WS_WUP = 11 * MiB, WS_WDN = 22 * MiB;
constexpr size_t WS_ROPE = 28 * MiB;
constexpr size_t WS_SS1 = 30 * MiB;
constexpr size_t WS_XB = 32 * MiB;
constexpr size_t WS_PROJ = 66 * MiB;
constexpr size_t WS_OHAT = 202 * MiB;
constexpr size_t WS_UPH = 66 * MiB, WS_ACT = 160 * MiB;
constexpr size_t WS_END = 256 * MiB;
static_assert(WS_WDN + (size_t)D * DFF * 2 <= WS_ROPE && WS_ROPE + 2056 * 64 * 8 <= WS_SS1 && WS_SS1 + M * 4 <= WS_XB && WS_XB + (size_t)M * D * 2 <= WS_PROJ, "ws map 1");
static_assert(WS_PROJ + (size_t)M * INW * 2 <= WS_OHAT && WS_OHAT + (size_t)M * D * 2 <= WS_END && WS_UPH + (size_t)M * UPH_W * 2 <= WS_ACT && WS_ACT + (size_t)M * DFF * 2 <= WS_END, "ws map 2");
constexpr int CW_TMO = 0, CW_CODE = 1, CW_BAR = 4096;
constexpr int RING_OFF = 0, RING_BYTES = 131072;
constexpr int LDSCTL_OFF = RING_BYTES, MISC_OFF = LDSCTL_OFF + 320;
constexpr int LDS_BYTES = 147456;
#define GAS __attribute__((address_space(1)))
#define LAS __attribute__((address_space(3)))
typedef unsigned short bf16;
typedef unsigned v4u __attribute__((ext_vector_type(4)));
typedef unsigned v2u __attribute__((ext_vector_type(2)));
typedef float f32x4 __attribute__((ext_vector_type(4)));
typedef GAS unsigned gu32;
#define RLX_AGENT __ATOMIC_RELAXED, __HIP_MEMORY_SCOPE_AGENT
#define LDS_WAIT() asm volatile("s_waitcnt lgkmcnt(0)" ::: "memory")
#define VM_WAIT() asm volatile("s_waitcnt vmcnt(0)" ::: "memory")
__device__ __forceinline__ unsigned f2bf(float f) { unsigned u = __builtin_bit_cast(unsigned, f); return (u + 0x7fffu + ((u >> 16) & 1u)) >> 16; }
__device__ __forceinline__ unsigned pk2(float lo, float hi) { return f2bf(lo) | (f2bf(hi) << 16); }
__device__ __forceinline__ float bf2f(unsigned short h) { return __builtin_bit_cast(float, (unsigned)h << 16); }
__device__ __forceinline__ float bflo(unsigned w) { return __builtin_bit_cast(float, w << 16); }
__device__ __forceinline__ float bfhi(unsigned w) { return __builtin_bit_cast(float, w & 0xffff0000u); }

#define XB_TMO      128
#define XB_XCNT(j)  (256  + 64 * (j))
#define XB_XSUB(j)  (1280 + 64 * (j))
#define XB_XGEN(j)  (2304 + 64 * (j))
#define XB_TOP      3328
#define XB_TOPGEN   3392
#define XCD_BAR_WORDS 3456
#define XB_SPIN_CAP (1u << 18)

__device__ __forceinline__ unsigned xb_ld(unsigned* p)              { return __hip_atomic_load(p, __ATOMIC_RELAXED, __HIP_MEMORY_SCOPE_AGENT); }
__device__ __forceinline__ unsigned xb_add(unsigned* p, unsigned v) { return __hip_atomic_fetch_add(p, v, __ATOMIC_RELAXED, __HIP_MEMORY_SCOPE_AGENT); }
__device__ __forceinline__ unsigned xb_xcc_id() { return (unsigned)__builtin_amdgcn_s_getreg((3 << 11) | 20) & 0xFu; }
#define XB_SPIN(cond, bar) do { unsigned _sp = 0; while (cond) { __builtin_amdgcn_s_sleep(1); \
    if ((++_sp & 255u) == 0u) { if (xb_ld(&(bar)[XB_TMO])) break; if (_sp > XB_SPIN_CAP) { atomicAdd(&(bar)[XB_TMO], 1u); break; } } } } while (0)

struct XcdBarrier {
    unsigned* bar; unsigned x;
    volatile LAS unsigned* st;
};

__device__ __forceinline__ XcdBarrier xcd_barrier_post(unsigned* bar, volatile LAS unsigned* st) {
    XcdBarrier b; b.bar = bar; b.x = xb_xcc_id(); b.st = st;
    if (threadIdx.x == 0) (void)xb_add(&bar[XB_XCNT(b.x)], 1u);
    return b;
}
__device__ __forceinline__ void xcd_barrier_complete(unsigned* bar, unsigned x, unsigned& nloc, unsigned& nx) {
    const unsigned G = gridDim.x * gridDim.y * gridDim.z;
    unsigned sum, cnt, mine, sp = 0u;
    for (;;) {
        sum = 0u; cnt = 0u; mine = 0u;
#pragma unroll
        for (unsigned j = 0; j < 16; ++j) { const unsigned c = xb_ld(&bar[XB_XCNT(j)]); sum += c; cnt += (c > 0u) ? 1u : 0u; mine = (j == x) ? c : mine; }
        if (sum == G) break;
        __builtin_amdgcn_s_sleep(1);
        if ((++sp & 255u) == 0u) { if (xb_ld(&bar[XB_TMO])) break; if (sp > XB_SPIN_CAP) { atomicAdd(&bar[XB_TMO], 1u); break; } }
    }
    nloc = mine > 0u ? mine : 1u; nx = cnt > 0u ? cnt : 1u;
}

__device__ __forceinline__ void xcd_barrier(const XcdBarrier& b) {
    asm volatile("s_waitcnt vmcnt(0)" ::: "memory");
    __syncthreads();
    if (threadIdx.x == 0) {
        unsigned* bar = b.bar;
        __builtin_amdgcn_s_waitcnt(0);
        unsigned nloc = b.st[0], nx = b.st[1];
        if (nloc == 0u) { xcd_barrier_complete(bar, b.x, nloc, nx); b.st[0] = nloc; b.st[1] = nx; }
        const unsigned old = xb_add(&bar[XB_XSUB(b.x)], 1u);
        const unsigned gen = old / nloc;
        if (old + 1u == (gen + 1u) * nloc) {
            __builtin_amdgcn_fence(__ATOMIC_RELEASE, "agent");
            asm volatile("s_waitcnt vmcnt(0)" ::: "memory");
            const unsigned og = xb_add(&bar[XB_TOP], 1u);
            const unsigned tg = og / nx;
            if (og + 1u == (tg + 1u) * nx) xb_add(&bar[XB_TOPGEN], 1u);
            else XB_SPIN(xb_ld(&bar[XB_TOPGEN]) == tg, bar);
            __builtin_amdgcn_fence(__ATOMIC_ACQUIRE, "agent");
            xb_add(&bar[XB_XGEN(b.x)], 1u);
            asm volatile("s_waitcnt vmcnt(0)" ::: "memory");
        } else {
            XB_SPIN(xb_ld(&bar[XB_XGEN(b.x)]) == gen, bar);
            __builtin_amdgcn_fence(__ATOMIC_ACQUIRE, "agent");
            asm volatile("s_waitcnt vmcnt(0)" ::: "memory");
        }
    }
    __syncthreads();
}
#ifndef PH_MASK
#define PH_MASK 127
#endif
__device__ __forceinline__ float wave_sum(float v) {
#pragma unroll
    for (int o = 1; o < 64; o <<= 1) v += __shfl_xor(v, o);
    return v;
}
__device__ __forceinline__ float silu_f(float x) { return x / (1.0f + expf(-x)); }
__device__ __forceinline__ void sincos_acc(double ang, float& c, float& s) {
    const double TWO_OVER_PI = 0.63661977236758134308, PIO2_HI = 1.57079632679489655800e+00, PIO2_LO = 6.12323399573676603587e-17;
    const double q = rint(ang * TWO_OVER_PI);
    double r = fma(-q, PIO2_HI, ang); r = fma(-q, PIO2_LO, r);
    const int n = ((int)q) & 3;
    const double z = r * r;
    const double S1 = -1.66666666666666324348e-01, S2 = 8.33333333332248946124e-03, S3 = -1.98412698298579493134e-04, S4 = 2.75573137070700676789e-06, S5 = -2.50507602534068634195e-08, S6 = 1.58969099521155010221e-10;
    const double C1 = 4.16666666666666019037e-02, C2 = -1.38888888888741095749e-03, C3 = 2.48015872894767294178e-05, C4 = -2.75573143513906633035e-07, C5 = 2.08757232129817482790e-09, C6 = -1.13596475577881948265e-11;
    const double sn = r + r * z * (S1 + z * (S2 + z * (S3 + z * (S4 + z * (S5 + z * S6)))));
    const double cs = 1.0 - 0.5 * z + z * z * (C1 + z * (C2 + z * (C3 + z * (C4 + z * (C5 + z * C6)))));
    double sv, cv;
    if (n == 0) { sv = sn; cv = cs; } else if (n == 1) { sv = cs; cv = -sn; } else if (n == 2) { sv = -sn; cv = -cs; } else { sv = -cs; cv = sn; }
    c = (float)cv; s = (float)sv;
}
__device__ __forceinline__ int up_col_map(int n) { const int g = n >= DFF ? 1 : 0, ch = n - g * DFF; return (ch >> 7) * 256 + g * 128 + (ch & 127); }
template <bool UPMAP>
__device__ __forceinline__ void p0_transpose_item(const float* W, int K, int N, bf16* WT, const float* kscale, LAS float* scr, int item, int lane) {
    const int nblk = N / 32, kb = item / nblk, nb = item % nblk, k0 = 64 * kb, n0 = 32 * nb;
#pragma unroll 8
    for (int i = 0; i < 32; ++i) { const int kk = 2 * i + (lane >> 5); const float sc = kscale ? kscale[k0 + kk] : 1.0f; scr[kk * 33 + (lane & 31)] = W[(size_t)(k0 + kk) * N + n0 + (lane & 31)] * sc; }
    LDS_WAIT(); asm volatile("" ::: "memory");
    const int c = lane & 7;
    const int r0 = UPMAP ? up_col_map(n0) : n0;
#pragma unroll
    for (int j = 0; j < 4; ++j) { const int n = (lane >> 3) + 8 * j; const LAS float* s = scr + (8 * c) * 33 + n;
        v4u o; o.x = pk2(s[0 * 33], s[1 * 33]); o.y = pk2(s[2 * 33], s[3 * 33]); o.z = pk2(s[4 * 33], s[5 * 33]); o.w = pk2(s[6 * 33], s[7 * 33]);
        *(GAS v4u*)(WT + (size_t)(r0 + n) * K + k0 + 8 * c) = o; }
    LDS_WAIT(); asm volatile("" ::: "memory");
}
__device__ __forceinline__ void x_row_to_bf16(const float* xrow, bf16* orow, float* ss, int lane) {
    const GAS f32x4* xr = (const GAS f32x4*)xrow + lane;
    f32x4 v[4]; float s = 0.f;
#pragma unroll
    for (int j = 0; j < 4; ++j) { v[j] = xr[64 * j]; s += (v[j].x * v[j].x + v[j].y * v[j].y) + (v[j].z * v[j].z + v[j].w * v[j].w); }
    s = wave_sum(s);
    if (lane == 0) *ss = s;
    GAS unsigned long long* o8 = (GAS unsigned long long*)orow + lane;
#pragma unroll
    for (int j = 0; j < 4; ++j) o8[64 * j] = (unsigned long long)pk2(v[j].x, v[j].y) | ((unsigned long long)pk2(v[j].z, v[j].w) << 32);
}

__device__ __forceinline__ float group_sum128(float v, LAS float* red, int d) {
#pragma unroll
    for (int o = 32; o > 0; o >>= 1) v += __shfl_xor(v, o);
    __syncthreads();
    if ((d & 63) == 0) red[d >> 6] = v;
    __syncthreads();
    return red[0] + red[1];
}
template <bool RET>
__device__ __forceinline__ void rec_item(LAS float* scr, const bf16* proj, const float2* tab, const float* normw, const float* lbraw,
                                         const float* s_in, float* s_out, bf16* ohat, int T, int row0, int p0, int h, int kh, int d) {
    LAS float* sq = scr; LAS float* sf = scr + 128; LAS float* sk = scr + 256; LAS float* po = scr + 384; LAS float* red = scr + 640 + 2 * kh;
    float S[64];
    if (s_in) {
#pragma unroll
        for (int k = 0; k < 64; ++k) S[k] = s_in[(size_t)(kh * 64 + k) * HD + d];
    } else {
#pragma unroll
        for (int k = 0; k < 64; ++k) S[k] = 0.f;
    }
    const int ch = h * HD + d;
    const float nw = normw[d];
    float lb = 0.f, gamma = 0.f;
    if (!RET) { const float a0 = lbraw[ch], a1 = lbraw[512 + ch]; const float mx = fmaxf(a0, a1), e0 = expf(a0 - mx), e1 = expf(a1 - mx); lb = e0 / (e0 + e1); }
    else gamma = 1.0f - exp2f(-5.0f - (float)h);
    const int j = d & 63; const bool hi = d >= 64;
    for (int t = 0; t < T; ++t) {
        const bf16* pr = proj + (size_t)(row0 + t) * INW + (RET ? 2048 : 0);
        float qv, fv, kv;
        if (!RET) { qv = bf2f(pr[ch]); const float fa = bf2f(pr[512 + ch]); fv = lb + (1.0f - lb) / (1.0f + expf(-fa)); kv = 1.0f - fv; }
        else { const float2 cs = tab[(size_t)(p0 + t) * 64 + j];
            const float q1 = bf2f(pr[h * HD + j]), q2 = bf2f(pr[h * HD + j + 64]), k1 = bf2f(pr[512 + h * HD + j]), k2 = bf2f(pr[512 + h * HD + j + 64]);
            qv = hi ? (q1 * cs.y + q2 * cs.x) : (q1 * cs.x - q2 * cs.y);
            kv = (hi ? (k1 * cs.y + k2 * cs.x) : (k1 * cs.x - k2 * cs.y)) * 0.08838834764831845f; fv = gamma; }
        const float v = bf2f(pr[1024 + ch]), g = bf2f(pr[1536 + ch]);
        __syncthreads();
        if (kh == 0) { sq[d] = qv; sf[d] = fv; sk[d] = kv; }
        __syncthreads();
        float o = 0.f;
#pragma unroll
        for (int k = 0; k < 64; ++k) { S[k] = fmaf(sf[kh * 64 + k], S[k], sk[kh * 64 + k] * v); o = fmaf(S[k], sq[kh * 64 + k], o); }
        po[kh * 128 + d] = o;
        __syncthreads();
        o = po[d] + po[128 + d];
        float res;
        if (!RET) { const float ss = group_sum128(o * o, red, d); res = o * (1.0f / sqrtf(ss * (1.0f / HD) + 1e-6f)); }
        else { const float mu = group_sum128(o, red, d) * (1.0f / HD); const float xc = o - mu; const float var = group_sum128(xc * xc, red, d) * (1.0f / HD); res = xc * (1.0f / sqrtf(var + 1e-6f)); }
        if (kh == 0) ohat[(size_t)(row0 + t) * D + (RET ? 512 : 0) + ch] = (bf16)f2bf(res * nw * silu_f(g));
    }
#pragma unroll
    for (int k = 0; k < 64; ++k) s_out[(size_t)(kh * 64 + k) * HD + d] = S[k];
}

struct Args { const float* in[17]; float* out; unsigned char* ws; };
__global__ void __launch_bounds__(NWAVES * 64, 2) hyb_fwd(Args args) {
    extern __shared__ __attribute__((aligned(16))) unsigned char lds_raw[];
    LAS unsigned char* lds = (LAS unsigned char*)lds_raw;
    volatile LAS unsigned* MISC = (volatile LAS unsigned*)(lds + MISC_OFF);
    const int tid = threadIdx.x, lane = tid & 63, wave = __builtin_amdgcn_readfirstlane(tid >> 6);
    const int G = gridDim.x; const int bx = blockIdx.x; const int vcu = (G % 8 == 0) ? (bx % 8) * (G / 8) + bx / 8 : bx;
    unsigned char* ws = args.ws;
    gu32* ctl = (gu32*)(ws + WS_CTL);
    const float* x_prompt = args.in[0]; const float* x_sample = args.in[1]; const float* state_hgrn = args.in[2]; const float* state_ret = args.in[3]; const float* state_conv = args.in[4];
    const float* w_norm1 = args.in[5]; const float* w_in = args.in[6]; const float* hgrn_lb = args.in[7]; const float* hgrn_norm_w = args.in[8]; const float* ret_norm_w = args.in[9];
    const float* w_out = args.in[10]; const float* w_norm2 = args.in[11]; const float* w_ffn_in = args.in[12]; const float* conv_w = args.in[13]; const float* conv_b = args.in[14];
    const float* w_ffn_out = args.in[15]; const float* w_norm_f = args.in[16];
    float* out_y = args.out;
    float* out_hgp = out_y + (size_t)M * D; float* out_rtp = out_hgp + (size_t)NBP * NH * HD * HD; float* out_cvp = out_rtp + (size_t)NBP * NH * HD * HD;
    float* out_hgs = out_cvp + (size_t)NBP * 2 * UPW; float* out_rts = out_hgs + (size_t)NBS * NH * HD * HD; float* out_cvs = out_rts + (size_t)NBS * NH * HD * HD;
    bf16* WIN = (bf16*)(ws + WS_WIN); bf16* WOUT = (bf16*)(ws + WS_WOUT); bf16* WUP = (bf16*)(ws + WS_WUP); bf16* WDN = (bf16*)(ws + WS_WDN);
    float2* ROPE = (float2*)(ws + WS_ROPE); float* SS1 = (float*)(ws + WS_SS1); float* SS2 = (float*)(ws + WS_SS2); float* SS3 = (float*)(ws + WS_SS3);
    bf16* XB = (bf16*)(ws + WS_XB); bf16* PROJ = (bf16*)(ws + WS_PROJ); bf16* OHAT = (bf16*)(ws + WS_OHAT); bf16* UPH = (bf16*)(ws + WS_UPH); bf16* ACT = (bf16*)(ws + WS_ACT);

    for (int u = tid; u < (LDS_BYTES - LDSCTL_OFF) / 4; u += NWAVES * 64) ((LAS unsigned*)(lds + LDSCTL_OFF))[u] = 0u;
    __syncthreads();
    XcdBarrier bar = xcd_barrier_post((unsigned*)(ctl + CW_BAR), MISC + 8);
    const int gw = vcu * NWAVES + wave, NGW = G * NWAVES;

#if PH_MASK & 1
    {
        LAS float* scr = (LAS float*)(lds + RING_OFF + wave * 16384);
        constexpr int I_IN = (D / 64) * (INW / 32), I_OUT = (D / 64) * (D / 32), I_UP = (D / 64) * (UPW / 32), I_DN = (DFF / 64) * (D / 32);
        constexpr int NITEMS = I_IN + I_OUT + I_UP + I_DN;
        for (int it = gw; it < NITEMS; it += NGW) {
            int r = it;
            if (r < I_IN) { p0_transpose_item<false>(w_in, D, INW, WIN, w_norm1, scr, r, lane); continue; } r -= I_IN;
            if (r < I_OUT) { p0_transpose_item<false>(w_out, D, D, WOUT, nullptr, scr, r, lane); continue; } r -= I_OUT;
            if (r < I_UP) { p0_transpose_item<true>(w_ffn_in, D, UPW, WUP, w_norm2, scr, r, lane); continue; } r -= I_UP;
            p0_transpose_item<false>(w_ffn_out, DFF, D, WDN, nullptr, scr, r, lane);
        }
        for (int m = gw; m < M; m += NGW) x_row_to_bf16(m < MP ? x_prompt + (size_t)m * D : x_sample + (size_t)(m - MP) * D, XB + (size_t)m * D, SS1 + m, lane);
        for (int i = vcu * 512 + tid; i < 2056 * 64; i += G * 512) {
            const int p = i >> 6, j = i & 63; const int pos = p < 2048 ? p : PAST + (p - 2048);
            const double inv = exp2(-(double)j * (13.287712379549449 / 64.0));
            float c, s; sincos_acc((double)pos * inv, c, s); ROPE[i] = make_float2(c, s);
        }
    }
    xcd_barrier(bar);

#endif
#if PH_MASK & 2
    {
        pg8::Gemm g{XB, WIN, M, INW, D}; pg8::StaticOrder S; S.init(M, INW, G, bx);
        pg8::EpiScaleBf16 E{PROJ, INW, SS1};
        pg8::gemm_phase<pg8::EpiScaleBf16, pg8::StaticOrder, true, true>(lds + RING_OFF, g, S, E);
    }
    xcd_barrier(bar);

#endif
#if PH_MASK & 4
    {
        int t2 = threadIdx.x; asm volatile("" : "+v"(t2));
        const int grp = t2 >> 8, kh = (t2 >> 7) & 1, d = t2 & 127;
        LAS float* scr = (LAS float*)(lds + RING_OFF) + grp * 1024;
        for (int q = vcu; q < 544; q += G) {
            if (q < 16) { const int it = q * 2 + grp, b = it >> 2, h = it & 3;
                rec_item<false>(scr, PROJ, ROPE, hgrn_norm_w, hgrn_lb, nullptr, out_hgp + (size_t)it * HD * HD, OHAT, TP, b * TP, 0, h, kh, d); }
            else if (q < 32) { const int it = (q - 16) * 2 + grp, b = it >> 2, h = it & 3;
                rec_item<true>(scr, PROJ, ROPE, ret_norm_w, hgrn_lb, nullptr, out_rtp + (size_t)it * HD * HD, OHAT, TP, b * TP, 0, h, kh, d); }
            else if (q < 288) { const int it = (q - 32) * 2 + grp, b = it >> 2, h = it & 3;
                rec_item<false>(scr, PROJ, ROPE, hgrn_norm_w, hgrn_lb, state_hgrn + (size_t)it * HD * HD, out_hgs + (size_t)it * HD * HD, OHAT, TS, MP + b * TS, 2048, h, kh, d); }
            else { const int it = (q - 288) * 2 + grp, b = it >> 2, h = it & 3;
                rec_item<true>(scr, PROJ, ROPE, ret_norm_w, hgrn_lb, state_ret + (size_t)it * HD * HD, out_rts + (size_t)it * HD * HD, OHAT, TS, MP + b * TS, 2048, h, kh, d); }
        }
    }
    xcd_barrier(bar);

#endif
#if PH_MASK & 8
    {
        pg8::Gemm g{OHAT, WOUT, M, D, D}; pg8::StaticOrder S; S.init(M, D, G, bx);
        pg8::EpiResF32 E{x_prompt, x_sample, out_y, XB, SS2};
        pg8::gemm_phase<pg8::EpiResF32, pg8::StaticOrder, true, true>(lds + RING_OFF, g, S, E);
    }
    xcd_barrier(bar);

#endif
#if PH_MASK & 16
    for (int half = 0; half < NHALF; ++half) {
        {
            pg8::Gemm g{XB, WUP + (size_t)half * UPH_W * D, M, UPH_W, D}; pg8::StaticOrder S; S.init(M, UPH_W, G, bx);
            pg8::EpiScaleBf16 E{UPH, UPH_W, SS2};
            pg8::gemm_phase<pg8::EpiScaleBf16, pg8::StaticOrder, true, true>(lds + RING_OFF, g, S, E);
        }
        xcd_barrier(bar);
        for (int i = vcu * 512 + tid; i < M * 176; i += G * 512) {
            const int row = i / 176, g8 = i - row * 176, pnl = g8 >> 4, c8 = (g8 & 15) * 8, ch = (half * 11 + pnl) * 128 + c8;
            const bool smp = row >= MP; const int rr = smp ? row - MP : row, T = smp ? TS : TP, b = smp ? rr >> 3 : rr >> 11, t = rr & (T - 1);
            float cu[8], cg[8];
#pragma unroll
            for (int e = 0; e < 8; ++e) { cu[e] = conv_b[ch + e]; cg[e] = conv_b[DFF + ch + e]; }
#pragma unroll
            for (int j = 0; j < 3; ++j) {
                const int tt = t - 2 + j; float eu[8], eg[8];
                if (tt >= 0) { const bf16* p = UPH + (size_t)(row - 2 + j) * UPH_W + pnl * 256 + c8; const v4u a = *(const v4u*)p, bb = *(const v4u*)(p + 128);
#pragma unroll
                    for (int e = 0; e < 4; ++e) { eu[2 * e] = bflo(a[e]); eu[2 * e + 1] = bfhi(a[e]); eg[2 * e] = bflo(bb[e]); eg[2 * e + 1] = bfhi(bb[e]); } }
                else if (smp) { const float* p = state_conv + (size_t)(b * 2 + tt + 2) * UPW + ch;
#pragma unroll
                    for (int e = 0; e < 8; ++e) { eu[e] = p[e]; eg[e] = p[DFF + e]; } }
                else {
#pragma unroll
                    for (int e = 0; e < 8; ++e) { eu[e] = 0.f; eg[e] = 0.f; } }
#pragma unroll
                for (int e = 0; e < 8; ++e) { cu[e] = fmaf(conv_w[j * UPW + ch + e], eu[e], cu[e]); cg[e] = fmaf(conv_w[j * UPW + DFF + ch + e], eg[e], cg[e]); }
                if (j == 2 && t >= T - 2) { float* cs = (smp ? out_cvs : out_cvp) + (size_t)(b * 2 + (t - (T - 2))) * UPW + ch;
#pragma unroll
                    for (int e = 0; e < 8; ++e) { cs[e] = eu[e]; cs[DFF + e] = eg[e]; } }
            }
            v4u o;
#pragma unroll
            for (int e = 0; e < 4; ++e) o[e] = pk2(silu_f(cg[2 * e]) * cu[2 * e], silu_f(cg[2 * e + 1]) * cu[2 * e + 1]);
            *(v4u*)(ACT + (size_t)row * DFF + ch) = o;
        }
        xcd_barrier(bar);
    }

#endif
#if PH_MASK & 32
    {
        pg8::Gemm g{ACT, WDN, M, D, DFF}; pg8::StaticOrder S; S.init(M, D, G, bx);
        pg8::EpiResF32 E{out_y, out_y + (size_t)MP * D, out_y, nullptr, SS3};
        pg8::gemm_phase<pg8::EpiResF32, pg8::StaticOrder, true, true>(lds + RING_OFF, g, S, E);
    }
    xcd_barrier(bar);

#endif
#if PH_MASK & 64
    for (int m = gw; m < M; m += NGW) {
        const float r = 1.0f / sqrtf(SS3[m] * (1.0f / D) + 1e-6f);
        GAS f32x4* xr = (GAS f32x4*)(out_y + (size_t)m * D) + lane; const GAS f32x4* wf = (const GAS f32x4*)w_norm_f + lane;
#pragma unroll
        for (int j = 0; j < 4; ++j) { const f32x4 v = xr[64 * j], w = wf[64 * j]; xr[64 * j] = v * r * w; }
    }
#endif
}

extern "C" void kernel_launch(void* const* d_in, const int* in_sizes, int n_in, void* d_out, int out_size, void* d_ws, size_t ws_size, hipStream_t stream) {
    static int grid = 0;
    if (grid == 0) {
        if (n_in != 17 || ws_size < WS_END) { fprintf(stderr, "kernel_launch: unexpected inputs (n_in %d, ws %zu); nothing launched\n", n_in, ws_size); grid = -1; return; }
        int dev = 0, cus = 0, per_cu = 0;
        if (hipGetDevice(&dev) != hipSuccess || hipDeviceGetAttribute(&cus, hipDeviceAttributeMultiprocessorCount, dev) != hipSuccess) { grid = -1; return; }
        if (hipFuncSetAttribute((const void*)hyb_fwd, hipFuncAttributeMaxDynamicSharedMemorySize, LDS_BYTES) != hipSuccess) { fprintf(stderr, "kernel_launch: hipFuncSetAttribute failed\n"); grid = -1; return; }
        if (hipOccupancyMaxActiveBlocksPerMultiprocessor(&per_cu, (const void*)hyb_fwd, NWAVES * 64, LDS_BYTES) != hipSuccess || per_cu < 1)
            fprintf(stderr, "kernel_launch: note: occupancy query reports %d workgroups per CU\n", per_cu);
        (void)hipGetLastError();
        grid = cus;
    }
    if (grid < 0) return;
    if (hipMemsetAsync((char*)d_ws + WS_CTL, 0, CTL_ZERO_BYTES, stream) != hipSuccess) return;
    Args a{};
    for (int i = 0; i < 17; ++i) a.in[i] = (const float*)d_in[i];
    a.out = (float*)d_out; a.ws = (unsigned char*)d_ws;
    hipLaunchKernelGGL(hyb_fwd, dim3(grid), dim3(NWAVES * 64), LDS_BYTES, stream, a);
}
```

```cpp
#include <hip/hip_runtime.h>
#include <cstdio>
#include <cstdint>
namespace pg8 {
#define PG8_LAS __attribute__((address_space(3)))
typedef unsigned short bf16_t;
typedef short bf16x8 __attribute__((ext_vector_type(8)));
typedef float f32x4 __attribute__((ext_vector_type(4)));
typedef unsigned u32x4 __attribute__((ext_vector_type(4)));
typedef unsigned u32x2 __attribute__((ext_vector_type(2)));
constexpr int BM = 256, BK = 64, HALF = 128, HTB = HALF * BK * 2  , STAGE_BYTES = 8 * HTB, NXCD = 8, WGM = 8;

__host__ __device__ __forceinline__ int lds_byte(int r, int c) { const int st = (r >> 4) * 2 + (c >> 5), rr = r & 15, cc = c & 31, ob = rr * 64 + cc * 2; return st * 1024 + (ob ^ (((ob >> 9) & 1) << 5)); }
__host__ __device__ __forceinline__ void stage_rc(int b, int& R, int& C) { const int st = b / 1024, sb = b % 1024, swz = sb ^ (((sb >> 9) & 1) << 5); R = (st >> 1) * 16 + swz / 64; C = (st & 1) * 32 + (swz % 64) / 2; }
__host__ __device__ __forceinline__ int perm32(int rho) { const int n = rho >> 4, i = rho & 15; return 8 * (i >> 2) + 4 * n + (i & 3); }

struct Unit { int pm, pn; };
struct Gemm { const bf16_t* A; const bf16_t* Bt; int M, N, K; };

struct StaticOrder {
    int nM, nN, nwg, G, c;
    __host__ __device__ void init(int M, int N, int G_, int c_) { nM = M / BM; nN = N / BM; nwg = nM * nN; G = G_; c = c_; }
    __host__ __device__ bool next(int i, Unit& u) const {
        const long L = (long)i * G + c; if (L >= nwg) return false;
        int wgid = (int)L; { const int q = nwg / NXCD, r = nwg % NXCD, xcd = wgid % NXCD, off = wgid / NXCD; wgid = (xcd < r ? xcd * (q + 1) : r * (q + 1) + (xcd - r) * q) + off; }
        const int nig = WGM * nN, gid = wgid / nig, fm = gid * WGM, gsz = (nM - fm) < WGM ? (nM - fm) : WGM;
        u.pm = fm + ((wgid % nig) % gsz); u.pn = (wgid % nig) / gsz; return true;
    }
    __device__ __forceinline__ void a_ready(const Unit&) const {}
    __device__ __forceinline__ void done(const Unit&) const {}
};
typedef __bf16 bf16x2_t __attribute__((ext_vector_type(2)));
typedef float f32x2_t __attribute__((ext_vector_type(2)));
__device__ __forceinline__ unsigned cvt_pk_bf16(float lo, float hi) { const f32x2_t v = {lo, hi}; return __builtin_bit_cast(unsigned, __builtin_convertvector(v, bf16x2_t)); }
constexpr float RMS_EPS = 1e-6f;
struct EpiScaleBf16 {
    static constexpr bool PERM = true, AFTER_DRAIN = false;
    bf16_t* O; int ldc; const float* ss;
    __device__ __forceinline__ void operator()(const f32x4 (&acc)[2][2][4][2], const Unit& u, int wr, int wc, int fr, int fq) const {
        const int row0 = u.pm * BM + wr * 64 + fr, col0 = u.pn * BM + wc * 32 + 8 * fq;
#pragma unroll
        for (int ai = 0; ai < 2; ++ai)
#pragma unroll
            for (int m = 0; m < 4; ++m) { const int row = row0 + ai * HALF + m * 16; const float r = 1.0f / sqrtf(ss[row] * (1.0f / 1024.0f) + RMS_EPS);
                bf16_t* rowp = O + (size_t)row * ldc + col0;
#pragma unroll
                for (int bj = 0; bj < 2; ++bj) { const f32x4 v0 = acc[ai][bj][m][0] * r, v1 = acc[ai][bj][m][1] * r;
                    u32x4 w; w.x = cvt_pk_bf16(v0[0], v0[1]); w.y = cvt_pk_bf16(v0[2], v0[3]); w.z = cvt_pk_bf16(v1[0], v1[1]); w.w = cvt_pk_bf16(v1[2], v1[3]);
                    *(u32x4*)(rowp + bj * HALF) = w; } }
    }
};
struct EpiResF32 {
    static constexpr bool PERM = false, AFTER_DRAIN = false;
    const float* Xp; const float* Xs; float* out; bf16_t* xb; float* ss;
    __device__ __forceinline__ void operator()(const f32x4 (&acc)[2][2][4][2], const Unit& u, int wr, int wc, int fr, int fq) const {
        const int row0 = u.pm * BM + wr * 64 + fr, col0 = u.pn * BM + wc * 32 + 4 * fq;
        const float* X = u.pm < 64 ? Xp : Xs - (size_t)16384 * 1024;
#pragma unroll
        for (int ai = 0; ai < 2; ++ai)
#pragma unroll
            for (int m = 0; m < 4; ++m) { const int row = row0 + ai * HALF + m * 16; const size_t off = (size_t)row * 1024 + col0; float sq = 0.f;
#pragma unroll
                for (int bj = 0; bj < 2; ++bj)
#pragma unroll
                    for (int n = 0; n < 2; ++n) { const f32x4 x = *(const f32x4*)(X + off + bj * HALF + n * 16) + acc[ai][bj][m][n];
                        *(f32x4*)(out + off + bj * HALF + n * 16) = x; sq += (x[0] * x[0] + x[1] * x[1]) + (x[2] * x[2] + x[3] * x[3]);
                        if (xb) { u32x2 w; w.x = cvt_pk_bf16(x[0], x[1]); w.y = cvt_pk_bf16(x[2], x[3]); *(u32x2*)(xb + off + bj * HALF + n * 16) = w; } }
                sq += __shfl_xor(sq, 16); sq += __shfl_xor(sq, 32);
                if (fq == 0) atomicAdd(ss + row, sq); }
    }
};

__device__ __forceinline__ float fexp2(float x) { return __builtin_amdgcn_exp2f(x); }
__device__ __forceinline__ float flog2(float x) { return __builtin_amdgcn_logf(x); }
__device__ __forceinline__ float frcp(float x) { return __builtin_amdgcn_rcpf(x); }
__device__ __forceinline__ float fsigmoid(float x) { return frcp(1.0f + fexp2(-1.4426950408889634f * x)); }
struct EpiPrep {
    static constexpr bool PERM = true, AFTER_DRAIN = false;
    bf16_t* RB; const float* ss; const float* LB; const float* ROPE; float* DVP; float* DVS;
    __device__ __forceinline__ void operator()(const f32x4 (&acc)[2][2][4][2], const Unit& u, int wr, int wc, int fr, int fq) const {
        asm volatile("" : "+v"(fr), "+v"(fq));
        const int kind = u.pn & 1, hp = u.pn >> 1;
        const int row0 = u.pm * BM + wr * 64 + fr, cp = wc * 32 + 8 * fq;
        const bool smp = u.pm >= 64;
        float r[2][4];
#pragma unroll
        for (int ai = 0; ai < 2; ++ai)
#pragma unroll
            for (int m = 0; m < 4; ++m) r[ai][m] = 1.0f / sqrtf(ss[row0 + ai * HALF + m * 16] * (1.0f / 1024.0f) + RMS_EPS);
        bf16_t* base = RB + (size_t)row0 * 4096 + u.pn * BM + cp;
        if (kind == 1) {
#pragma unroll
            for (int ai = 0; ai < 2; ++ai)
#pragma unroll
                for (int m = 0; m < 4; ++m) { bf16_t* rowp = base + (size_t)(ai * HALF + m * 16) * 4096; const float rr = r[ai][m];
                    { const f32x4 v0 = acc[ai][0][m][0] * rr, v1 = acc[ai][0][m][1] * rr;
                      u32x4 w; w.x = cvt_pk_bf16(v0[0], v0[1]); w.y = cvt_pk_bf16(v0[2], v0[3]); w.z = cvt_pk_bf16(v1[0], v1[1]); w.w = cvt_pk_bf16(v1[2], v1[3]); *(u32x4*)rowp = w; }
                    { f32x4 v0 = acc[ai][1][m][0] * rr, v1 = acc[ai][1][m][1] * rr;
#pragma unroll
                      for (int e = 0; e < 4; ++e) { v0[e] = v0[e] * fsigmoid(v0[e]); v1[e] = v1[e] * fsigmoid(v1[e]); }
                      u32x4 w; w.x = cvt_pk_bf16(v0[0], v0[1]); w.y = cvt_pk_bf16(v0[2], v0[3]); w.z = cvt_pk_bf16(v1[0], v1[1]); w.w = cvt_pk_bf16(v1[2], v1[3]); *(u32x4*)(rowp + HALF) = w; } }
        } else if (hp < 4) {
            float lbv[8];
#pragma unroll
            for (int c = 0; c < 8; ++c) lbv[c] = LB[hp * 128 + cp + c];
#pragma unroll
            for (int ai = 0; ai < 2; ++ai) {
                unsigned Qp[4][4], Kp[4][4];
#pragma unroll
                for (int cpair = 0; cpair < 4; ++cpair) {
                    float qo[2][4], ko[2][4];
#pragma unroll
                    for (int cc = 0; cc < 2; ++cc) { const int c = 2 * cpair + cc, n = c >> 2, e = c & 3;
                        float lf[4], kk[4];
#pragma unroll
                        for (int m = 0; m < 4; ++m) { const float fa = acc[ai][1][m][n][e] * r[ai][m]; const float f = lbv[c] + (1.0f - lbv[c]) * fsigmoid(fa); lf[m] = flog2(f); kk[m] = 1.0f - f; }
                        if (!smp) {
#pragma unroll
                            for (int m = 0; m < 4; ++m) {
#pragma unroll
                                for (int d = 1; d < 16; d <<= 1) { const float t = __shfl_up(lf[m], d, 16); if (fr >= d) lf[m] += t; } }
                            float carry = 0.f;
#pragma unroll
                            for (int m = 0; m < 4; ++m) { lf[m] += carry; carry = __shfl(lf[m], 15, 16); }
                            if (fr == 15) DVP[((size_t)((u.pm * 4 + ai * 2 + wr) * 4 + hp)) * 128 + cp + c] = fexp2(lf[3]);
                        } else {
#pragma unroll
                            for (int m = 0; m < 4; ++m) {
#pragma unroll
                                for (int d = 1; d < 8; d <<= 1) { const float t = __shfl_up(lf[m], d, 8); if ((fr & 7) >= d) lf[m] += t; }
                                if ((fr & 7) == 7) { const int seq = (u.pm - 64) * 32 + ai * 16 + wr * 8 + m * 2 + (fr >> 3); DVS[((size_t)(seq * 4 + hp)) * 128 + cp + c] = fexp2(lf[m]); } }
                        }
#pragma unroll
                        for (int m = 0; m < 4; ++m) { const float eb = fexp2(lf[m]); qo[cc][m] = acc[ai][0][m][n][e] * r[ai][m] * eb; ko[cc][m] = kk[m] * frcp(eb); }
                    }
#pragma unroll
                    for (int m = 0; m < 4; ++m) { Qp[m][cpair] = cvt_pk_bf16(qo[0][m], qo[1][m]); Kp[m][cpair] = cvt_pk_bf16(ko[0][m], ko[1][m]); }
                }
#pragma unroll
                for (int m = 0; m < 4; ++m) { bf16_t* rowp = base + (size_t)(ai * HALF + m * 16) * 4096;
                    u32x4 w; w.x = Qp[m][0]; w.y = Qp[m][1]; w.z = Qp[m][2]; w.w = Qp[m][3]; *(u32x4*)rowp = w;
                    u32x4 k; k.x = Kp[m][0]; k.y = Kp[m][1]; k.z = Kp[m][2]; k.w = Kp[m][3]; *(u32x4*)(rowp + HALF) = k; }
            }
        } else {
            const int h = hp - 4; const float lg = flog2(1.0f - fexp2(-5.0f - (float)h));
            const bool isk = wc >= 2; const int j0 = cp & 63;
            bf16_t* obase = RB + (size_t)row0 * 4096 + u.pn * BM + (isk ? 128 : 0) + j0;
#pragma unroll
            for (int ai = 0; ai < 2; ++ai)
#pragma unroll
                for (int m = 0; m < 4; ++m) { const int row = row0 + ai * HALF + m * 16; const int p = smp ? 2048 + (row & 7) : (row & 2047), tau = smp ? (row & 7) : (row & 63);
                    const float dec = fexp2((float)(tau + 1) * lg); const float sc = (isk ? 0.08838834764831845f * frcp(dec) : dec) * r[ai][m];
                    const f32x4* tp = (const f32x4*)(ROPE + ((size_t)p * 64 + j0) * 2); const f32x4 t0 = tp[0], t1 = tp[1], t2 = tp[2], t3 = tp[3];
                    const float cs[8] = {t0[0], t0[2], t1[0], t1[2], t2[0], t2[2], t3[0], t3[2]}, sn[8] = {t0[1], t0[3], t1[1], t1[3], t2[1], t2[3], t3[1], t3[3]};
                    float o1[8], o2[8];
#pragma unroll
                    for (int c = 0; c < 8; ++c) { const float x1 = acc[ai][0][m][c >> 2][c & 3] * sc, x2 = acc[ai][1][m][c >> 2][c & 3] * sc; o1[c] = x1 * cs[c] - x2 * sn[c]; o2[c] = x1 * sn[c] + x2 * cs[c]; }
                    bf16_t* rowp = obase + (size_t)(ai * HALF + m * 16) * 4096;
                    u32x4 w; w.x = cvt_pk_bf16(o1[0], o1[1]); w.y = cvt_pk_bf16(o1[2], o1[3]); w.z = cvt_pk_bf16(o1[4], o1[5]); w.w = cvt_pk_bf16(o1[6], o1[7]); *(u32x4*)rowp = w;
                    u32x4 k; k.x = cvt_pk_bf16(o2[0], o2[1]); k.y = cvt_pk_bf16(o2[2], o2[3]); k.z = cvt_pk_bf16(o2[4], o2[5]); k.w = cvt_pk_bf16(o2[6], o2[7]); *(u32x4*)(rowp + 64) = k; }
        }
    }
};
template <class Epi, class Sched, bool ALIGN_EPI = false, bool SP2 = false>
__device__ __forceinline__ void gemm_phase(PG8_LAS unsigned char* lds, const Gemm g, const Sched& S, const Epi& E) {
    int tid = threadIdx.x; asm volatile("" : "+v"(tid));
    const int wid = __builtin_amdgcn_readfirstlane(tid >> 6), lane = tid & 63, wr = wid >> 2, wc = wid & 3, fr = lane & 15, fq = lane >> 4;
    const int K = g.K, nt = K / BK;
    unsigned voffA[2], voffB[2];
#pragma unroll
    for (int i = 0; i < 2; ++i) { int R, C; stage_rc(tid * 16 + i * 8192, R, C); const int Rb = Epi::PERM ? ((R & ~31) + perm32(R & 31)) : R;
        voffA[i] = (unsigned)(R * K + C) * 2u; voffB[i] = (unsigned)(Rb * K + C) * 2u; }
    const size_t kstep = (size_t)(BK * 2);
    const size_t hstep = (size_t)HALF * K * 2;
    const size_t tstep = 2 * hstep;
    const unsigned ldsw = (unsigned)wid * 1024u;
    const int aoff = lds_byte(wr * 64 + fr, fq * 8), boff = lds_byte(wc * 32 + fr, fq * 8);
#define PG8_SA(b, h) (((b) * 2 + (h)) * HTB)
#define PG8_SB(b, h) ((4 + (b) * 2 + (h)) * HTB)
#define PG8_STAGE(bufoff, gbase, voff) do { _Pragma("unroll") for (int _i = 0; _i < 2; ++_i) \
        __builtin_amdgcn_global_load_lds((const unsigned*)((const char*)(gbase) + (voff)[_i]), (PG8_LAS unsigned*)(lds + (bufoff) + ldsw + _i * 8192), 16, 0, 0); } while (0)
#define PG8_LDA(dst, b, h) do { _Pragma("unroll") for (int m = 0; m < 4; ++m) _Pragma("unroll") for (int k = 0; k < 2; ++k) dst[m][k] = *(const PG8_LAS bf16x8*)(lds + PG8_SA(b, h) + aoff + m * 2048 + k * 1024); } while (0)
#define PG8_LDB(dst, b, h) do { _Pragma("unroll") for (int n = 0; n < 2; ++n) _Pragma("unroll") for (int k = 0; k < 2; ++k) dst[n][k] = *(const PG8_LAS bf16x8*)(lds + PG8_SB(b, h) + boff + n * 2048 + k * 1024); } while (0)
#define PG8_MMA(ai, bj, At, Bt) do { __builtin_amdgcn_s_setprio(1); _Pragma("unroll") for (int m = 0; m < 4; ++m) _Pragma("unroll") for (int n = 0; n < 2; ++n) _Pragma("unroll") for (int k = 0; k < 2; ++k) \
        acc[ai][bj][m][n] = __builtin_amdgcn_mfma_f32_16x16x32_bf16(Bt[n][k], At[m][k], acc[ai][bj][m][n], 0, 0, 0); __builtin_amdgcn_s_setprio(0); } while (0)
#define PG8_WAIT_V(n) asm volatile("s_waitcnt vmcnt(" #n ")" ::: "memory")
#define PG8_WAIT_L(n) asm volatile("s_waitcnt lgkmcnt(" #n ")" ::: "memory")
#define PG8_BAR __builtin_amdgcn_s_barrier()
#define PG8_SCHED __builtin_amdgcn_sched_barrier(0)
    Unit cur, nxt; int ui = 0;
    if (!S.next(0, cur)) return;
    f32x4 acc[2][2][4][2];
#pragma unroll
    for (int a = 0; a < 2; ++a)
#pragma unroll
        for (int b = 0; b < 2; ++b)
#pragma unroll
            for (int m = 0; m < 4; ++m)
#pragma unroll
                for (int n = 0; n < 2; ++n) acc[a][b][m][n] = (f32x4){0.f, 0.f, 0.f, 0.f};
    bf16x8 At[4][2], B0[2][2], B1[2][2];
    const char* cA = (const char*)g.A + (size_t)cur.pm * tstep; const char* cB = (const char*)g.Bt + (size_t)cur.pn * tstep;
    S.a_ready(cur);
    if constexpr (SP2) {
        PG8_STAGE(PG8_SB(0, 0), cB, voffB); PG8_STAGE(PG8_SB(0, 1), cB + hstep, voffB); PG8_STAGE(PG8_SA(0, 0), cA, voffA); PG8_STAGE(PG8_SA(0, 1), cA + hstep, voffA);
        if (wr == 1) PG8_BAR;
        PG8_WAIT_V(2); PG8_BAR;
        PG8_STAGE(PG8_SB(1, 0), cB + kstep, voffB); PG8_STAGE(PG8_SA(1, 0), cA + kstep, voffA); PG8_STAGE(PG8_SB(1, 1), cB + hstep + kstep, voffB);
        PG8_WAIT_V(6); PG8_BAR;
    } else {
        PG8_STAGE(PG8_SB(0, 0), cB, voffB); PG8_STAGE(PG8_SA(0, 0), cA, voffA); PG8_STAGE(PG8_SB(0, 1), cB + hstep, voffB); PG8_STAGE(PG8_SA(0, 1), cA + hstep, voffA);
        if (wr == 1) PG8_BAR;
        PG8_WAIT_V(4); PG8_BAR;
        PG8_STAGE(PG8_SB(1, 0), cB + kstep, voffB); PG8_STAGE(PG8_SA(1, 0), cA + kstep, voffA); PG8_STAGE(PG8_SB(1, 1), cB + hstep + kstep, voffB);
        PG8_WAIT_V(6); PG8_BAR;
    }
    for (;;) {
        const bool has_next = S.next(ui + 1, nxt);
        const char* nA = has_next ? (const char*)g.A + (size_t)nxt.pm * tstep : cA; const char* nB = has_next ? (const char*)g.Bt + (size_t)nxt.pn * tstep : cB;
        for (int t = 0; t < nt; t += 2) {
            const bool last = (t == nt - 2);
            const char* a1 = cA + (size_t)(t + 1) * kstep;
            const char* a2 = last ? nA : cA + (size_t)(t + 2) * kstep; const char* b2 = last ? nB : cB + (size_t)(t + 2) * kstep;
            const char* a3 = a2 + kstep; const char* b3 = b2 + kstep;
            if (last && has_next) S.a_ready(nxt);
            if constexpr (SP2) {
            PG8_LDB(B0, 0, 0); PG8_LDB(B1, 0, 1); PG8_SCHED; PG8_LDA(At, 0, 0); PG8_STAGE(PG8_SA(1, 1), a1 + hstep, voffA);
            PG8_WAIT_V(8); PG8_WAIT_L(0); PG8_BAR; PG8_MMA(0, 0, At, B0); PG8_MMA(0, 1, At, B1); PG8_BAR; PG8_SCHED;
            PG8_LDA(At, 0, 1); PG8_STAGE(PG8_SB(0, 0), b2, voffB); PG8_STAGE(PG8_SB(0, 1), b2 + hstep, voffB); PG8_STAGE(PG8_SA(0, 0), a2, voffA);
            PG8_WAIT_V(8); PG8_WAIT_L(0); PG8_BAR; PG8_MMA(1, 0, At, B0); PG8_MMA(1, 1, At, B1); PG8_BAR; PG8_SCHED;
            PG8_LDB(B0, 1, 0); PG8_LDB(B1, 1, 1); PG8_SCHED; PG8_LDA(At, 1, 0); PG8_STAGE(PG8_SA(0, 1), a2 + hstep, voffA);
            PG8_WAIT_V(8); PG8_WAIT_L(0); PG8_BAR; PG8_MMA(0, 0, At, B0); PG8_MMA(0, 1, At, B1); PG8_BAR; PG8_SCHED;
            PG8_LDA(At, 1, 1); PG8_STAGE(PG8_SB(1, 0), b3, voffB); PG8_STAGE(PG8_SB(1, 1), b3 + hstep, voffB); PG8_STAGE(PG8_SA(1, 0), a3, voffA);
            PG8_WAIT_V(8); PG8_WAIT_L(0); PG8_BAR; PG8_MMA(1, 0, At, B0); PG8_MMA(1, 1, At, B1); PG8_BAR; PG8_SCHED;
            } else {
            PG8_LDB(B0, 0, 0); PG8_SCHED; PG8_LDA(At, 0, 0); PG8_STAGE(PG8_SA(1, 1), a1 + hstep, voffA);
            PG8_WAIT_L(8); PG8_BAR; PG8_WAIT_L(0); PG8_MMA(0, 0, At, B0); PG8_BAR; PG8_SCHED;
            PG8_LDB(B1, 0, 1); PG8_STAGE(PG8_SB(0, 0), b2, voffB);
            PG8_BAR; PG8_WAIT_L(0); PG8_MMA(0, 1, At, B1); PG8_BAR;
            PG8_LDA(At, 0, 1); PG8_STAGE(PG8_SA(0, 0), a2, voffA);
            PG8_BAR; PG8_WAIT_L(0); PG8_MMA(1, 0, At, B0); PG8_BAR; PG8_SCHED;
            PG8_STAGE(PG8_SB(0, 1), b2 + hstep, voffB);
            PG8_WAIT_V(6); PG8_BAR; PG8_MMA(1, 1, At, B1); PG8_BAR;
            PG8_LDB(B0, 1, 0); PG8_SCHED; PG8_LDA(At, 1, 0); PG8_STAGE(PG8_SA(0, 1), a2 + hstep, voffA);
            PG8_WAIT_L(8); PG8_BAR; PG8_WAIT_L(0); PG8_MMA(0, 0, At, B0); PG8_BAR; PG8_SCHED;
            PG8_LDB(B1, 1, 1); PG8_STAGE(PG8_SB(1, 0), b3, voffB);
            PG8_BAR; PG8_WAIT_L(0); PG8_MMA(0, 1, At, B1); PG8_BAR;
            PG8_LDA(At, 1, 1); PG8_STAGE(PG8_SA(1, 0), a3, voffA);
            PG8_BAR; PG8_WAIT_L(0); PG8_MMA(1, 0, At, B0); PG8_BAR; PG8_SCHED;
            PG8_STAGE(PG8_SB(1, 1), b3 + hstep, voffB);
            PG8_WAIT_V(6); PG8_BAR; PG8_MMA(1, 1, At, B1); PG8_BAR;
            }
        }
        if constexpr (ALIGN_EPI) { if (wr == 0) PG8_BAR; }
        if constexpr (!Epi::AFTER_DRAIN) { E(acc, cur, wr, wc, fr, fq); S.done(cur); }
        if (!has_next) break;
#pragma unroll
        for (int a = 0; a < 2; ++a)
#pragma unroll
            for (int b = 0; b < 2; ++b)
#pragma unroll
                for (int m = 0; m < 4; ++m)
#pragma unroll
                    for (int n = 0; n < 2; ++n) acc[a][b][m][n] = (f32x4){0.f, 0.f, 0.f, 0.f};
        cur = nxt; cA = nA; cB = nB; ++ui;
        if constexpr (ALIGN_EPI) { if (wr == 1) PG8_BAR; }
    }
    PG8_WAIT_V(0);
    if constexpr (!ALIGN_EPI) { if (wr == 0) PG8_BAR; }
    PG8_BAR;
    if constexpr (Epi::AFTER_DRAIN) { E.fused(acc, cur, wr, wc, fr, fq, lds, wid, lane); S.done(cur); }
#undef PG8_SA
#undef PG8_SB
#undef PG8_STAGE
#undef PG8_LDA
#undef PG8_LDB
#undef PG8_MMA
#undef PG8_WAIT_V
#undef PG8_WAIT_L
#undef PG8_BAR
#undef PG8_SCHED
}
}
constexpr int NWAVES = 8;
constexpr int D = 1024, MP = 16384, MS = 1024, M = MP + MS;
constexpr int TP = 2048, NBP = 8, TS = 8, NBS = 128, PAST = 16384;
constexpr int INW = 4096, DFF = 2816, UPW = 5632, HD = 128, NH = 4;
constexpr int NHALF = 2, UPH_W = UPW / NHALF;
constexpr size_t MiB = 1u << 20, KiB = 1024;
constexpr size_t WS_CTL = 0, CTL_ZERO_BYTES = 320 * KiB;
constexpr size_t WS_SS2 = 64 * KiB, WS_SS3 = 192 * KiB;
constexpr size_t WS_WIN = 1 * MiB, WS_WOUT = 9 * MiB, WS_WUP = 11 * MiB, WS_WDN = 22 * MiB;
constexpr size_t WS_ROPE = 28 * MiB;
constexpr size_t WS_SS1 = 30 * MiB;
constexpr size_t WS_LB = 30 * MiB + 96 * KiB;
constexpr size_t WS_DVP = 30 * MiB + 128 * KiB;
constexpr size_t WS_DVS = 30 * MiB + 640 * KiB;
constexpr size_t WS_XB = 32 * MiB;
constexpr size_t WS_PROJ = 66 * MiB;
constexpr size_t WS_OHAT = 202 * MiB;
constexpr size_t WS_UPH = 66 * MiB, WS_ACT = 160 * MiB;
constexpr size_t WS_END = 256 * MiB;
static_assert(WS_WDN + (size_t)D * DFF * 2 <= WS_ROPE && WS_ROPE + 2056 * 64 * 8 <= WS_SS1 && WS_SS1 + M * 4 <= WS_XB && WS_XB + (size_t)M * D * 2 <= WS_PROJ, "ws map 1");
static_assert(WS_PROJ + (size_t)M * INW * 2 <= WS_OHAT && WS_OHAT + (size_t)M * D * 2 <= WS_END && WS_UPH + (size_t)M * UPH_W * 2 <= WS_ACT && WS_ACT + (size_t)M * DFF * 2 <= WS_END, "ws map 2");
constexpr int CW_TMO = 0, CW_CODE = 1, CW_BAR = 4096;
constexpr int RING_OFF = 0, RING_BYTES = 131072;
constexpr int LDSCTL_OFF = RING_BYTES, MISC_OFF = LDSCTL_OFF + 320;
constexpr int LDS_BYTES = 147456;
constexpr int RP_OFF = MISC_OFF + 128, RP_STRIDE = 144, RSTAT_OFF = RP_OFF + 64 * RP_STRIDE, RDVEC_OFF = RSTAT_OFF + 1024, R_END = RDVEC_OFF + 1024;
static_assert(RP_OFF % 16 == 0 && R_END <= LDS_BYTES, "LDS map");
#define GAS __attribute__((address_space(1)))
#define LAS __attribute__((address_space(3)))
typedef unsigned short bf16;
typedef unsigned v4u __attribute__((ext_vector_type(4)));
typedef unsigned v2u __attribute__((ext_vector_type(2)));
typedef float f32x4 __attribute__((ext_vector_type(4)));
typedef GAS unsigned gu32;
#define RLX_AGENT __ATOMIC_RELAXED, __HIP_MEMORY_SCOPE_AGENT
#define LDS_WAIT() asm volatile("s_waitcnt lgkmcnt(0)" ::: "memory")
#define VM_WAIT() asm volatile("s_waitcnt vmcnt(0)" ::: "memory")
__device__ __forceinline__ unsigned f2bf(float f) { unsigned u = __builtin_bit_cast(unsigned, f); return (u + 0x7fffu + ((u >> 16) & 1u)) >> 16; }
__device__ __forceinline__ unsigned pk2(float lo, float hi) { return f2bf(lo) | (f2bf(hi) << 16); }
__device__ __forceinline__ float bf2f(unsigned short h) { return __builtin_bit_cast(float, (unsigned)h << 16); }
__device__ __forceinline__ float bflo(unsigned w) { return __builtin_bit_cast(float, w << 16); }
__device__ __forceinline__ float bfhi(unsigned w) { return __builtin_bit_cast(float, w & 0xffff0000u); }

#define XB_TMO      128
#define XB_XCNT(j)  (256  + 64 * (j))
#define XB_XSUB(j)  (1280 + 64 * (j))
#define XB_XGEN(j)  (2304 + 64 * (j))
#define XB_TOP      3328
#define XB_TOPGEN   3392
#define XCD_BAR_WORDS 3456
#define XB_SPIN_CAP (1u << 18)

__device__ __forceinline__ unsigned xb_ld(unsigned* p)              { return __hip_atomic_load(p, __ATOMIC_RELAXED, __HIP_MEMORY_SCOPE_AGENT); }
__device__ __forceinline__ unsigned xb_add(unsigned* p, unsigned v) { return __hip_atomic_fetch_add(p, v, __ATOMIC_RELAXED, __HIP_MEMORY_SCOPE_AGENT); }
__device__ __forceinline__ unsigned xb_xcc_id() { return (unsigned)__builtin_amdgcn_s_getreg((3 << 11) | 20) & 0xFu; }
#define XB_SPIN(cond, bar) do { unsigned _sp = 0; while (cond) { __builtin_amdgcn_s_sleep(1); \
    if ((++_sp & 255u) == 0u) { if (xb_ld(&(bar)[XB_TMO])) break; if (_sp > XB_SPIN_CAP) { atomicAdd(&(bar)[XB_TMO], 1u); break; } } } } while (0)

struct XcdBarrier {
    unsigned* bar; unsigned x;
    volatile LAS unsigned* st;
};

__device__ __forceinline__ XcdBarrier xcd_barrier_post(unsigned* bar, volatile LAS unsigned* st) {
    XcdBarrier b; b.bar = bar; b.x = xb_xcc_id(); b.st = st;
    if (threadIdx.x == 0) (void)xb_add(&bar[XB_XCNT(b.x)], 1u);
    return b;
}
__device__ __forceinline__ void xcd_barrier_complete(unsigned* bar, unsigned x, unsigned& nloc, unsigned& nx) {
    const unsigned G = gridDim.x * gridDim.y * gridDim.z;
    unsigned sum, cnt, mine, sp = 0u;
    for (;;) {
        sum = 0u; cnt = 0u; mine = 0u;
#pragma unroll
        for (unsigned j = 0; j < 16; ++j) { const unsigned c = xb_ld(&bar[XB_XCNT(j)]); sum += c; cnt += (c > 0u) ? 1u : 0u; mine = (j == x) ? c : mine; }
        if (sum == G) break;
        __builtin_amdgcn_s_sleep(1);
        if ((++sp & 255u) == 0u) { if (xb_ld(&bar[XB_TMO])) break; if (sp > XB_SPIN_CAP) { atomicAdd(&bar[XB_TMO], 1u); break; } }
    }
    nloc = mine > 0u ? mine : 1u; nx = cnt > 0u ? cnt : 1u;
}

__device__ __forceinline__ void xcd_barrier(const XcdBarrier& b) {
    asm volatile("s_waitcnt vmcnt(0)" ::: "memory");
    __syncthreads();
    if (threadIdx.x == 0) {
        unsigned* bar = b.bar;
        __builtin_amdgcn_s_waitcnt(0);
        unsigned nloc = b.st[0], nx = b.st[1];
        if (nloc == 0u) { xcd_barrier_complete(bar, b.x, nloc, nx); b.st[0] = nloc; b.st[1] = nx; }
        const unsigned old = xb_add(&bar[XB_XSUB(b.x)], 1u);
        const unsigned gen = old / nloc;
        if (old + 1u == (gen + 1u) * nloc) {
            __builtin_amdgcn_fence(__ATOMIC_RELEASE, "agent");
            asm volatile("s_waitcnt vmcnt(0)" ::: "memory");
            const unsigned og = xb_add(&bar[XB_TOP], 1u);
            const unsigned tg = og / nx;
            if (og + 1u == (tg + 1u) * nx) xb_add(&bar[XB_TOPGEN], 1u);
            else XB_SPIN(xb_ld(&bar[XB_TOPGEN]) == tg, bar);
            __builtin_amdgcn_fence(__ATOMIC_ACQUIRE, "agent");
            xb_add(&bar[XB_XGEN(b.x)], 1u);
            asm volatile("s_waitcnt vmcnt(0)" ::: "memory");
        } else {
            XB_SPIN(xb_ld(&bar[XB_XGEN(b.x)]) == gen, bar);
            __builtin_amdgcn_fence(__ATOMIC_ACQUIRE, "agent");
            asm volatile("s_waitcnt vmcnt(0)" ::: "memory");
        }
    }
    __syncthreads();
}
#ifndef PH_MASK
#define PH_MASK 127
#endif
__device__ __forceinline__ float wave_sum(float v) {
#pragma unroll
    for (int o = 1; o < 64; o <<= 1) v += __shfl_xor(v, o);
    return v;
}
__device__ __forceinline__ float silu_f(float x) { return x / (1.0f + expf(-x)); }
__device__ __forceinline__ void sincos_acc(double ang, float& c, float& s) {
    const double TWO_OVER_PI = 0.63661977236758134308, PIO2_HI = 1.57079632679489655800e+00, PIO2_LO = 6.12323399573676603587e-17;
    const double q = rint(ang * TWO_OVER_PI);
    double r = fma(-q, PIO2_HI, ang); r = fma(-q, PIO2_LO, r);
    const int n = ((int)q) & 3;
    const double z = r * r;
    const double S1 = -1.66666666666666324348e-01, S2 = 8.33333333332248946124e-03, S3 = -1.98412698298579493134e-04, S4 = 2.75573137070700676789e-06, S5 = -2.50507602534068634195e-08, S6 = 1.58969099521155010221e-10;
    const double C1 = 4.16666666666666019037e-02, C2 = -1.38888888888741095749e-03, C3 = 2.48015872894767294178e-05, C4 = -2.75573143513906633035e-07, C5 = 2.08757232129817482790e-09, C6 = -1.13596475577881948265e-11;
    const double sn = r + r * z * (S1 + z * (S2 + z * (S3 + z * (S4 + z * (S5 + z * S6)))));
    const double cs = 1.0 - 0.5 * z + z * z * (C1 + z * (C2 + z * (C3 + z * (C4 + z * (C5 + z * C6)))));
    double sv, cv;
    if (n == 0) { sv = sn; cv = cs; } else if (n == 1) { sv = cs; cv = -sn; } else if (n == 2) { sv = -sn; cv = -cs; } else { sv = -cs; cv = sn; }
    c = (float)cv; s = (float)sv;
}
__device__ __forceinline__ int up_col_map(int n) { const int g = n >= DFF ? 1 : 0, ch = n - g * DFF; return (ch >> 7) * 256 + g * 128 + (ch & 127); }
__device__ __forceinline__ int in_col_map(int n) {
    const int grp = n >> 11, part = (n >> 9) & 3, h = (n >> 7) & 3, c = n & 127, hp = grp * 4 + h;
    if (part >= 2) return (2 * hp + 1) * 256 + (part - 2) * 128 + c;
    if (grp == 0) return (2 * hp) * 256 + part * 128 + c;
    return (2 * hp) * 256 + (c >> 6) * 128 + part * 64 + (c & 63);
}
template <int MAPMODE>
__device__ __forceinline__ void p0_transpose_item(const float* W, int K, int N, bf16* WT, const float* kscale, LAS float* scr, int item, int lane) {
    const int nblk = N / 32, kb = item / nblk, nb = item % nblk, k0 = 64 * kb, n0 = 32 * nb;
#pragma unroll 8
    for (int i = 0; i < 32; ++i) { const int kk = 2 * i + (lane >> 5); const float sc = kscale ? kscale[k0 + kk] : 1.0f; scr[kk * 33 + (lane & 31)] = W[(size_t)(k0 + kk) * N + n0 + (lane & 31)] * sc; }
    LDS_WAIT(); asm volatile("" ::: "memory");
    const int c = lane & 7;
    const int r0 = MAPMODE == 1 ? up_col_map(n0) : MAPMODE == 2 ? in_col_map(n0) : n0;
#pragma unroll
    for (int j = 0; j < 4; ++j) { const int n = (lane >> 3) + 8 * j; const LAS float* s = scr + (8 * c) * 33 + n;
        v4u o; o.x = pk2(s[0 * 33], s[1 * 33]); o.y = pk2(s[2 * 33], s[3 * 33]); o.z = pk2(s[4 * 33], s[5 * 33]); o.w = pk2(s[6 * 33], s[7 * 33]);
        *(GAS v4u*)(WT + (size_t)(r0 + n) * K + k0 + 8 * c) = o; }
    LDS_WAIT(); asm volatile("" ::: "memory");
}
__device__ __forceinline__ void x_row_to_bf16(const float* xrow, bf16* orow, float* ss, int lane) {
    const GAS f32x4* xr = (const GAS f32x4*)xrow + lane;
    f32x4 v[4]; float s = 0.f;
#pragma unroll
    for (int j = 0; j < 4; ++j) { v[j] = xr[64 * j]; s += (v[j].x * v[j].x + v[j].y * v[j].y) + (v[j].z * v[j].z + v[j].w * v[j].w); }
    s = wave_sum(s);
    if (lane == 0) *ss = s;
    GAS unsigned long long* o8 = (GAS unsigned long long*)orow + lane;
#pragma unroll
    for (int j = 0; j < 4; ++j) o8[64 * j] = (unsigned long long)pk2(v[j].x, v[j].y) | ((unsigned long long)pk2(v[j].z, v[j].w) << 32);
}

typedef short bf16x8 __attribute__((ext_vector_type(8)));
typedef short s16x4 __attribute__((ext_vector_type(4)));
template <int CTRL> __device__ __forceinline__ float dppf(float x) { return __builtin_bit_cast(float, __builtin_amdgcn_update_dpp(0, __builtin_bit_cast(int, x), CTRL, 0xf, 0xf, true)); }
__device__ __forceinline__ float row16_sum(float x) { x += dppf<0xB1>(x); x += dppf<0x4E>(x); x += dppf<0x141>(x); x += dppf<0x140>(x); return x; }
__device__ __forceinline__ unsigned off_b(unsigned row, unsigned ch) { return 256u * row + 16u * (ch ^ (((row & 3) << 2) | ((row >> 2) & 3))); }
__device__ __forceinline__ unsigned row_read_addr_16(unsigned lane, unsigned rb, unsigned s) { return off_b((lane & 15) + 16 * rb, 4 * s + (lane >> 4)); }
__device__ __forceinline__ unsigned tr_read_addr_16(unsigned lane, unsigned c, unsigned ks, unsigned t) {
    const unsigned g = lane >> 4, q = (lane & 15) >> 2, p = lane & 3; return off_b(32 * ks + 8 * g + 4 * t + q, 2 * c + (p >> 1)) + 8 * (p & 1); }
__device__ __forceinline__ s16x4 lds_tr(LAS unsigned char* p) { return __builtin_amdgcn_ds_read_tr16_b64_v4i16((LAS s16x4*)p); }
__device__ __forceinline__ bf16x8 cat8(s16x4 a, s16x4 b) { bf16x8 r; r[0] = a[0]; r[1] = a[1]; r[2] = a[2]; r[3] = a[3]; r[4] = b[0]; r[5] = b[1]; r[6] = b[2]; r[7] = b[3]; return r; }
__device__ __forceinline__ bf16x8 pack8(f32x4 a, f32x4 b) { v4u w; w.x = pg8::cvt_pk_bf16(a[0], a[1]); w.y = pg8::cvt_pk_bf16(a[2], a[3]); w.z = pg8::cvt_pk_bf16(b[0], b[1]); w.w = pg8::cvt_pk_bf16(b[2], b[3]); return __builtin_bit_cast(bf16x8, w); }
#define RBAR() do { asm volatile("s_waitcnt lgkmcnt(0)" ::: "memory"); __builtin_amdgcn_s_barrier(); asm volatile("" ::: "memory"); } while (0)

template <bool RET>
__device__ __forceinline__ void rec_chain(LAS unsigned char* lds, const bf16* RB, const float* DVP, const float* normw, float* s_out, bf16* OHAT, int b, int h) {
    int tid = threadIdx.x; asm volatile("" : "+v"(tid));
    const int w = __builtin_amdgcn_readfirstlane(tid >> 6), l = tid & 63, g = l >> 4, c16 = l & 15;
    const int hp = (RET ? 4 : 0) + h, row_base = b * TP;
    const float dconst = RET ? exp2f(64.0f * log2f(1.0f - exp2f(-5.0f - (float)h))) : 1.0f;
    const float nw = normw[16 * w + c16];
    const bf16* gsrc = RB + (size_t)(row_base + (tid >> 6)) * INW + hp * 512 + (tid & 63) * 8;
    v4u pf[8]; f32x4 pfd = {0.f, 0.f, 0.f, 0.f};
#define REC_LOAD(c) do { _Pragma("unroll") for (int i_ = 0; i_ < 8; ++i_) pf[i_] = *(const v4u*)(gsrc + (size_t)((c) * 64 + 8 * i_) * INW); \
        if (!RET && tid < 32) pfd = *(const f32x4*)(DVP + ((size_t)((b * 32 + (c)) * 4 + h)) * 128 + tid * 4); } while (0)
#define REC_STORE(buf) do { _Pragma("unroll") for (int i_ = 0; i_ < 8; ++i_) *(LAS v4u*)(lds + (buf) * 65536 + ((tid & 63) >> 4) * 16384 + off_b((tid >> 6) + 8 * i_, tid & 15)) = pf[i_]; \
        if (!RET && tid < 32) *(LAS f32x4*)(lds + RDVEC_OFF + (buf) * 512 + tid * 16) = pfd; } while (0)
#define REC_PTILE(buf, ti, si) do { f32x4 a_ = {0.f, 0.f, 0.f, 0.f}; \
        _Pragma("unroll") for (int ks_ = 0; ks_ < 4; ++ks_) { const bf16x8 ak_ = *(const LAS bf16x8*)(lds + (buf) * 65536 + 16384 + row_read_addr_16(l, (si), ks_)); \
            const bf16x8 bq_ = *(const LAS bf16x8*)(lds + (buf) * 65536 + row_read_addr_16(l, (ti), ks_)); a_ = __builtin_amdgcn_mfma_f32_16x16x32_bf16(ak_, bq_, a_, 0, 0, 0); } \
        if ((si) == (ti)) { _Pragma("unroll") for (int r_ = 0; r_ < 4; ++r_) a_[r_] = (4 * g + r_ <= c16) ? a_[r_] : 0.f; } \
        v2u pw_; pw_.x = pg8::cvt_pk_bf16(a_[0], a_[1]); pw_.y = pg8::cvt_pk_bf16(a_[2], a_[3]); \
        *(LAS v2u*)(lds + RP_OFF + (16 * (ti) + c16) * RP_STRIDE + (16 * (si) + 4 * g) * 2) = pw_; } while (0)
#define REC_PHASE1(buf) do { switch (w) { case 0: REC_PTILE(buf, 0, 0); REC_PTILE(buf, 3, 2); break; case 1: REC_PTILE(buf, 1, 0); REC_PTILE(buf, 3, 3); break; case 2: REC_PTILE(buf, 1, 1); break; \
        case 3: REC_PTILE(buf, 2, 0); break; case 4: REC_PTILE(buf, 2, 1); break; case 5: REC_PTILE(buf, 2, 2); break; case 6: REC_PTILE(buf, 3, 0); break; default: REC_PTILE(buf, 3, 1); break; } } while (0)
    f32x4 S[8];
#pragma unroll
    for (int i = 0; i < 8; ++i) S[i] = (f32x4){0.f, 0.f, 0.f, 0.f};
    if (tid < 256) { const int t = tid >> 2, q4 = tid & 3; const int ti = t >> 4; if (ti == 0 || ti == 2) *(LAS v2u*)(lds + RP_OFF + t * RP_STRIDE + (16 * (ti + 1) + 4 * q4) * 2) = (v2u){0u, 0u}; }
    if (tid < 256) *(LAS float*)(lds + RSTAT_OFF + tid * 4) = 0.f;
    REC_LOAD(0); REC_STORE(0);
    RBAR();
    REC_LOAD(1);
    REC_PHASE1(0);
    for (int c = 0; c < 32; ++c) {
        const int buf = c & 1;
        LAS unsigned char* tb = lds + buf * 65536;
        RBAR();
        bf16x8 bv[2];
#pragma unroll
        for (int ks = 0; ks < 2; ++ks) bv[ks] = cat8(lds_tr(tb + 32768 + tr_read_addr_16(l, w, ks, 0)), lds_tr(tb + 32768 + tr_read_addr_16(l, w, ks, 1)));
        f32x4 O[4];
#pragma unroll
        for (int ti = 0; ti < 4; ++ti) O[ti] = (f32x4){0.f, 0.f, 0.f, 0.f};
#pragma unroll
        for (int k4 = 0; k4 < 4; ++k4) {
            const bf16x8 bs = pack8(S[2 * k4], S[2 * k4 + 1]);
#pragma unroll
            for (int ti = 0; ti < 4; ++ti) {
                const s16x4 lo = *(const LAS s16x4*)(tb + off_b(16 * ti + c16, 4 * k4 + (g >> 1)) + 8 * (g & 1)), hi = *(const LAS s16x4*)(tb + off_b(16 * ti + c16, 4 * k4 + 2 + (g >> 1)) + 8 * (g & 1));
                O[ti] = __builtin_amdgcn_mfma_f32_16x16x32_bf16(cat8(lo, hi), bs, O[ti], 0, 0, 0); }
        }
#pragma unroll
        for (int ti = 0; ti < 4; ++ti)
#pragma unroll
            for (int ks = 0; ks < 2; ++ks) if (ks <= (ti >> 1)) {
                const bf16x8 ap = *(const LAS bf16x8*)(lds + RP_OFF + (16 * ti + c16) * RP_STRIDE + (32 * ks + 8 * g) * 2);
                O[ti] = __builtin_amdgcn_mfma_f32_16x16x32_bf16(ap, bv[ks], O[ti], 0, 0, 0); }
#pragma unroll
        for (int i = 0; i < 8; ++i) {
#pragma unroll
            for (int ks = 0; ks < 2; ++ks) { const bf16x8 ak = cat8(lds_tr(tb + 16384 + tr_read_addr_16(l, i, ks, 0)), lds_tr(tb + 16384 + tr_read_addr_16(l, i, ks, 1)));
                S[i] = __builtin_amdgcn_mfma_f32_16x16x32_bf16(ak, bv[ks], S[i], 0, 0, 0); }
            if (RET) S[i] = S[i] * dconst; else S[i] = S[i] * *(const LAS f32x4*)(lds + RDVEC_OFF + buf * 512 + (16 * i + 4 * g) * 4);
            if (i & 1) __builtin_amdgcn_sched_barrier(0);
        }
        LAS float* st = (LAS float*)(lds + RSTAT_OFF + buf * 512);
#pragma unroll
        for (int ti = 0; ti < 4; ++ti)
#pragma unroll
            for (int r = 0; r < 4; ++r) { const float o = O[ti][r]; const float s2 = row16_sum(o * o); float s1 = 0.f; if (RET) s1 = row16_sum(o);
                if (c16 == 0) { if (RET) __hip_atomic_fetch_add(st + 16 * ti + 4 * g + r, s1, __ATOMIC_RELAXED, __HIP_MEMORY_SCOPE_WORKGROUP);
                                __hip_atomic_fetch_add(st + 64 + 16 * ti + 4 * g + r, s2, __ATOMIC_RELAXED, __HIP_MEMORY_SCOPE_WORKGROUP); } }
        if (c + 1 < 32) REC_STORE(buf ^ 1);
        RBAR();
#pragma unroll
        for (int ti = 0; ti < 4; ++ti) {
            const f32x4 m1 = *(const LAS f32x4*)(lds + RSTAT_OFF + buf * 512 + (16 * ti + 4 * g) * 4), m2 = *(const LAS f32x4*)(lds + RSTAT_OFF + buf * 512 + 256 + (16 * ti + 4 * g) * 4);
            const s16x4 gs = lds_tr(tb + 49152 + off_b(16 * ti + 4 * g + (c16 >> 2), 2 * w + ((c16 & 3) >> 1)) + 8 * (c16 & 1));
#pragma unroll
            for (int r = 0; r < 4; ++r) {
                float val;
                if (RET) { const float mu = m1[r] * (1.0f / HD); const float var = fmaxf(m2[r] * (1.0f / HD) - mu * mu, 0.f); val = (O[ti][r] - mu) * (1.0f / sqrtf(var + 1e-6f)); }
                else val = O[ti][r] * (1.0f / sqrtf(m2[r] * (1.0f / HD) + 1e-6f));
                OHAT[(size_t)(row_base + c * 64 + 16 * ti + 4 * g + r) * D + hp * HD + 16 * w + c16] = (bf16)f2bf(val * nw * bf2f((unsigned short)gs[r])); }
        }
        if (tid < 128) *(LAS float*)(lds + RSTAT_OFF + (buf ^ 1) * 512 + tid * 4) = 0.f;
        if (c + 2 < 32) REC_LOAD(c + 2);
        if (c + 1 < 32) REC_PHASE1(buf ^ 1);
    }
#pragma unroll
    for (int i = 0; i < 8; ++i)
#pragma unroll
        for (int r = 0; r < 4; ++r) s_out[(size_t)(16 * i + 4 * g + r) * HD + 16 * w + c16] = S[i][r];
    RBAR();
#undef REC_LOAD
#undef REC_STORE
#undef REC_PTILE
#undef REC_PHASE1
}

__device__ __forceinline__ float group_sum128(float v, LAS float* red, int d) {
#pragma unroll
    for (int o = 32; o > 0; o >>= 1) v += __shfl_xor(v, o);
    __syncthreads();
    if ((d & 63) == 0) red[d >> 6] = v;
    __syncthreads();
    return red[0] + red[1];
}
template <bool RET>
__device__ __forceinline__ void rec_item(LAS float* scr, const bf16* RB, const float* DVS, const float* normw, const float* s_in, float* s_out, bf16* ohat, int seq, int h, int kh, int d) {
    LAS float* sq = scr; LAS float* sk = scr + 128; LAS float* po = scr + 384; LAS float* red = scr + 640 + 2 * kh;
    float S[64];
    { const float* p = s_in + (size_t)(kh * 64) * HD + d;
#pragma unroll
      for (int k8 = 0; k8 < 8; ++k8) {
#pragma unroll
          for (int j = 0; j < 8; ++j) S[8 * k8 + j] = p[j * HD];
          p += 8 * HD; asm volatile("" : "+v"(p)); } }
    const int hp = (RET ? 4 : 0) + h, row0 = MP + seq * TS;
    const float nw = normw[d];
    for (int t = 0; t < TS; ++t) {
        const bf16* pr = RB + (size_t)(row0 + t) * INW + hp * 512;
        const float qv = bf2f(pr[d]), kv = bf2f(pr[128 + d]), v = bf2f(pr[256 + d]), gs = bf2f(pr[384 + d]);
        __syncthreads();
        if (kh == 0) { sq[d] = qv; sk[d] = kv; }
        __syncthreads();
        float o = 0.f;
#pragma unroll
        for (int k = 0; k < 64; ++k) { S[k] = fmaf(sk[kh * 64 + k], v, S[k]); o = fmaf(S[k], sq[kh * 64 + k], o); }
        po[kh * 128 + d] = o;
        __syncthreads();
        o = po[d] + po[128 + d];
        float res;
        if (!RET) { const float ss = group_sum128(o * o, red, d); res = o * (1.0f / sqrtf(ss * (1.0f / HD) + 1e-6f)); }
        else { const float mu = group_sum128(o, red, d) * (1.0f / HD); const float xc = o - mu; const float var = group_sum128(xc * xc, red, d) * (1.0f / HD); res = xc * (1.0f / sqrtf(var + 1e-6f)); }
        if (kh == 0) ohat[(size_t)(row0 + t) * D + hp * HD + d] = (bf16)f2bf(res * nw * gs);
    }
    const float dconst = RET ? exp2f(8.0f * log2f(1.0f - exp2f(-5.0f - (float)h))) : 1.0f;
    __syncthreads();
    if (!RET && kh == 0) sq[d] = DVS[((size_t)(seq * 4 + h)) * 128 + d];
    __syncthreads();
    { float* p = s_out + (size_t)(kh * 64) * HD + d;
#pragma unroll
      for (int k8 = 0; k8 < 8; ++k8) {
#pragma unroll
          for (int j = 0; j < 8; ++j) { const float dd = RET ? dconst : sq[kh * 64 + 8 * k8 + j]; p[j * HD] = S[8 * k8 + j] * dd; }
          p += 8 * HD; asm volatile("" : "+v"(p)); } }
}

struct Args { const float* in[17]; float* out; unsigned char* ws; };
__global__ void __launch_bounds__(NWAVES * 64, 2) hyb_fwd(Args args) {
    extern __shared__ __attribute__((aligned(16))) unsigned char lds_raw[];
    LAS unsigned char* lds = (LAS unsigned char*)lds_raw;
    volatile LAS unsigned* MISC = (volatile LAS unsigned*)(lds + MISC_OFF);
    const int tid = threadIdx.x, lane = tid & 63, wave = __builtin_amdgcn_readfirstlane(tid >> 6);
    const int G = gridDim.x; const int bx = blockIdx.x; const int vcu = (G % 8 == 0) ? (bx % 8) * (G / 8) + bx / 8 : bx;
    unsigned char* ws = args.ws;
    gu32* ctl = (gu32*)(ws + WS_CTL);
    const float* x_prompt = args.in[0]; const float* x_sample = args.in[1]; const float* state_hgrn = args.in[2]; const float* state_ret = args.in[3]; const float* state_conv = args.in[4];
    const float* w_norm1 = args.in[5]; const float* w_in = args.in[6]; const float* hgrn_lb = args.in[7]; const float* hgrn_norm_w = args.in[8]; const float* ret_norm_w = args.in[9];
    const float* w_out = args.in[10]; const float* w_norm2 = args.in[11]; const float* w_ffn_in = args.in[12]; const float* conv_w = args.in[13]; const float* conv_b = args.in[14];
    const float* w_ffn_out = args.in[15]; const float* w_norm_f = args.in[16];
    float* out_y = args.out;
    float* out_hgp = out_y + (size_t)M * D; float* out_rtp = out_hgp + (size_t)NBP * NH * HD * HD; float* out_cvp = out_rtp + (size_t)NBP * NH * HD * HD;
    float* out_hgs = out_cvp + (size_t)NBP * 2 * UPW; float* out_rts = out_hgs + (size_t)NBS * NH * HD * HD; float* out_cvs = out_rts + (size_t)NBS * NH * HD * HD;
    bf16* WIN = (bf16*)(ws + WS_WIN); bf16* WOUT = (bf16*)(ws + WS_WOUT); bf16* WUP = (bf16*)(ws + WS_WUP); bf16* WDN = (bf16*)(ws + WS_WDN);
    float2* ROPE = (float2*)(ws + WS_ROPE); float* LBT = (float*)(ws + WS_LB); float* DVP = (float*)(ws + WS_DVP); float* DVS = (float*)(ws + WS_DVS); float* SS1 = (float*)(ws + WS_SS1); float* SS2 = (float*)(ws + WS_SS2); float* SS3 = (float*)(ws + WS_SS3);
    bf16* XB = (bf16*)(ws + WS_XB); bf16* PROJ = (bf16*)(ws + WS_PROJ); bf16* OHAT = (bf16*)(ws + WS_OHAT); bf16* UPH = (bf16*)(ws + WS_UPH); bf16* ACT = (bf16*)(ws + WS_ACT);

    for (int u = tid; u < (LDS_BYTES - LDSCTL_OFF) / 4; u += NWAVES * 64) ((LAS unsigned*)(lds + LDSCTL_OFF))[u] = 0u;
    __syncthreads();
    XcdBarrier bar = xcd_barrier_post((unsigned*)(ctl + CW_BAR), MISC + 8);
    const int gw = vcu * NWAVES + wave, NGW = G * NWAVES;

#if PH_MASK & 1
    {
        LAS float* scr = (LAS float*)(lds + RING_OFF + wave * 16384);
        constexpr int I_IN = (D / 64) * (INW / 32), I_OUT = (D / 64) * (D / 32), I_UP = (D / 64) * (UPW / 32), I_DN = (DFF / 64) * (D / 32);
        constexpr int NITEMS = I_IN + I_OUT + I_UP + I_DN;
        for (int it = gw; it < NITEMS; it += NGW) {
            int r = it;
            if (r < I_IN) { p0_transpose_item<2>(w_in, D, INW, WIN, w_norm1, scr, r, lane); continue; } r -= I_IN;
            if (r < I_OUT) { p0_transpose_item<0>(w_out, D, D, WOUT, nullptr, scr, r, lane); continue; } r -= I_OUT;
            if (r < I_UP) { p0_transpose_item<1>(w_ffn_in, D, UPW, WUP, w_norm2, scr, r, lane); continue; } r -= I_UP;
            p0_transpose_item<0>(w_ffn_out, DFF, D, WDN, nullptr, scr, r, lane);
        }
        for (int m = gw; m < M; m += NGW) x_row_to_bf16(m < MP ? x_prompt + (size_t)m * D : x_sample + (size_t)(m - MP) * D, XB + (size_t)m * D, SS1 + m, lane);
        if (bx == 0) { const float a0 = hgrn_lb[tid], a1 = hgrn_lb[512 + tid]; const float mx = fmaxf(a0, a1), e0 = expf(a0 - mx), e1 = expf(a1 - mx); LBT[tid] = e0 / (e0 + e1); }
        for (int i = vcu * 512 + tid; i < 2056 * 64; i += G * 512) {
            const int p = i >> 6, j = i & 63; const int pos = p < 2048 ? p : PAST + (p - 2048);
            const double inv = exp2(-(double)j * (13.287712379549449 / 64.0));
            float c, s; sincos_acc((double)pos * inv, c, s); ROPE[i] = make_float2(c, s);
        }
    }
    xcd_barrier(bar);

#endif
#if PH_MASK & 2
    {
        pg8::Gemm g{XB, WIN, M, INW, D}; pg8::StaticOrder S; S.init(M, INW, G, bx);
        pg8::EpiPrep E{PROJ, SS1, LBT, (const float*)ROPE, DVP, DVS};
        pg8::gemm_phase<pg8::EpiPrep, pg8::StaticOrder, true, true>(lds + RING_OFF, g, S, E);
    }
    xcd_barrier(bar);

#endif
#if PH_MASK & 4
    {
        if (bx < 64) {
            const int b = (bx >> 2) & 7, h = bx & 3;
            if (bx < 32) rec_chain<false>(lds, PROJ, DVP, hgrn_norm_w, out_hgp + (size_t)(b * 4 + h) * HD * HD, OHAT, b, h);
            else rec_chain<true>(lds, PROJ, DVP, ret_norm_w, out_rtp + (size_t)(b * 4 + h) * HD * HD, OHAT, b, h);
        } else {
            int t2 = threadIdx.x; asm volatile("" : "+v"(t2));
            const int grp = t2 >> 8, kh = (t2 >> 7) & 1, d = t2 & 127;
            LAS float* scr = (LAS float*)(lds + RING_OFF) + grp * 1024;
            for (int q = bx - 64; q < 512; q += G - 64) {
                if (q < 256) { const int it = q * 2 + grp, seq = it >> 2, h = it & 3;
                    rec_item<false>(scr, PROJ, DVS, hgrn_norm_w, state_hgrn + (size_t)it * HD * HD, out_hgs + (size_t)it * HD * HD, OHAT, seq, h, kh, d); }
                else { const int it = (q - 256) * 2 + grp, seq = it >> 2, h = it & 3;
                    rec_item<true>(scr, PROJ, DVS, ret_norm_w, state_ret + (size_t)it * HD * HD, out_rts + (size_t)it * HD * HD, OHAT, seq, h, kh, d); }
            }
        }
    }
    xcd_barrier(bar);

#endif
#if PH_MASK & 8
    {
        pg8::Gemm g{OHAT, WOUT, M, D, D}; pg8::StaticOrder S; S.init(M, D, G, bx);
        pg8::EpiResF32 E{x_prompt, x_sample, out_y, XB, SS2};
        pg8::gemm_phase<pg8::EpiResF32, pg8::StaticOrder, true, true>(lds + RING_OFF, g, S, E);
    }
    xcd_barrier(bar);

#endif
#if PH_MASK & 16
    for (int half = 0; half < NHALF; ++half) {
        {
            pg8::Gemm g{XB, WUP + (size_t)half * UPH_W * D, M, UPH_W, D}; pg8::StaticOrder S; S.init(M, UPH_W, G, bx);
            pg8::EpiScaleBf16 E{UPH, UPH_W, SS2};
            pg8::gemm_phase<pg8::EpiScaleBf16, pg8::StaticOrder, true, true>(lds + RING_OFF, g, S, E);
        }
        xcd_barrier(bar);
        for (int i = vcu * 512 + tid; i < M * 176; i += G * 512) {
            const int row = i / 176, g8 = i - row * 176, pnl = g8 >> 4, c8 = (g8 & 15) * 8, ch = (half * 11 + pnl) * 128 + c8;
            const bool smp = row >= MP; const int rr = smp ? row - MP : row, T = smp ? TS : TP, b = smp ? rr >> 3 : rr >> 11, t = rr & (T - 1);
            float cu[8], cg[8];
#pragma unroll
            for (int e = 0; e < 8; ++e) { cu[e] = conv_b[ch + e]; cg[e] = conv_b[DFF + ch + e]; }
#pragma unroll
            for (int j = 0; j < 3; ++j) {
                const int tt = t - 2 + j; float eu[8], eg[8];
                if (tt >= 0) { const bf16* p = UPH + (size_t)(row - 2 + j) * UPH_W + pnl * 256 + c8; const v4u a = *(const v4u*)p, bb = *(const v4u*)(p + 128);
#pragma unroll
                    for (int e = 0; e < 4; ++e) { eu[2 * e] = bflo(a[e]); eu[2 * e + 1] = bfhi(a[e]); eg[2 * e] = bflo(bb[e]); eg[2 * e + 1] = bfhi(bb[e]); } }
                else if (smp) { const float* p = state_conv + (size_t)(b * 2 + tt + 2) * UPW + ch;
#pragma unroll
                    for (int e = 0; e < 8; ++e) { eu[e] = p[e]; eg[e] = p[DFF + e]; } }
                else {
#pragma unroll
                    for (int e = 0; e < 8; ++e) { eu[e] = 0.f; eg[e] = 0.f; } }
#pragma unroll
                for (int e = 0; e < 8; ++e) { cu[e] = fmaf(conv_w[j * UPW + ch + e], eu[e], cu[e]); cg[e] = fmaf(conv_w[j * UPW + DFF + ch + e], eg[e], cg[e]); }
                if (j == 2 && t >= T - 2) { float* cs = (smp ? out_cvs : out_cvp) + (size_t)(b * 2 + (t - (T - 2))) * UPW + ch;
#pragma unroll
                    for (int e = 0; e < 8; ++e) { cs[e] = eu[e]; cs[DFF + e] = eg[e]; } }
            }
            v4u o;
#pragma unroll
            for (int e = 0; e < 4; ++e) o[e] = pk2(silu_f(cg[2 * e]) * cu[2 * e], silu_f(cg[2 * e + 1]) * cu[2 * e + 1]);
            *(v4u*)(ACT + (size_t)row * DFF + ch) = o;
        }
        xcd_barrier(bar);
    }

#endif
#if PH_MASK & 32
    {
        pg8::Gemm g{ACT, WDN, M, D, DFF}; pg8::StaticOrder S; S.init(M, D, G, bx);
        pg8::EpiResF32 E{out_y, out_y + (size_t)MP * D, out_y, nullptr, SS3};
        pg8::gemm_phase<pg8::EpiResF32, pg8::StaticOrder, true, true>(lds + RING_OFF, g, S, E);
    }
    xcd_barrier(bar);

#endif
#if PH_MASK & 64
    for (int m = gw; m < M; m += NGW) {
        const float r = 1.0f / sqrtf(SS3[m] * (1.0f / D) + 1e-6f);
        GAS f32x4* xr = (GAS f32x4*)(out_y + (size_t)m * D) + lane; const GAS f32x4* wf = (const GAS f32x4*)w_norm_f + lane;
#pragma unroll
        for (int j = 0; j < 4; ++j) { const f32x4 v = xr[64 * j], w = wf[64 * j]; xr[64 * j] = v * r * w; }
    }
#endif
}

extern "C" void kernel_launch(void* const* d_in, const int* in_sizes, int n_in, void* d_out, int out_size, void* d_ws, size_t ws_size, hipStream_t stream) {
    static int grid = 0;
    if (grid == 0) {
        if (n_in != 17 || ws_size < WS_END) { fprintf(stderr, "kernel_launch: unexpected inputs (n_in %d, ws %zu); nothing launched\n", n_in, ws_size); grid = -1; return; }
        int dev = 0, cus = 0, per_cu = 0;
        if (hipGetDevice(&dev) != hipSuccess || hipDeviceGetAttribute(&cus, hipDeviceAttributeMultiprocessorCount, dev) != hipSuccess) { grid = -1; return; }
        if (hipFuncSetAttribute((const void*)hyb_fwd, hipFuncAttributeMaxDynamicSharedMemorySize, LDS_BYTES) != hipSuccess) { fprintf(stderr, "kernel_launch: hipFuncSetAttribute failed\n"); grid = -1; return; }
        if (hipOccupancyMaxActiveBlocksPerMultiprocessor(&per_cu, (const void*)hyb_fwd, NWAVES * 64, LDS_BYTES) != hipSuccess || per_cu < 1)
            fprintf(stderr, "kernel_launch: note: occupancy query reports %d workgroups per CU\n", per_cu);
        (void)hipGetLastError();
        grid = cus;
    }
    if (grid < 0) return;
    if (hipMemsetAsync((char*)d_ws + WS_CTL, 0, CTL_ZERO_BYTES, stream) != hipSuccess) return;
    Args a{};
    for (int i = 0; i < 17; ++i) a.in[i] = (const float*)d_in[i];
    a.out = (float*)d_out; a.ws = (unsigned char*)d_ws;
    hipLaunchKernelGGL(hyb_fwd, dim3(grid), dim3(NWAVES * 64), LDS_BYTES, stream, a);
}
```

```cpp
#include <hip/hip_runtime.h>
#include <cstdio>
#include <cstdint>
namespace pg8 {
#define PG8_LAS __attribute__((address_space(3)))
typedef unsigned short bf16_t;
typedef short bf16x8 __attribute__((ext_vector_type(8)));
typedef float f32x4 __attribute__((ext_vector_type(4)));
typedef unsigned u32x4 __attribute__((ext_vector_type(4)));
typedef unsigned u32x2 __attribute__((ext_vector_type(2)));
constexpr int BM = 256, BK = 64, HALF = 128, HTB = HALF * BK * 2  , STAGE_BYTES = 8 * HTB, NXCD = 8, WGM = 8;

__host__ __device__ __forceinline__ int lds_byte(int r, int c) { const int st = (r >> 4) * 2 + (c >> 5), rr = r & 15, cc = c & 31, ob = rr * 64 + cc * 2; return st * 1024 + (ob ^ (((ob >> 9) & 1) << 5)); }
__host__ __device__ __forceinline__ void stage_rc(int b, int& R, int& C) { const int st = b / 1024, sb = b % 1024, swz = sb ^ (((sb >> 9) & 1) << 5); R = (st >> 1) * 16 + swz / 64; C = (st & 1) * 32 + (swz % 64) / 2; }
__host__ __device__ __forceinline__ int perm32(int rho) { const int n = rho >> 4, i = rho & 15; return 8 * (i >> 2) + 4 * n + (i & 3); }

struct Unit { int pm, pn; };
struct Gemm { const bf16_t* A; const bf16_t* Bt; int M, N, K; };

struct StaticOrder {
    int nM, nN, nwg, G, c;
    __host__ __device__ void init(int M, int N, int G_, int c_) { nM = M / BM; nN = N / BM; nwg = nM * nN; G = G_; c = c_; }
    __host__ __device__ bool next(int i, Unit& u) const {
        const long L = (long)i * G + c; if (L >= nwg) return false;
        int wgid = (int)L; { const int q = nwg / NXCD, r = nwg % NXCD, xcd = wgid % NXCD, off = wgid / NXCD; wgid = (xcd < r ? xcd * (q + 1) : r * (q + 1) + (xcd - r) * q) + off; }
        const int nig = WGM * nN, gid = wgid / nig, fm = gid * WGM, gsz = (nM - fm) < WGM ? (nM - fm) : WGM;
        u.pm = fm + ((wgid % nig) % gsz); u.pn = (wgid % nig) / gsz; return true;
    }
    __device__ __forceinline__ void a_ready(const Unit&) const {}
    __device__ __forceinline__ void done(const Unit&) const {}
};
typedef __bf16 bf16x2_t __attribute__((ext_vector_type(2)));
typedef float f32x2_t __attribute__((ext_vector_type(2)));
__device__ __forceinline__ unsigned cvt_pk_bf16(float lo, float hi) { const f32x2_t v = {lo, hi}; return __builtin_bit_cast(unsigned, __builtin_convertvector(v, bf16x2_t)); }
constexpr float RMS_EPS = 1e-6f;
struct EpiScaleBf16 {
    static constexpr bool PERM = true, AFTER_DRAIN = false;
    bf16_t* O; int ldc; const float* ss;
    __device__ __forceinline__ void operator()(const f32x4 (&acc)[2][2][4][2], const Unit& u, int wr, int wc, int fr, int fq) const {
        const int row0 = u.pm * BM + wr * 64 + fr, col0 = u.pn * BM + wc * 32 + 8 * fq;
#pragma unroll
        for (int ai = 0; ai < 2; ++ai)
#pragma unroll
            for (int m = 0; m < 4; ++m) { const int row = row0 + ai * HALF + m * 16; const float r = 1.0f / sqrtf(ss[row] * (1.0f / 1024.0f) + RMS_EPS);
                bf16_t* rowp = O + (size_t)row * ldc + col0;
#pragma unroll
                for (int bj = 0; bj < 2; ++bj) { const f32x4 v0 = acc[ai][bj][m][0] * r, v1 = acc[ai][bj][m][1] * r;
                    u32x4 w; w.x = cvt_pk_bf16(v0[0], v0[1]); w.y = cvt_pk_bf16(v0[2], v0[3]); w.z = cvt_pk_bf16(v1[0], v1[1]); w.w = cvt_pk_bf16(v1[2], v1[3]);
                    *(u32x4*)(rowp + bj * HALF) = w; } }
    }
};
struct EpiResF32 {
    static constexpr bool PERM = false, AFTER_DRAIN = false;
    const float* Xp; const float* Xs; float* out; bf16_t* xb; float* ss;
    __device__ __forceinline__ void operator()(const f32x4 (&acc)[2][2][4][2], const Unit& u, int wr, int wc, int fr, int fq) const {
        const int row0 = u.pm * BM + wr * 64 + fr, col0 = u.pn * BM + wc * 32 + 4 * fq;
        const float* X = u.pm < 64 ? Xp : Xs - (size_t)16384 * 1024;
#pragma unroll
        for (int ai = 0; ai < 2; ++ai)
#pragma unroll
            for (int m = 0; m < 4; ++m) { const int row = row0 + ai * HALF + m * 16; const size_t off = (size_t)row * 1024 + col0; float sq = 0.f;
#pragma unroll
                for (int bj = 0; bj < 2; ++bj)
#pragma unroll
                    for (int n = 0; n < 2; ++n) { const f32x4 x = *(const f32x4*)(X + off + bj * HALF + n * 16) + acc[ai][bj][m][n];
                        *(f32x4*)(out + off + bj * HALF + n * 16) = x; sq += (x[0] * x[0] + x[1] * x[1]) + (x[2] * x[2] + x[3] * x[3]);
                        if (xb) { u32x2 w; w.x = cvt_pk_bf16(x[0], x[1]); w.y = cvt_pk_bf16(x[2], x[3]); *(u32x2*)(xb + off + bj * HALF + n * 16) = w; } }
                sq += __shfl_xor(sq, 16); sq += __shfl_xor(sq, 32);
                if (fq == 0) atomicAdd(ss + row, sq); }
    }
};

__device__ __forceinline__ float fexp2(float x) { return __builtin_amdgcn_exp2f(x); }
__device__ __forceinline__ float flog2(float x) { return __builtin_amdgcn_logf(x); }
__device__ __forceinline__ float frcp(float x) { return __builtin_amdgcn_rcpf(x); }
__device__ __forceinline__ float fsigmoid(float x) { return frcp(1.0f + fexp2(-1.4426950408889634f * x)); }
struct EpiPrep {
    static constexpr bool PERM = true, AFTER_DRAIN = false;
    bf16_t* RB; const float* ss; const float* LB; const float* ROPE; float* DVP; float* DVS;
    __device__ __forceinline__ void operator()(const f32x4 (&acc)[2][2][4][2], const Unit& u, int wr, int wc, int fr, int fq) const {
        asm volatile("" : "+v"(fr), "+v"(fq));
        const int kind = u.pn & 1, hp = u.pn >> 1;
        const int row0 = u.pm * BM + wr * 64 + fr, cp = wc * 32 + 8 * fq;
        const bool smp = u.pm >= 64;
        float r[2][4];
#pragma unroll
        for (int ai = 0; ai < 2; ++ai)
#pragma unroll
            for (int m = 0; m < 4; ++m) r[ai][m] = 1.0f / sqrtf(ss[row0 + ai * HALF + m * 16] * (1.0f / 1024.0f) + RMS_EPS);
        bf16_t* base = RB + (size_t)row0 * 4096 + u.pn * BM + cp;
        if (kind == 1) {
#pragma unroll
            for (int ai = 0; ai < 2; ++ai)
#pragma unroll
                for (int m = 0; m < 4; ++m) { bf16_t* rowp = base + (size_t)(ai * HALF + m * 16) * 4096; const float rr = r[ai][m];
                    { const f32x4 v0 = acc[ai][0][m][0] * rr, v1 = acc[ai][0][m][1] * rr;
                      u32x4 w; w.x = cvt_pk_bf16(v0[0], v0[1]); w.y = cvt_pk_bf16(v0[2], v0[3]); w.z = cvt_pk_bf16(v1[0], v1[1]); w.w = cvt_pk_bf16(v1[2], v1[3]); *(u32x4*)rowp = w; }
                    { f32x4 v0 = acc[ai][1][m][0] * rr, v1 = acc[ai][1][m][1] * rr;
#pragma unroll
                      for (int e = 0; e < 4; ++e) { v0[e] = v0[e] * fsigmoid(v0[e]); v1[e] = v1[e] * fsigmoid(v1[e]); }
                      u32x4 w; w.x = cvt_pk_bf16(v0[0], v0[1]); w.y = cvt_pk_bf16(v0[2], v0[3]); w.z = cvt_pk_bf16(v1[0], v1[1]); w.w = cvt_pk_bf16(v1[2], v1[3]); *(u32x4*)(rowp + HALF) = w; } }
        } else if (hp < 4) {
            float lbv[8];
#pragma unroll
            for (int c = 0; c < 8; ++c) lbv[c] = LB[hp * 128 + cp + c];
#pragma unroll
            for (int ai = 0; ai < 2; ++ai) {
                unsigned Qp[4][4], Kp[4][4];
#pragma unroll
                for (int cpair = 0; cpair < 4; ++cpair) {
                    float qo[2][4], ko[2][4];
#pragma unroll
                    for (int cc = 0; cc < 2; ++cc) { const int c = 2 * cpair + cc, n = c >> 2, e = c & 3;
                        float lf[4], kk[4];
#pragma unroll
                        for (int m = 0; m < 4; ++m) { const float fa = acc[ai][1][m][n][e] * r[ai][m]; const float f = lbv[c] + (1.0f - lbv[c]) * fsigmoid(fa); lf[m] = flog2(f); kk[m] = 1.0f - f; }
                        if (!smp) {
#pragma unroll
                            for (int m = 0; m < 4; ++m) {
#pragma unroll
                                for (int d = 1; d < 16; d <<= 1) { const float t = __shfl_up(lf[m], d, 16); if (fr >= d) lf[m] += t; } }
                            float carry = 0.f;
#pragma unroll
                            for (int m = 0; m < 4; ++m) { lf[m] += carry; carry = __shfl(lf[m], 15, 16); }
                            if (fr == 15) DVP[((size_t)((u.pm * 4 + ai * 2 + wr) * 4 + hp)) * 128 + cp + c] = fexp2(lf[3]);
                        } else {
#pragma unroll
                            for (int m = 0; m < 4; ++m) {
#pragma unroll
                                for (int d = 1; d < 8; d <<= 1) { const float t = __shfl_up(lf[m], d, 8); if ((fr & 7) >= d) lf[m] += t; }
                                if ((fr & 7) == 7) { const int seq = (u.pm - 64) * 32 + ai * 16 + wr * 8 + m * 2 + (fr >> 3); DVS[((size_t)(seq * 4 + hp)) * 128 + cp + c] = fexp2(lf[m]); } }
                        }
#pragma unroll
                        for (int m = 0; m < 4; ++m) { const float eb = fexp2(lf[m]); qo[cc][m] = acc[ai][0][m][n][e] * r[ai][m] * eb; ko[cc][m] = kk[m] * frcp(eb); }
                    }
#pragma unroll
                    for (int m = 0; m < 4; ++m) { Qp[m][cpair] = cvt_pk_bf16(qo[0][m], qo[1][m]); Kp[m][cpair] = cvt_pk_bf16(ko[0][m], ko[1][m]); }
                }
#pragma unroll
                for (int m = 0; m < 4; ++m) { bf16_t* rowp = base + (size_t)(ai * HALF + m * 16) * 4096;
                    u32x4 w; w.x = Qp[m][0]; w.y = Qp[m][1]; w.z = Qp[m][2]; w.w = Qp[m][3]; *(u32x4*)rowp = w;
                    u32x4 k; k.x = Kp[m][0]; k.y = Kp[m][1]; k.z = Kp[m][2]; k.w = Kp[m][3]; *(u32x4*)(rowp + HALF) = k; }
            }
        } else {
            const int h = hp - 4; const float lg = flog2(1.0f - fexp2(-5.0f - (float)h));
            const bool isk = wc >= 2; const int j0 = cp & 63;
            bf16_t* obase = RB + (size_t)row0 * 4096 + u.pn * BM + (isk ? 128 : 0) + j0;
#pragma unroll
            for (int ai = 0; ai < 2; ++ai)
#pragma unroll
                for (int m = 0; m < 4; ++m) { const int row = row0 + ai * HALF + m * 16; const int p = smp ? 2048 + (row & 7) : (row & 2047), tau = smp ? (row & 7) : (row & 63);
                    const float dec = fexp2((float)(tau + 1) * lg); const float sc = (isk ? 0.08838834764831845f * frcp(dec) : dec) * r[ai][m];
                    const f32x4* tp = (const f32x4*)(ROPE + ((size_t)p * 64 + j0) * 2); const f32x4 t0 = tp[0], t1 = tp[1], t2 = tp[2], t3 = tp[3];
                    const float cs[8] = {t0[0], t0[2], t1[0], t1[2], t2[0], t2[2], t3[0], t3[2]}, sn[8] = {t0[1], t0[3], t1[1], t1[3], t2[1], t2[3], t3[1], t3[3]};
                    float o1[8], o2[8];
#pragma unroll
                    for (int c = 0; c < 8; ++c) { const float x1 = acc[ai][0][m][c >> 2][c & 3] * sc, x2 = acc[ai][1][m][c >> 2][c & 3] * sc; o1[c] = x1 * cs[c] - x2 * sn[c]; o2[c] = x1 * sn[c] + x2 * cs[c]; }
                    bf16_t* rowp = obase + (size_t)(ai * HALF + m * 16) * 4096;
                    u32x4 w; w.x = cvt_pk_bf16(o1[0], o1[1]); w.y = cvt_pk_bf16(o1[2], o1[3]); w.z = cvt_pk_bf16(o1[4], o1[5]); w.w = cvt_pk_bf16(o1[6], o1[7]); *(u32x4*)rowp = w;
                    u32x4 k; k.x = cvt_pk_bf16(o2[0], o2[1]); k.y = cvt_pk_bf16(o2[2], o2[3]); k.z = cvt_pk_bf16(o2[4], o2[5]); k.w = cvt_pk_bf16(o2[6], o2[7]); *(u32x4*)(rowp + 64) = k; }
        }
    }
};
template <class Epi, class Sched, bool ALIGN_EPI = false, bool SP2 = false, bool ABLK = false>
__device__ __forceinline__ void gemm_phase(PG8_LAS unsigned char* lds, const Gemm g, const Sched& S, const Epi& E) {
    int tid = threadIdx.x; asm volatile("" : "+v"(tid));
    const int wid = __builtin_amdgcn_readfirstlane(tid >> 6), lane = tid & 63, wr = wid >> 2, wc = wid & 3, fr = lane & 15, fq = lane >> 4;
    const int K = g.K, nt = K / BK;
    unsigned voffA[2], voffB[2];
#pragma unroll
    for (int i = 0; i < 2; ++i) { int R, C; stage_rc(tid * 16 + i * 8192, R, C); const int Rb = Epi::PERM ? ((R & ~31) + perm32(R & 31)) : R;
        voffA[i] = ABLK ? (unsigned)(((R >> 4) * (K >> 3) + (C >> 3)) * 256 + (R & 15) * 16) : (unsigned)(R * K + C) * 2u; voffB[i] = (unsigned)(Rb * K + C) * 2u; }
    const size_t kstep = (size_t)(BK * 2), kstepA = ABLK ? (size_t)(BK / 8) * 256 : kstep;
    const size_t hstep = (size_t)HALF * K * 2;
    const size_t tstep = 2 * hstep;
    const unsigned ldsw = (unsigned)wid * 1024u;
    const int aoff = lds_byte(wr * 64 + fr, fq * 8), boff = lds_byte(wc * 32 + fr, fq * 8);
#define PG8_SA(b, h) (((b) * 2 + (h)) * HTB)
#define PG8_SB(b, h) ((4 + (b) * 2 + (h)) * HTB)
#define PG8_STAGE(bufoff, gbase, voff) do { _Pragma("unroll") for (int _i = 0; _i < 2; ++_i) \
        __builtin_amdgcn_global_load_lds((const unsigned*)((const char*)(gbase) + (voff)[_i]), (PG8_LAS unsigned*)(lds + (bufoff) + ldsw + _i * 8192), 16, 0, 0); } while (0)
#define PG8_LDA(dst, b, h) do { _Pragma("unroll") for (int m = 0; m < 4; ++m) _Pragma("unroll") for (int k = 0; k < 2; ++k) dst[m][k] = *(const PG8_LAS bf16x8*)(lds + PG8_SA(b, h) + aoff + m * 2048 + k * 1024); } while (0)
#define PG8_LDB(dst, b, h) do { _Pragma("unroll") for (int n = 0; n < 2; ++n) _Pragma("unroll") for (int k = 0; k < 2; ++k) dst[n][k] = *(const PG8_LAS bf16x8*)(lds + PG8_SB(b, h) + boff + n * 2048 + k * 1024); } while (0)
#define PG8_MMA(ai, bj, At, Bt) do { __builtin_amdgcn_s_setprio(1); _Pragma("unroll") for (int m = 0; m < 4; ++m) _Pragma("unroll") for (int n = 0; n < 2; ++n) _Pragma("unroll") for (int k = 0; k < 2; ++k) \
        acc[ai][bj][m][n] = __builtin_amdgcn_mfma_f32_16x16x32_bf16(Bt[n][k], At[m][k], acc[ai][bj][m][n], 0, 0, 0); __builtin_amdgcn_s_setprio(0); } while (0)
#define PG8_WAIT_V(n) asm volatile("s_waitcnt vmcnt(" #n ")" ::: "memory")
#define PG8_WAIT_L(n) asm volatile("s_waitcnt lgkmcnt(" #n ")" ::: "memory")
#define PG8_BAR __builtin_amdgcn_s_barrier()
#define PG8_SCHED __builtin_amdgcn_sched_barrier(0)
    Unit cur, nxt; int ui = 0;
    if (!S.next(0, cur)) return;
    f32x4 acc[2][2][4][2];
#pragma unroll
    for (int a = 0; a < 2; ++a)
#pragma unroll
        for (int b = 0; b < 2; ++b)
#pragma unroll
            for (int m = 0; m < 4; ++m)
#pragma unroll
                for (int n = 0; n < 2; ++n) acc[a][b][m][n] = (f32x4){0.f, 0.f, 0.f, 0.f};
    bf16x8 At[4][2], B0[2][2], B1[2][2];
    const char* cA = (const char*)g.A + (size_t)cur.pm * tstep; const char* cB = (const char*)g.Bt + (size_t)cur.pn * tstep;
    S.a_ready(cur);
    if constexpr (SP2) {
        PG8_STAGE(PG8_SB(0, 0), cB, voffB); PG8_STAGE(PG8_SB(0, 1), cB + hstep, voffB); PG8_STAGE(PG8_SA(0, 0), cA, voffA); PG8_STAGE(PG8_SA(0, 1), cA + hstep, voffA);
        if (wr == 1) PG8_BAR;
        PG8_WAIT_V(2); PG8_BAR;
        PG8_STAGE(PG8_SB(1, 0), cB + kstep, voffB); PG8_STAGE(PG8_SA(1, 0), cA + kstepA, voffA); PG8_STAGE(PG8_SB(1, 1), cB + hstep + kstep, voffB);
        PG8_WAIT_V(6); PG8_BAR;
    } else {
        PG8_STAGE(PG8_SB(0, 0), cB, voffB); PG8_STAGE(PG8_SA(0, 0), cA, voffA); PG8_STAGE(PG8_SB(0, 1), cB + hstep, voffB); PG8_STAGE(PG8_SA(0, 1), cA + hstep, voffA);
        if (wr == 1) PG8_BAR;
        PG8_WAIT_V(4); PG8_BAR;
        PG8_STAGE(PG8_SB(1, 0), cB + kstep, voffB); PG8_STAGE(PG8_SA(1, 0), cA + kstepA, voffA); PG8_STAGE(PG8_SB(1, 1), cB + hstep + kstep, voffB);
        PG8_WAIT_V(6); PG8_BAR;
    }
    for (;;) {
        const bool has_next = S.next(ui + 1, nxt);
        const char* nA = has_next ? (const char*)g.A + (size_t)nxt.pm * tstep : cA; const char* nB = has_next ? (const char*)g.Bt + (size_t)nxt.pn * tstep : cB;
        for (int t = 0; t < nt; t += 2) {
            const bool last = (t == nt - 2);
            const char* a1 = cA + (size_t)(t + 1) * kstepA;
            const char* a2 = last ? nA : cA + (size_t)(t + 2) * kstepA; const char* b2 = last ? nB : cB + (size_t)(t + 2) * kstep;
            const char* a3 = a2 + kstepA; const char* b3 = b2 + kstep;
            if (last && has_next) S.a_ready(nxt);
            if constexpr (SP2) {
            PG8_LDB(B0, 0, 0); PG8_LDB(B1, 0, 1); PG8_SCHED; PG8_LDA(At, 0, 0); PG8_STAGE(PG8_SA(1, 1), a1 + hstep, voffA);
            PG8_WAIT_V(8); PG8_WAIT_L(0); PG8_BAR; PG8_MMA(0, 0, At, B0); PG8_MMA(0, 1, At, B1); PG8_BAR; PG8_SCHED;
            PG8_LDA(At, 0, 1); PG8_STAGE(PG8_SB(0, 0), b2, voffB); PG8_STAGE(PG8_SB(0, 1), b2 + hstep, voffB); PG8_STAGE(PG8_SA(0, 0), a2, voffA);
            PG8_WAIT_V(8); PG8_WAIT_L(0); PG8_BAR; PG8_MMA(1, 0, At, B0); PG8_MMA(1, 1, At, B1); PG8_BAR; PG8_SCHED;
            PG8_LDB(B0, 1, 0); PG8_LDB(B1, 1, 1); PG8_SCHED; PG8_LDA(At, 1, 0); PG8_STAGE(PG8_SA(0, 1), a2 + hstep, voffA);
            PG8_WAIT_V(8); PG8_WAIT_L(0); PG8_BAR; PG8_MMA(0, 0, At, B0); PG8_MMA(0, 1, At, B1); PG8_BAR; PG8_SCHED;
            PG8_LDA(At, 1, 1); PG8_STAGE(PG8_SB(1, 0), b3, voffB); PG8_STAGE(PG8_SB(1, 1), b3 + hstep, voffB); PG8_STAGE(PG8_SA(1, 0), a3, voffA);
            PG8_WAIT_V(8); PG8_WAIT_L(0); PG8_BAR; PG8_MMA(1, 0, At, B0); PG8_MMA(1, 1, At, B1); PG8_BAR; PG8_SCHED;
            } else {
            PG8_LDB(B0, 0, 0); PG8_SCHED; PG8_LDA(At, 0, 0); PG8_STAGE(PG8_SA(1, 1), a1 + hstep, voffA);
            PG8_WAIT_L(8); PG8_BAR; PG8_WAIT_L(0); PG8_MMA(0, 0, At, B0); PG8_BAR; PG8_SCHED;
            PG8_LDB(B1, 0, 1); PG8_STAGE(PG8_SB(0, 0), b2, voffB);
            PG8_BAR; PG8_WAIT_L(0); PG8_MMA(0, 1, At, B1); PG8_BAR;
            PG8_LDA(At, 0, 1); PG8_STAGE(PG8_SA(0, 0), a2, voffA);
            PG8_BAR; PG8_WAIT_L(0); PG8_MMA(1, 0, At, B0); PG8_BAR; PG8_SCHED;
            PG8_STAGE(PG8_SB(0, 1), b2 + hstep, voffB);
            PG8_WAIT_V(6); PG8_BAR; PG8_MMA(1, 1, At, B1); PG8_BAR;
            PG8_LDB(B0, 1, 0); PG8_SCHED; PG8_LDA(At, 1, 0); PG8_STAGE(PG8_SA(0, 1), a2 + hstep, voffA);
            PG8_WAIT_L(8); PG8_BAR; PG8_WAIT_L(0); PG8_MMA(0, 0, At, B0); PG8_BAR; PG8_SCHED;
            PG8_LDB(B1, 1, 1); PG8_STAGE(PG8_SB(1, 0), b3, voffB);
            PG8_BAR; PG8_WAIT_L(0); PG8_MMA(0, 1, At, B1); PG8_BAR;
            PG8_LDA(At, 1, 1); PG8_STAGE(PG8_SA(1, 0), a3, voffA);
            PG8_BAR; PG8_WAIT_L(0); PG8_MMA(1, 0, At, B0); PG8_BAR; PG8_SCHED;
            PG8_STAGE(PG8_SB(1, 1), b3 + hstep, voffB);
            PG8_WAIT_V(6); PG8_BAR; PG8_MMA(1, 1, At, B1); PG8_BAR;
            }
        }
        if constexpr (ALIGN_EPI) { if (wr == 0) PG8_BAR; }
        if constexpr (!Epi::AFTER_DRAIN) { E(acc, cur, wr, wc, fr, fq); S.done(cur); }
        if (!has_next) break;
#pragma unroll
        for (int a = 0; a < 2; ++a)
#pragma unroll
            for (int b = 0; b < 2; ++b)
#pragma unroll
                for (int m = 0; m < 4; ++m)
#pragma unroll
                    for (int n = 0; n < 2; ++n) acc[a][b][m][n] = (f32x4){0.f, 0.f, 0.f, 0.f};
        cur = nxt; cA = nA; cB = nB; ++ui;
        if constexpr (ALIGN_EPI) { if (wr == 1) PG8_BAR; }
    }
    PG8_WAIT_V(0);
    if constexpr (!ALIGN_EPI) { if (wr == 0) PG8_BAR; }
    PG8_BAR;
    if constexpr (Epi::AFTER_DRAIN) { E.fused(acc, cur, wr, wc, fr, fq, lds, wid, lane); S.done(cur); }
#undef PG8_SA
#undef PG8_SB
#undef PG8_STAGE
#undef PG8_LDA
#undef PG8_LDB
#undef PG8_MMA
#undef PG8_WAIT_V
#undef PG8_WAIT_L
#undef PG8_BAR
#undef PG8_SCHED
}
}
constexpr int NWAVES = 8;
constexpr int D = 1024, MP = 16384, MS = 1024, M = MP + MS;
constexpr int TP = 2048, NBP = 8, TS = 8, NBS = 128, PAST = 16384;
constexpr int INW = 4096, DFF = 2816, UPW = 5632, HD = 128, NH = 4;
constexpr int NHALF = 2, UPH_W = UPW / NHALF;
constexpr size_t MiB = 1u << 20, KiB = 1024;
constexpr size_t WS_CTL = 0, CTL_ZERO_BYTES = 320 * KiB;
constexpr size_t WS_SS2 = 64 * KiB, WS_SS3 = 192 * KiB;
constexpr size_t WS_WIN = 1 * MiB, WS_WOUT = 9 * MiB, WS_WUP = 11 * MiB, WS_WDN = 22 * MiB;
constexpr size_t WS_ROPE = 28 * MiB;
constexpr size_t WS_SS1 = 30 * MiB;
constexpr size_t WS_LB = 30 * MiB + 96 * KiB;
constexpr size_t WS_DVP = 30 * MiB + 128 * KiB;
constexpr size_t WS_DVS = 30 * MiB + 640 * KiB;
constexpr size_t WS_XB = 32 * MiB;
constexpr size_t WS_PROJ = 66 * MiB;
constexpr size_t WS_OHAT = 202 * MiB;
constexpr size_t WS_UPH = 66 * MiB, WS_ACT = 160 * MiB;
constexpr size_t WS_END = 256 * MiB;
static_assert(WS_WDN + (size_t)D * DFF * 2 <= WS_ROPE && WS_ROPE + 2056 * 64 * 8 <= WS_SS1 && WS_SS1 + M * 4 <= WS_XB && WS_XB + (size_t)M * D * 2 <= WS_PROJ, "ws map 1");
static_assert(WS_PROJ + (size_t)M * INW * 2 <= WS_OHAT && WS_OHAT + (size_t)M * D * 2 <= WS_END && WS_UPH + (size_t)M * UPH_W * 2 <= WS_ACT && WS_ACT + (size_t)M * DFF * 2 <= WS_END, "ws map 2");
constexpr int CW_TMO = 0, CW_CODE = 1, CW_BAR = 4096;
constexpr int RING_OFF = 0, RING_BYTES = 131072;
constexpr int LDSCTL_OFF = RING_BYTES, MISC_OFF = LDSCTL_OFF + 320;
constexpr int LDS_BYTES = 163840;
constexpr int RQK_OFF = 0, RV_OFF = 98304, RP_OFF = MISC_OFF + 128, RP_STRIDE = 144, RP_BYTES = 64 * RP_STRIDE, RSTAT_OFF = RP_OFF + 2 * RP_BYTES, RSTAT_BYTES = 4096, RDVEC_OFF = RSTAT_OFF + 2 * RSTAT_BYTES, R_END = RDVEC_OFF + 1536;
static_assert(RP_OFF % 16 == 0 && R_END <= LDS_BYTES, "LDS map");
#define GAS __attribute__((address_space(1)))
#define LAS __attribute__((address_space(3)))
typedef unsigned short bf16;
typedef unsigned v4u __attribute__((ext_vector_type(4)));
typedef unsigned v2u __attribute__((ext_vector_type(2)));
typedef float f32x4 __attribute__((ext_vector_type(4)));
typedef GAS unsigned gu32;
#define RLX_AGENT __ATOMIC_RELAXED, __HIP_MEMORY_SCOPE_AGENT
#define LDS_WAIT() asm volatile("s_waitcnt lgkmcnt(0)" ::: "memory")
#define VM_WAIT() asm volatile("s_waitcnt vmcnt(0)" ::: "memory")
__device__ __forceinline__ unsigned f2bf(float f) { unsigned u = __builtin_bit_cast(unsigned, f); return (u + 0x7fffu + ((u >> 16) & 1u)) >> 16; }
__device__ __forceinline__ unsigned pk2(float lo, float hi) { return f2bf(lo) | (f2bf(hi) << 16); }
__device__ __forceinline__ float bf2f(unsigned short h) { return __builtin_bit_cast(float, (unsigned)h << 16); }
__device__ __forceinline__ float bflo(unsigned w) { return __builtin_bit_cast(float, w << 16); }
__device__ __forceinline__ float bfhi(unsigned w) { return __builtin_bit_cast(float, w & 0xffff0000u); }

#define XB_TMO      128
#define XB_XCNT(j)  (256  + 64 * (j))
#define XB_XSUB(j)  (1280 + 64 * (j))
#define XB_XGEN(j)  (2304 + 64 * (j))
#define XB_TOP      3328
#define XB_TOPGEN   3392
#define XCD_BAR_WORDS 3456
#define XB_SPIN_CAP (1u << 18)

__device__ __forceinline__ unsigned xb_ld(unsigned* p)              { return __hip_atomic_load(p, __ATOMIC_RELAXED, __HIP_MEMORY_SCOPE_AGENT); }
__device__ __forceinline__ unsigned xb_add(unsigned* p, unsigned v) { return __hip_atomic_fetch_add(p, v, __ATOMIC_RELAXED, __HIP_MEMORY_SCOPE_AGENT); }
__device__ __forceinline__ unsigned xb_xcc_id() { return (unsigned)__builtin_amdgcn_s_getreg((3 << 11) | 20) & 0xFu; }
#define XB_SPIN(cond, bar) do { unsigned _sp = 0; while (cond) { __builtin_amdgcn_s_sleep(1); \
    if ((++_sp & 255u) == 0u) { if (xb_ld(&(bar)[XB_TMO])) break; if (_sp > XB_SPIN_CAP) { atomicAdd(&(bar)[XB_TMO], 1u); break; } } } } while (0)

struct XcdBarrier {
    unsigned* bar; unsigned x;
    volatile LAS unsigned* st;
};

__device__ __forceinline__ XcdBarrier xcd_barrier_post(unsigned* bar, volatile LAS unsigned* st) {
    XcdBarrier b; b.bar = bar; b.x = xb_xcc_id(); b.st = st;
    if (threadIdx.x == 0) (void)xb_add(&bar[XB_XCNT(b.x)], 1u);
    return b;
}
__device__ __forceinline__ void xcd_barrier_complete(unsigned* bar, unsigned x, unsigned& nloc, unsigned& nx) {
    const unsigned G = gridDim.x * gridDim.y * gridDim.z;
    unsigned sum, cnt, mine, sp = 0u;
    for (;;) {
        sum = 0u; cnt = 0u; mine = 0u;
#pragma unroll
        for (unsigned j = 0; j < 16; ++j) { const unsigned c = xb_ld(&bar[XB_XCNT(j)]); sum += c; cnt += (c > 0u) ? 1u : 0u; mine = (j == x) ? c : mine; }
        if (sum == G) break;
        __builtin_amdgcn_s_sleep(1);
        if ((++sp & 255u) == 0u) { if (xb_ld(&bar[XB_TMO])) break; if (sp > XB_SPIN_CAP) { atomicAdd(&bar[XB_TMO], 1u); break; } }
    }
    nloc = mine > 0u ? mine : 1u; nx = cnt > 0u ? cnt : 1u;
}

__device__ __forceinline__ void xcd_barrier(const XcdBarrier& b) {
    asm volatile("s_waitcnt vmcnt(0)" ::: "memory");
    __syncthreads();
    if (threadIdx.x == 0) {
        unsigned* bar = b.bar;
        __builtin_amdgcn_s_waitcnt(0);
        unsigned nloc = b.st[0], nx = b.st[1];
        if (nloc == 0u) { xcd_barrier_complete(bar, b.x, nloc, nx); b.st[0] = nloc; b.st[1] = nx; }
        const unsigned old = xb_add(&bar[XB_XSUB(b.x)], 1u);
        const unsigned gen = old / nloc;
        if (old + 1u == (gen + 1u) * nloc) {
            __builtin_amdgcn_fence(__ATOMIC_RELEASE, "agent");
            asm volatile("s_waitcnt vmcnt(0)" ::: "memory");
            const unsigned og = xb_add(&bar[XB_TOP], 1u);
            const unsigned tg = og / nx;
            if (og + 1u == (tg + 1u) * nx) xb_add(&bar[XB_TOPGEN], 1u);
            else XB_SPIN(xb_ld(&bar[XB_TOPGEN]) == tg, bar);
            __builtin_amdgcn_fence(__ATOMIC_ACQUIRE, "agent");
            xb_add(&bar[XB_XGEN(b.x)], 1u);
            asm volatile("s_waitcnt vmcnt(0)" ::: "memory");
        } else {
            XB_SPIN(xb_ld(&bar[XB_XGEN(b.x)]) == gen, bar);
            __builtin_amdgcn_fence(__ATOMIC_ACQUIRE, "agent");
            asm volatile("s_waitcnt vmcnt(0)" ::: "memory");
        }
    }
    __syncthreads();
}
#ifndef PH_MASK
#define PH_MASK 127
#endif
#ifndef REP_MASK
#define REP_MASK 0
#endif
#define REPS(k) ((((REP_MASK) >> (k)) & 1) + 1)
#ifndef REP_ABL
#define REP_ABL 0
#endif
#ifndef REP_SEL
#define REP_SEL 3
#endif
__device__ __forceinline__ float wave_sum(float v) {
#pragma unroll
    for (int o = 1; o < 64; o <<= 1) v += __shfl_xor(v, o);
    return v;
}
__device__ __forceinline__ float silu_f(float x) { return x / (1.0f + expf(-x)); }
__device__ __forceinline__ void sincos_acc(double ang, float& c, float& s) {
    const double TWO_OVER_PI = 0.63661977236758134308, PIO2_HI = 1.57079632679489655800e+00, PIO2_LO = 6.12323399573676603587e-17;
    const double q = rint(ang * TWO_OVER_PI);
    double r = fma(-q, PIO2_HI, ang); r = fma(-q, PIO2_LO, r);
    const int n = ((int)q) & 3;
    const double z = r * r;
    const double S1 = -1.66666666666666324348e-01, S2 = 8.33333333332248946124e-03, S3 = -1.98412698298579493134e-04, S4 = 2.75573137070700676789e-06, S5 = -2.50507602534068634195e-08, S6 = 1.58969099521155010221e-10;
    const double C1 = 4.16666666666666019037e-02, C2 = -1.38888888888741095749e-03, C3 = 2.48015872894767294178e-05, C4 = -2.75573143513906633035e-07, C5 = 2.08757232129817482790e-09, C6 = -1.13596475577881948265e-11;
    const double sn = r + r * z * (S1 + z * (S2 + z * (S3 + z * (S4 + z * (S5 + z * S6)))));
    const double cs = 1.0 - 0.5 * z + z * z * (C1 + z * (C2 + z * (C3 + z * (C4 + z * (C5 + z * C6)))));
    double sv, cv;
    if (n == 0) { sv = sn; cv = cs; } else if (n == 1) { sv = cs; cv = -sn; } else if (n == 2) { sv = -sn; cv = -cs; } else { sv = -cs; cv = sn; }
    c = (float)cv; s = (float)sv;
}
__device__ __forceinline__ int up_col_map(int n) { const int g = n >= DFF ? 1 : 0, ch = n - g * DFF; return (ch >> 7) * 256 + g * 128 + (ch & 127); }
__device__ __forceinline__ int in_col_map(int n) {
    const int grp = n >> 11, part = (n >> 9) & 3, h = (n >> 7) & 3, c = n & 127, hp = grp * 4 + h;
    if (part >= 2) return (2 * hp + 1) * 256 + (part - 2) * 128 + c;
    if (grp == 0) return (2 * hp) * 256 + part * 128 + c;
    return (2 * hp) * 256 + (c >> 6) * 128 + part * 64 + (c & 63);
}
template <int MAPMODE>
__device__ __forceinline__ void p0_transpose_item(const float* W, int K, int N, bf16* WT, const float* kscale, LAS float* scr, int item, int lane) {
    const int nblk = N / 32, kb = item / nblk, nb = item % nblk, k0 = 64 * kb, n0 = 32 * nb;
#pragma unroll 8
    for (int i = 0; i < 32; ++i) { const int kk = 2 * i + (lane >> 5); const float sc = kscale ? kscale[k0 + kk] : 1.0f; scr[kk * 33 + (lane & 31)] = W[(size_t)(k0 + kk) * N + n0 + (lane & 31)] * sc; }
    LDS_WAIT(); asm volatile("" ::: "memory");
    const int c = lane & 7;
    const int r0 = MAPMODE == 1 ? up_col_map(n0) : MAPMODE == 2 ? in_col_map(n0) : n0;
#pragma unroll
    for (int j = 0; j < 4; ++j) { const int n = (lane >> 3) + 8 * j; const LAS float* s = scr + (8 * c) * 33 + n;
        v4u o; o.x = pk2(s[0 * 33], s[1 * 33]); o.y = pk2(s[2 * 33], s[3 * 33]); o.z = pk2(s[4 * 33], s[5 * 33]); o.w = pk2(s[6 * 33], s[7 * 33]);
        *(GAS v4u*)(WT + (size_t)(r0 + n) * K + k0 + 8 * c) = o; }
    LDS_WAIT(); asm volatile("" ::: "memory");
}
__device__ __forceinline__ void x_row_to_bf16(const float* xrow, bf16* orow, float* ss, int lane) {
    const GAS f32x4* xr = (const GAS f32x4*)xrow + lane;
    f32x4 v[4]; float s = 0.f;
#pragma unroll
    for (int j = 0; j < 4; ++j) { v[j] = xr[64 * j]; s += (v[j].x * v[j].x + v[j].y * v[j].y) + (v[j].z * v[j].z + v[j].w * v[j].w); }
    s = wave_sum(s);
    if (lane == 0) *ss = s;
    GAS unsigned long long* o8 = (GAS unsigned long long*)orow + lane;
#pragma unroll
    for (int j = 0; j < 4; ++j) o8[64 * j] = (unsigned long long)pk2(v[j].x, v[j].y) | ((unsigned long long)pk2(v[j].z, v[j].w) << 32);
}

typedef short bf16x8 __attribute__((ext_vector_type(8)));
typedef short s16x4 __attribute__((ext_vector_type(4)));
template <int CTRL> __device__ __forceinline__ float dppf(float x) { return __builtin_bit_cast(float, __builtin_amdgcn_update_dpp(0, __builtin_bit_cast(int, x), CTRL, 0xf, 0xf, true)); }
__device__ __forceinline__ float row16_sum(float x) { x += dppf<0xB1>(x); x += dppf<0x4E>(x); x += dppf<0x141>(x); x += dppf<0x140>(x); return x; }
__device__ __forceinline__ unsigned off_b(unsigned row, unsigned ch) { return 2048u * (row >> 3) + 512u * (ch >> 2) + 64u * (row & 7) + 16u * ((ch & 3) ^ ((row >> 2) & 3)); }
__device__ __forceinline__ unsigned row_read_addr_16(unsigned lane, unsigned rb, unsigned s) { return off_b((lane & 15) + 16 * rb, 4 * s + (lane >> 4)); }
__device__ __forceinline__ unsigned tr_read_addr_16(unsigned lane, unsigned c, unsigned ks, unsigned t) {
    const unsigned g = lane >> 4, q = (lane & 15) >> 2, p = lane & 3; return off_b(32 * ks + 8 * g + 4 * t + q, 2 * c + (p >> 1)) + 8 * (p & 1); }
__device__ __forceinline__ s16x4 lds_tr(LAS unsigned char* p) { return __builtin_amdgcn_ds_read_tr16_b64_v4i16((LAS s16x4*)p); }
__device__ __forceinline__ bf16x8 cat8(s16x4 a, s16x4 b) { bf16x8 r; r[0] = a[0]; r[1] = a[1]; r[2] = a[2]; r[3] = a[3]; r[4] = b[0]; r[5] = b[1]; r[6] = b[2]; r[7] = b[3]; return r; }
__device__ __forceinline__ bf16x8 pack8(f32x4 a, f32x4 b) { v4u w; w.x = pg8::cvt_pk_bf16(a[0], a[1]); w.y = pg8::cvt_pk_bf16(a[2], a[3]); w.z = pg8::cvt_pk_bf16(b[0], b[1]); w.w = pg8::cvt_pk_bf16(b[2], b[3]); return __builtin_bit_cast(bf16x8, w); }
#define RBAR() do { asm volatile("s_waitcnt lgkmcnt(0)" ::: "memory"); __builtin_amdgcn_s_barrier(); asm volatile("" ::: "memory"); } while (0)

template <bool RET, bool SMP, int ABL = 0>
__device__ __forceinline__ void rec_core(LAS unsigned char* lds, const bf16* RB, const float* DV, const float* normw, const float* s_in, float* s_out, bf16* OHAT, bf16* dummy, int h, int first, int stride, int count) {
    constexpr int NT = SMP ? 1 : 4, NKS = SMP ? 1 : 2, NQK = SMP ? 1 : 4, NV = SMP ? 1 : 2;
    int tid = threadIdx.x; asm volatile("" : "+v"(tid));
    const int w = __builtin_amdgcn_readfirstlane(tid >> 6), l = tid & 63, g = l >> 4, c16 = l & 15;
    const int hp = (RET ? 4 : 0) + h;
    const float dconst = RET ? exp2f((SMP ? 8.0f : 64.0f) * log2f(1.0f - exp2f(-5.0f - (float)h))) : 1.0f;
    const f32x4 nw = *(const f32x4*)(normw + 16 * w + 4 * g);
    const unsigned q_ = c16 >> 2, p_l = c16 & 3, p1_ = p_l >> 1;
    unsigned KB[2][2], VB[2], QB[2];
#pragma unroll
    for (int t = 0; t < 2; ++t) {
#pragma unroll
        for (int ib = 0; ib < 2; ++ib) KB[t][ib] = 2048u * g + 64u * q_ + 8u * (p_l & 1) + 256u * t + 32u * (ib ^ (g & 1)) + 16u * (p1_ ^ t);
        VB[t] = 2048u * g + 64u * q_ + 8u * (p_l & 1) + 256u * t + 32u * ((w & 1) ^ (g & 1)) + 16u * (p1_ ^ t) + 512u * (w >> 1);
    }
    const unsigned RR = 2048u * (c16 >> 3) + 64u * (c16 & 7) + 16u * (g ^ ((c16 >> 2) & 3));
#pragma unroll
    for (int e = 0; e < 2; ++e) QB[e] = 2048u * (c16 >> 3) + 64u * (c16 & 7) + 16u * ((2 * e + (g >> 1)) ^ ((c16 >> 2) & 3)) + 8u * (g & 1);
    const unsigned WQ = 2048u * (tid >> 8) + 512u * ((tid & 15) >> 2) + 64u * ((tid >> 5) & 7) + 16u * ((tid & 3) ^ ((tid >> 7) & 3)) + 16384u * ((tid & 31) >> 4);
    const unsigned WV = 2048u * (tid >> 7) + 512u * ((tid & 15) >> 2) + 64u * ((tid >> 4) & 7) + 16u * ((tid & 3) ^ ((tid >> 6) & 3));
    const unsigned PW = RP_STRIDE * c16 + 8u * g, PR = RP_STRIDE * c16 + 16u * g;
#define REC_ROW0(c) (SMP ? MP + (((first) + (c) * (stride)) >> 2) * TS : (first) * TP + (c) * 64)
#define REC_HEAD(c) (SMP ? (((first) + (c) * (stride)) & 3) : h)
    v4u pq[NQK], pv[NV]; v2u pg[NT]; f32x4 pfd = {0.f, 0.f, 0.f, 0.f};
    const bool ldq = SMP ? tid < 256 : true, ldv = SMP ? tid < 128 : true;
    const unsigned qoff = ((unsigned)(SMP ? (tid >> 5) & 7 : tid >> 5) * INW + (tid & 31) * 8) * 2u, voff = ((unsigned)(SMP ? (tid >> 4) & 7 : tid >> 4) * INW + 256 + (tid & 15) * 8) * 2u;
    const unsigned goff = ((unsigned)(SMP ? (c16 & 7) : c16) * INW + 384 + 16 * w + 4 * g) * 2u, ooff = (unsigned)(2 * w + (g >> 1)) * 256u + (unsigned)c16 * 16u + (g & 1) * 8u;
#define REC_UB(c) ((const char*)RB + ((size_t)REC_ROW0(c) * INW + (RET ? 2048 : 0) + REC_HEAD(c) * 512) * 2)
#define REC_LOADQK(c) do { { const char* ub_ = REC_UB(c); \
        _Pragma("unroll") for (int i_ = 0; i_ < NQK; ++i_) pq[i_] = *(const v4u*)(ub_ + (size_t)i_ * (16 * INW * 2) + qoff); } \
        if (!RET) pfd = *(const f32x4*)(DV + (SMP ? (size_t)((first) + (c) * (stride)) : (size_t)(((first) * 32 + (c)) * 4 + h)) * 128 + (tid & 31) * 4); } while (0)
#define REC_STOREQK(c) do { if (ldq) { _Pragma("unroll") for (int i_ = 0; i_ < NQK; ++i_) *(LAS v4u*)(lds + RQK_OFF + ((c) % 3) * 32768 + WQ + 4096 * i_) = pq[i_]; } \
        if (!RET && tid < 32) *(LAS f32x4*)(lds + RDVEC_OFF + ((c) % 3) * 512 + tid * 16) = pfd; } while (0)
#define REC_LOADV(c) do { { const char* ub_ = REC_UB(c); \
        _Pragma("unroll") for (int i_ = 0; i_ < NV; ++i_) pv[i_] = *(const v4u*)(ub_ + (size_t)i_ * (32 * INW * 2) + voff); } } while (0)
#define REC_STOREV(c) do { if (ldv) { _Pragma("unroll") for (int i_ = 0; i_ < NV; ++i_) *(LAS v4u*)(lds + RV_OFF + ((c) & 1) * 16384 + WV + 8192 * i_) = pv[i_]; } } while (0)
#define REC_LOADG(c) do { const char* ub_ = REC_UB(c); \
        _Pragma("unroll") for (int ti_ = 0; ti_ < NT; ++ti_) pg[ti_] = *(const v2u*)(ub_ + (size_t)ti_ * (16 * INW * 2) + goff); } while (0)
#define REC_PTILE(slot, pb, ti, si) do { f32x4 a_ = {0.f, 0.f, 0.f, 0.f}; \
        _Pragma("unroll") for (int ks_ = 0; ks_ < 4; ++ks_) { const bf16x8 ak_ = *(const LAS bf16x8*)(lds + RQK_OFF + (slot) * 32768 + 16384 + RR + 4096 * (si) + 512 * ks_); \
            const bf16x8 bq_ = *(const LAS bf16x8*)(lds + RQK_OFF + (slot) * 32768 + RR + 4096 * (ti) + 512 * ks_); a_ = __builtin_amdgcn_mfma_f32_16x16x32_bf16(ak_, bq_, a_, 0, 0, 0); } \
        if ((si) == (ti)) { _Pragma("unroll") for (int r_ = 0; r_ < 4; ++r_) a_[r_] = (4 * g + r_ <= c16) ? a_[r_] : 0.f; } \
        v2u pw_; pw_.x = pg8::cvt_pk_bf16(a_[0], a_[1]); pw_.y = pg8::cvt_pk_bf16(a_[2], a_[3]); \
        *(LAS v2u*)(lds + RP_OFF + (pb) * RP_BYTES + PW + 2304 * (ti) + 32 * (si)) = pw_; } while (0)
#define REC_PHASE1(slot, pb) do { if (SMP) { if (w == 0) REC_PTILE(slot, pb, 0, 0); } else { switch (w) { case 0: REC_PTILE(slot, pb, 0, 0); REC_PTILE(slot, pb, 3, 2); break; case 1: REC_PTILE(slot, pb, 1, 0); REC_PTILE(slot, pb, 3, 3); break; \
        case 2: REC_PTILE(slot, pb, 1, 1); break; case 3: REC_PTILE(slot, pb, 2, 0); break; case 4: REC_PTILE(slot, pb, 2, 1); break; case 5: REC_PTILE(slot, pb, 2, 2); break; case 6: REC_PTILE(slot, pb, 3, 0); break; default: REC_PTILE(slot, pb, 3, 1); break; } } } while (0)
    f32x4 S[8], Sn[8];
    if (tid < 256) { const int t = tid >> 2, q4 = tid & 3; const int ti = t >> 4; if (ti == 0 || ti == 2) { *(LAS v2u*)(lds + RP_OFF + t * RP_STRIDE + (16 * (ti + 1) + 4 * q4) * 2) = (v2u){0u, 0u}; *(LAS v2u*)(lds + RP_OFF + RP_BYTES + t * RP_STRIDE + (16 * (ti + 1) + 4 * q4) * 2) = (v2u){0u, 0u}; } }
    if (SMP) { for (int q = tid; q < 8 * 24 * 16; q += 512) { const int slot = q / (24 * 16), rr = 8 + (q / 16) % 24, ch = q & 15;
            const int base = slot < 6 ? RQK_OFF + (slot >> 1) * 32768 + (slot & 1) * 16384 : RV_OFF + (slot - 6) * 16384; *(LAS v4u*)(lds + base + off_b(rr, ch)) = (v4u){0u, 0u, 0u, 0u}; } }
    if (!SMP) {
#pragma unroll
        for (int i = 0; i < 8; ++i) S[i] = (f32x4){0.f, 0.f, 0.f, 0.f};
    }
#define REC_LOADS(dst, c) do { const float* p_ = s_in + (size_t)((first) + (c) * (stride)) * HD * HD + (size_t)(4 * g) * HD + 16 * w + c16; \
        _Pragma("unroll") for (int i_ = 0; i_ < 8; ++i_) { _Pragma("unroll") for (int r_ = 0; r_ < 4; ++r_) dst[i_][r_] = p_[(16 * i_ + r_) * HD]; } } while (0)
    const int last = count - 1; const bool never = count > (1 << 20);
#define ABL_ON(bit) (!(ABL & (bit)) || never)
    REC_LOADQK(0); REC_LOADV(0); REC_STOREQK(0); REC_STOREV(0);
    { const int c1 = last < 1 ? last : 1; REC_LOADQK(c1); REC_STOREQK(1); }
    if (SMP) REC_LOADS(S, 0);
    RBAR();
    REC_PHASE1(0, 0);
    RBAR();
#pragma clang loop unroll(disable)
    for (int c = 0; c < count; ++c) {
        const int c1 = c + 1 < count ? c + 1 : last, c2 = c + 2 < count ? c + 2 : last;
        if (ABL_ON(4)) { REC_LOADQK(c2); REC_LOADV(c1); REC_LOADG(c); }
        if (SMP) REC_LOADS(Sn, c1);
        LAS unsigned char* qb = lds + RQK_OFF + (c % 3) * 32768; LAS unsigned char* vb = lds + RV_OFF + (c & 1) * 16384; LAS unsigned char* pb = lds + RP_OFF + (c & 1) * RP_BYTES;
        const float dcur = (RET && SMP) ? exp2f(8.0f * log2f(1.0f - exp2f(-5.0f - (float)REC_HEAD(c)))) : dconst;
        bf16x8 bv[NKS];
#pragma unroll
        for (int ks = 0; ks < NKS; ++ks) bv[ks] = cat8(lds_tr(vb + VB[0] + 8192 * ks), lds_tr(vb + VB[1] + 8192 * ks));
        f32x4 O[NT];
#pragma unroll
        for (int ti = 0; ti < NT; ++ti) O[ti] = (f32x4){0.f, 0.f, 0.f, 0.f};
        if (ABL_ON(16))
#pragma unroll
        for (int k4 = 0; k4 < 4; ++k4) {
            const bf16x8 as = pack8(S[2 * k4], S[2 * k4 + 1]);
#pragma unroll
            for (int ti = 0; ti < NT; ++ti) {
                const s16x4 lo = *(const LAS s16x4*)(qb + QB[0] + 4096 * ti + 512 * k4), hi = *(const LAS s16x4*)(qb + QB[1] + 4096 * ti + 512 * k4);
                O[ti] = __builtin_amdgcn_mfma_f32_16x16x32_bf16(as, cat8(lo, hi), O[ti], 0, 0, 0); }
        }
#pragma unroll
        for (int ti = 0; ti < NT; ++ti)
#pragma unroll
            for (int ks = 0; ks < NKS; ++ks) if (ks <= (ti >> 1)) {
                const bf16x8 bp = *(const LAS bf16x8*)(pb + PR + 2304 * ti + 64 * ks);
                O[ti] = __builtin_amdgcn_mfma_f32_16x16x32_bf16(bv[ks], bp, O[ti], 0, 0, 0); }
        if (ABL_ON(8))
#pragma unroll
        for (int i = 0; i < 8; ++i) {
#pragma unroll
            for (int ks = 0; ks < NKS; ++ks) { const bf16x8 ak = cat8(lds_tr(qb + 16384 + KB[0][i & 1] + 8192 * ks + 512 * (i >> 1)), lds_tr(qb + 16384 + KB[1][i & 1] + 8192 * ks + 512 * (i >> 1)));
                S[i] = __builtin_amdgcn_mfma_f32_16x16x32_bf16(ak, bv[ks], S[i], 0, 0, 0); }
            if (RET) S[i] = S[i] * dcur; else S[i] = S[i] * *(const LAS f32x4*)(lds + RDVEC_OFF + (c % 3) * 512 + (16 * i + 4 * g) * 4);
            if (i & 1) __builtin_amdgcn_sched_barrier(0);
        }
        if (SMP) {
            float* p_ = s_out + (size_t)(first + c * stride) * HD * HD + (size_t)(4 * g) * HD + 16 * w + c16;
#pragma unroll
            for (int i = 0; i < 8; ++i) {
#pragma unroll
                for (int r = 0; r < 4; ++r) p_[(16 * i + r) * HD] = S[i][r]; }
#pragma unroll
            for (int i = 0; i < 8; ++i) S[i] = Sn[i];
        }
        { LAS float* st = (LAS float*)(lds + RSTAT_OFF + (c & 1) * RSTAT_BYTES);
#pragma unroll
          for (int ti = 0; ti < NT; ++ti) { const f32x4 o = O[ti]; float s2 = (o[0] * o[0] + o[1] * o[1]) + (o[2] * o[2] + o[3] * o[3]), s1 = (o[0] + o[1]) + (o[2] + o[3]);
              s2 += __shfl_xor(s2, 16); s2 += __shfl_xor(s2, 32); if (RET) { s1 += __shfl_xor(s1, 16); s1 += __shfl_xor(s1, 32); }
              if (g == 0 && ABL_ON(1)) { st[512 + (16 * ti + c16) * 8 + w] = s2; if (RET) st[(16 * ti + c16) * 8 + w] = s1; } } }
        if (ABL_ON(32)) REC_PHASE1((c + 1) % 3, (c + 1) & 1);
        REC_STOREQK(c + 2);
        REC_STOREV(c + 1);
        RBAR();
        { LAS float* st = (LAS float*)(lds + RSTAT_OFF + (c & 1) * RSTAT_BYTES);
          const int row0_ = REC_ROW0(c);
          char* ob = (char*)OHAT + ((size_t)(row0_ >> 4) * 128 + (RET ? 64 : 0) + REC_HEAD(c) * 16) * 256 + (SMP ? (row0_ & 8) * 16 : 0);
          if (SMP && c16 >= 8) ob = (char*)dummy;
#pragma unroll
          for (int ti = 0; ti < NT; ++ti) {
              const f32x4 a2 = *(const LAS f32x4*)(st + 512 + (16 * ti + c16) * 8), b2 = *(const LAS f32x4*)(st + 512 + (16 * ti + c16) * 8 + 4);
              const float m2 = ((a2[0] + a2[1]) + (a2[2] + a2[3])) + ((b2[0] + b2[1]) + (b2[2] + b2[3])); float mu = 0.f, rs;
              if (RET) { const f32x4 a1 = *(const LAS f32x4*)(st + (16 * ti + c16) * 8), b1 = *(const LAS f32x4*)(st + (16 * ti + c16) * 8 + 4);
                  mu = (((a1[0] + a1[1]) + (a1[2] + a1[3])) + ((b1[0] + b1[1]) + (b1[2] + b1[3]))) * (1.0f / HD); rs = __builtin_amdgcn_rsqf(fmaxf(m2 * (1.0f / HD) - mu * mu, 0.f) + 1e-6f); }
              else rs = __builtin_amdgcn_rsqf(m2 * (1.0f / HD) + 1e-6f);
              const f32x4 o = (O[ti] - mu) * rs * nw;
              v2u ow; ow.x = pg8::cvt_pk_bf16(o[0] * bflo(pg[ti].x), o[1] * bfhi(pg[ti].x)); ow.y = pg8::cvt_pk_bf16(o[2] * bflo(pg[ti].y), o[3] * bfhi(pg[ti].y));
              if (ABL_ON(2)) *(v2u*)(ob + (size_t)ti * (128 * 256) + ooff) = ow; } }
    }
    if (!SMP) {
#pragma unroll
        for (int i = 0; i < 8; ++i)
#pragma unroll
            for (int r = 0; r < 4; ++r) s_out[(size_t)(16 * i + 4 * g + r) * HD + 16 * w + c16] = S[i][r];
    }
    RBAR();
#undef ABL_ON
#undef REC_ROW0
#undef REC_UB
#undef REC_HEAD
#undef REC_LOADQK
#undef REC_STOREQK
#undef REC_LOADV
#undef REC_STOREV
#undef REC_LOADG
#undef REC_LOADS
#undef REC_PTILE
#undef REC_PHASE1
}

struct Args { const float* in[17]; float* out; unsigned char* ws; };
__global__ void __launch_bounds__(NWAVES * 64, 2) hyb_fwd(Args args) {
    extern __shared__ __attribute__((aligned(16))) unsigned char lds_raw[];
    LAS unsigned char* lds = (LAS unsigned char*)lds_raw;
    volatile LAS unsigned* MISC = (volatile LAS unsigned*)(lds + MISC_OFF);
    const int tid = threadIdx.x, lane = tid & 63, wave = __builtin_amdgcn_readfirstlane(tid >> 6);
    const int G = gridDim.x; const int bx = blockIdx.x; const int vcu = (G % 8 == 0) ? (bx % 8) * (G / 8) + bx / 8 : bx;
    unsigned char* ws = args.ws;
    gu32* ctl = (gu32*)(ws + WS_CTL);
    const float* x_prompt = args.in[0]; const float* x_sample = args.in[1]; const float* state_hgrn = args.in[2]; const float* state_ret = args.in[3]; const float* state_conv = args.in[4];
    const float* w_norm1 = args.in[5]; const float* w_in = args.in[6]; const float* hgrn_lb = args.in[7]; const float* hgrn_norm_w = args.in[8]; const float* ret_norm_w = args.in[9];
    const float* w_out = args.in[10]; const float* w_norm2 = args.in[11]; const float* w_ffn_in = args.in[12]; const float* conv_w = args.in[13]; const float* conv_b = args.in[14];
    const float* w_ffn_out = args.in[15]; const float* w_norm_f = args.in[16];
    float* out_y = args.out;
    float* out_hgp = out_y + (size_t)M * D; float* out_rtp = out_hgp + (size_t)NBP * NH * HD * HD; float* out_cvp = out_rtp + (size_t)NBP * NH * HD * HD;
    float* out_hgs = out_cvp + (size_t)NBP * 2 * UPW; float* out_rts = out_hgs + (size_t)NBS * NH * HD * HD; float* out_cvs = out_rts + (size_t)NBS * NH * HD * HD;
    bf16* WIN = (bf16*)(ws + WS_WIN); bf16* WOUT = (bf16*)(ws + WS_WOUT); bf16* WUP = (bf16*)(ws + WS_WUP); bf16* WDN = (bf16*)(ws + WS_WDN);
    float2* ROPE = (float2*)(ws + WS_ROPE); float* LBT = (float*)(ws + WS_LB); float* DVP = (float*)(ws + WS_DVP); float* DVS = (float*)(ws + WS_DVS); float* SS1 = (float*)(ws + WS_SS1); float* SS2 = (float*)(ws + WS_SS2); float* SS3 = (float*)(ws + WS_SS3);
    bf16* XB = (bf16*)(ws + WS_XB); bf16* PROJ = (bf16*)(ws + WS_PROJ); bf16* OHAT = (bf16*)(ws + WS_OHAT); bf16* UPH = (bf16*)(ws + WS_UPH); bf16* ACT = (bf16*)(ws + WS_ACT);

    for (int u = tid; u < (LDS_BYTES - LDSCTL_OFF) / 4; u += NWAVES * 64) ((LAS unsigned*)(lds + LDSCTL_OFF))[u] = 0u;
    __syncthreads();
    XcdBarrier bar = xcd_barrier_post((unsigned*)(ctl + CW_BAR), MISC + 8);
    const int gw = vcu * NWAVES + wave, NGW = G * NWAVES;

#if PH_MASK & 1
    _Pragma("unroll") for (int rep_ = 0; rep_ < REPS(0); ++rep_) {
    {
        LAS float* scr = (LAS float*)(lds + RING_OFF + wave * 16384);
        constexpr int I_IN = (D / 64) * (INW / 32), I_OUT = (D / 64) * (D / 32), I_UP = (D / 64) * (UPW / 32), I_DN = (DFF / 64) * (D / 32);
        constexpr int NITEMS = I_IN + I_OUT + I_UP + I_DN;
        for (int it = gw; it < NITEMS; it += NGW) {
            int r = it;
            if (r < I_IN) { p0_transpose_item<2>(w_in, D, INW, WIN, w_norm1, scr, r, lane); continue; } r -= I_IN;
            if (r < I_OUT) { p0_transpose_item<0>(w_out, D, D, WOUT, nullptr, scr, r, lane); continue; } r -= I_OUT;
            if (r < I_UP) { p0_transpose_item<1>(w_ffn_in, D, UPW, WUP, w_norm2, scr, r, lane); continue; } r -= I_UP;
            p0_transpose_item<0>(w_ffn_out, DFF, D, WDN, nullptr, scr, r, lane);
        }
        for (int m = gw; m < M; m += NGW) x_row_to_bf16(m < MP ? x_prompt + (size_t)m * D : x_sample + (size_t)(m - MP) * D, XB + (size_t)m * D, SS1 + m, lane);
        if (bx == 0) { const float a0 = hgrn_lb[tid], a1 = hgrn_lb[512 + tid]; const float mx = fmaxf(a0, a1), e0 = expf(a0 - mx), e1 = expf(a1 - mx); LBT[tid] = e0 / (e0 + e1); }
        for (int i = vcu * 512 + tid; i < 2056 * 64; i += G * 512) {
            const int p = i >> 6, j = i & 63; const int pos = p < 2048 ? p : PAST + (p - 2048);
            const double inv = exp2(-(double)j * (13.287712379549449 / 64.0));
            float c, s; sincos_acc((double)pos * inv, c, s); ROPE[i] = make_float2(c, s);
        }
    }
    xcd_barrier(bar);

    }
#endif
#if PH_MASK & 2
    _Pragma("unroll") for (int rep_ = 0; rep_ < REPS(1); ++rep_) {
    {
        pg8::Gemm g{XB, WIN, M, INW, D}; pg8::StaticOrder S; S.init(M, INW, G, bx);
        pg8::EpiPrep E{PROJ, SS1, LBT, (const float*)ROPE, DVP, DVS};
        pg8::gemm_phase<pg8::EpiPrep, pg8::StaticOrder, true, true>(lds + RING_OFF, g, S, E);
    }
    xcd_barrier(bar);

    }
#endif
#if PH_MASK & 4
    _Pragma("unroll") for (int rep_ = 0; rep_ < REPS(2); ++rep_) {
    {
        if (bx < 64) { if (rep_ == 0) {
            const int b = (bx >> 2) & 7, h = bx & 3;
            if (bx < 32) rec_core<false, false>(lds, PROJ, DVP, hgrn_norm_w, nullptr, out_hgp + (size_t)(b * 4 + h) * HD * HD, OHAT, (bf16*)SS1, h, b, 0, 32);
            else rec_core<true, false>(lds, PROJ, DVP, ret_norm_w, nullptr, out_rtp + (size_t)(b * 4 + h) * HD * HD, OHAT, (bf16*)SS1, h, b, 0, 32);
        } else if (REP_SEL & 1) {
            const int b = (bx >> 2) & 7, h = bx & 3; float* sdum = (float*)(ws + 236 * MiB) + (size_t)bx * HD * HD;
            if (bx < 32) rec_core<false, false, REP_ABL>(lds, PROJ, DVP, hgrn_norm_w, nullptr, sdum, XB, (bf16*)SS1, h, b, 0, 32);
            else rec_core<true, false, REP_ABL>(lds, PROJ, DVP, ret_norm_w, nullptr, sdum, XB, (bf16*)SS1, h, b, 0, 32);
        } } else if (rep_ == 0 || (REP_SEL & 2)) {
            const int idx = bx - 64, nw_ = G - 64;
            const int cnt = idx < 512 ? (512 - idx + nw_ - 1) / nw_ : 0;
            if (cnt > 0) { rec_core<false, true>(lds, PROJ, DVS, hgrn_norm_w, state_hgrn, out_hgs, OHAT, (bf16*)SS1, 0, idx, nw_, cnt);
                           rec_core<true, true>(lds, PROJ, DVS, ret_norm_w, state_ret, out_rts, OHAT, (bf16*)SS1, 0, idx, nw_, cnt); }
        }
    }
    xcd_barrier(bar);

    }
#endif
#if PH_MASK & 8
    {
        pg8::Gemm g{OHAT, WOUT, M, D, D}; pg8::StaticOrder S; S.init(M, D, G, bx);
        pg8::EpiResF32 E{x_prompt, x_sample, out_y, XB, SS2};
        pg8::gemm_phase<pg8::EpiResF32, pg8::StaticOrder, true, true, true>(lds + RING_OFF, g, S, E);
    }
    xcd_barrier(bar);

#endif
#if PH_MASK & 16
    _Pragma("unroll") for (int rep_ = 0; rep_ < REPS(4); ++rep_) {
    for (int half = 0; half < NHALF; ++half) {
        {
            pg8::Gemm g{XB, WUP + (size_t)half * UPH_W * D, M, UPH_W, D}; pg8::StaticOrder S; S.init(M, UPH_W, G, bx);
            pg8::EpiScaleBf16 E{UPH, UPH_W, SS2};
            pg8::gemm_phase<pg8::EpiScaleBf16, pg8::StaticOrder, true, true>(lds + RING_OFF, g, S, E);
        }
        xcd_barrier(bar);
        for (int i = vcu * 512 + tid; i < M * 176; i += G * 512) {
            const int row = i / 176, g8 = i - row * 176, pnl = g8 >> 4, c8 = (g8 & 15) * 8, ch = (half * 11 + pnl) * 128 + c8;
            const bool smp = row >= MP; const int rr = smp ? row - MP : row, T = smp ? TS : TP, b = smp ? rr >> 3 : rr >> 11, t = rr & (T - 1);
            float cu[8], cg[8];
#pragma unroll
            for (int e = 0; e < 8; ++e) { cu[e] = conv_b[ch + e]; cg[e] = conv_b[DFF + ch + e]; }
#pragma unroll
            for (int j = 0; j < 3; ++j) {
                const int tt = t - 2 + j; float eu[8], eg[8];
                if (tt >= 0) { const bf16* p = UPH + (size_t)(row - 2 + j) * UPH_W + pnl * 256 + c8; const v4u a = *(const v4u*)p, bb = *(const v4u*)(p + 128);
#pragma unroll
                    for (int e = 0; e < 4; ++e) { eu[2 * e] = bflo(a[e]); eu[2 * e + 1] = bfhi(a[e]); eg[2 * e] = bflo(bb[e]); eg[2 * e + 1] = bfhi(bb[e]); } }
                else if (smp) { const float* p = state_conv + (size_t)(b * 2 + tt + 2) * UPW + ch;
#pragma unroll
                    for (int e = 0; e < 8; ++e) { eu[e] = p[e]; eg[e] = p[DFF + e]; } }
                else {
#pragma unroll
                    for (int e = 0; e < 8; ++e) { eu[e] = 0.f; eg[e] = 0.f; } }
#pragma unroll
                for (int e = 0; e < 8; ++e) { cu[e] = fmaf(conv_w[j * UPW + ch + e], eu[e], cu[e]); cg[e] = fmaf(conv_w[j * UPW + DFF + ch + e], eg[e], cg[e]); }
                if (j == 2 && t >= T - 2) { float* cs = (smp ? out_cvs : out_cvp) + (size_t)(b * 2 + (t - (T - 2))) * UPW + ch;
#pragma unroll
                    for (int e = 0; e < 8; ++e) { cs[e] = eu[e]; cs[DFF + e] = eg[e]; } }
            }
            v4u o;
#pragma unroll
            for (int e = 0; e < 4; ++e) o[e] = pk2(silu_f(cg[2 * e]) * cu[2 * e], silu_f(cg[2 * e + 1]) * cu[2 * e + 1]);
            *(v4u*)(ACT + (size_t)row * DFF + ch) = o;
        }
        xcd_barrier(bar);
    }

    }
#endif
#if PH_MASK & 32
    {
        pg8::Gemm g{ACT, WDN, M, D, DFF}; pg8::StaticOrder S; S.init(M, D, G, bx);
        pg8::EpiResF32 E{out_y, out_y + (size_t)MP * D, out_y, nullptr, SS3};
        pg8::gemm_phase<pg8::EpiResF32, pg8::StaticOrder, true, true>(lds + RING_OFF, g, S, E);
    }
    xcd_barrier(bar);

#endif
#if PH_MASK & 64
    for (int m = gw; m < M; m += NGW) {
        const float r = 1.0f / sqrtf(SS3[m] * (1.0f / D) + 1e-6f);
        GAS f32x4* xr = (GAS f32x4*)(out_y + (size_t)m * D) + lane; const GAS f32x4* wf = (const GAS f32x4*)w_norm_f + lane;
#pragma unroll
        for (int j = 0; j < 4; ++j) { const f32x4 v = xr[64 * j], w = wf[64 * j]; xr[64 * j] = v * r * w; }
    }
#endif
}

extern "C" void kernel_launch(void* const* d_in, const int* in_sizes, int n_in, void* d_out, int out_size, void* d_ws, size_t ws_size, hipStream_t stream) {
    static int grid = 0;
    if (grid == 0) {
        if (n_in != 17 || ws_size < WS_END) { fprintf(stderr, "kernel_launch: unexpected inputs (n_in %d, ws %zu); nothing launched\n", n_in, ws_size); grid = -1; return; }
        int dev = 0, cus = 0, per_cu = 0;
        if (hipGetDevice(&dev) != hipSuccess || hipDeviceGetAttribute(&cus, hipDeviceAttributeMultiprocessorCount, dev) != hipSuccess) { grid = -1; return; }
        if (hipFuncSetAttribute((const void*)hyb_fwd, hipFuncAttributeMaxDynamicSharedMemorySize, LDS_BYTES) != hipSuccess) { fprintf(stderr, "kernel_launch: hipFuncSetAttribute failed\n"); grid = -1; return; }
        if (hipOccupancyMaxActiveBlocksPerMultiprocessor(&per_cu, (const void*)hyb_fwd, NWAVES * 64, LDS_BYTES) != hipSuccess || per_cu < 1)
            fprintf(stderr, "kernel_launch: note: occupancy query reports %d workgroups per CU\n", per_cu);
        (void)hipGetLastError();
        grid = cus;
    }
    if (grid < 0) return;
    if (hipMemsetAsync((char*)d_ws + WS_CTL, 0, CTL_ZERO_BYTES, stream) != hipSuccess) return;
    Args a{};
    for (int i = 0; i < 17; ++i) a.in[i] = (const float*)d_in[i];
    a.out = (float*)d_out; a.ws = (unsigned char*)d_ws;
    hipLaunchKernelGGL(hyb_fwd, dim3(grid), dim3(NWAVES * 64), LDS_BYTES, stream, a);
}
```

```cpp
#include <hip/hip_runtime.h>
#include <cstdio>
#include <cstdint>
namespace pg8 {
#define PG8_LAS __attribute__((address_space(3)))
typedef unsigned short bf16_t;
typedef short bf16x8 __attribute__((ext_vector_type(8)));
typedef float f32x4 __attribute__((ext_vector_type(4)));
typedef unsigned u32x4 __attribute__((ext_vector_type(4)));
typedef unsigned u32x2 __attribute__((ext_vector_type(2)));
constexpr int BM = 256, BK = 64, HALF = 128, HTB = HALF * BK * 2  , STAGE_BYTES = 8 * HTB, NXCD = 8, WGM = 8;

__host__ __device__ __forceinline__ int lds_byte(int r, int c) { const int st = (r >> 4) * 2 + (c >> 5), rr = r & 15, cc = c & 31, ob = rr * 64 + cc * 2; return st * 1024 + (ob ^ (((ob >> 9) & 1) << 5)); }
__host__ __device__ __forceinline__ void stage_rc(int b, int& R, int& C) { const int st = b / 1024, sb = b % 1024, swz = sb ^ (((sb >> 9) & 1) << 5); R = (st >> 1) * 16 + swz / 64; C = (st & 1) * 32 + (swz % 64) / 2; }
__host__ __device__ __forceinline__ int perm32(int rho) { const int n = rho >> 4, i = rho & 15; return 8 * (i >> 2) + 4 * n + (i & 3); }

struct Unit { int pm, pn; };
struct Gemm { const bf16_t* A; const bf16_t* Bt; int M, N, K; };

struct StaticOrder {
    int nM, nN, nwg, G, c;
    __host__ __device__ void init(int M, int N, int G_, int c_) { nM = M / BM; nN = N / BM; nwg = nM * nN; G = G_; c = c_; }
    __host__ __device__ bool next(int i, Unit& u) const {
        const long L = (long)i * G + c; if (L >= nwg) return false;
        int wgid = (int)L; { const int q = nwg / NXCD, r = nwg % NXCD, xcd = wgid % NXCD, off = wgid / NXCD; wgid = (xcd < r ? xcd * (q + 1) : r * (q + 1) + (xcd - r) * q) + off; }
        const int nig = WGM * nN, gid = wgid / nig, fm = gid * WGM, gsz = (nM - fm) < WGM ? (nM - fm) : WGM;
        u.pm = fm + ((wgid % nig) % gsz); u.pn = (wgid % nig) / gsz; return true;
    }
    __device__ __forceinline__ void a_ready(const Unit&) const {}
    __device__ __forceinline__ void done(const Unit&) const {}
};
typedef __bf16 bf16x2_t __attribute__((ext_vector_type(2)));
typedef float f32x2_t __attribute__((ext_vector_type(2)));
__device__ __forceinline__ unsigned cvt_pk_bf16(float lo, float hi) { const f32x2_t v = {lo, hi}; return __builtin_bit_cast(unsigned, __builtin_convertvector(v, bf16x2_t)); }
constexpr float RMS_EPS = 1e-6f;
struct EpiScaleBf16 {
    static constexpr bool PERM = true, AFTER_DRAIN = false;
    bf16_t* O; int ldc; const float* ss;
    __device__ __forceinline__ void operator()(const f32x4 (&acc)[2][2][4][2], const Unit& u, int wr, int wc, int fr, int fq) const {
        const int row0 = u.pm * BM + wr * 64 + fr, col0 = u.pn * BM + wc * 32 + 8 * fq;
#pragma unroll
        for (int ai = 0; ai < 2; ++ai)
#pragma unroll
            for (int m = 0; m < 4; ++m) { const int row = row0 + ai * HALF + m * 16; const float r = 1.0f / sqrtf(ss[row] * (1.0f / 1024.0f) + RMS_EPS);
                bf16_t* rowp = O + (size_t)row * ldc + col0;
#pragma unroll
                for (int bj = 0; bj < 2; ++bj) { const f32x4 v0 = acc[ai][bj][m][0] * r, v1 = acc[ai][bj][m][1] * r;
                    u32x4 w; w.x = cvt_pk_bf16(v0[0], v0[1]); w.y = cvt_pk_bf16(v0[2], v0[3]); w.z = cvt_pk_bf16(v1[0], v1[1]); w.w = cvt_pk_bf16(v1[2], v1[3]);
                    *(u32x4*)(rowp + bj * HALF) = w; } }
    }
};
struct EpiResF32 {
    static constexpr bool PERM = false, AFTER_DRAIN = false;
    const float* Xp; const float* Xs; float* out; bf16_t* xb; float* ss;
    __device__ __forceinline__ void operator()(const f32x4 (&acc)[2][2][4][2], const Unit& u, int wr, int wc, int fr, int fq) const {
        const int row0 = u.pm * BM + wr * 64 + fr, col0 = u.pn * BM + wc * 32 + 4 * fq;
        const float* X = u.pm < 64 ? Xp : Xs - (size_t)16384 * 1024;
#pragma unroll
        for (int ai = 0; ai < 2; ++ai)
#pragma unroll
            for (int m = 0; m < 4; ++m) { const int row = row0 + ai * HALF + m * 16; const size_t off = (size_t)row * 1024 + col0; float sq = 0.f;
#pragma unroll
                for (int bj = 0; bj < 2; ++bj)
#pragma unroll
                    for (int n = 0; n < 2; ++n) { const f32x4 x = *(const f32x4*)(X + off + bj * HALF + n * 16) + acc[ai][bj][m][n];
                        *(f32x4*)(out + off + bj * HALF + n * 16) = x; sq += (x[0] * x[0] + x[1] * x[1]) + (x[2] * x[2] + x[3] * x[3]);
                        if (xb) { u32x2 w; w.x = cvt_pk_bf16(x[0], x[1]); w.y = cvt_pk_bf16(x[2], x[3]); *(u32x2*)(xb + off + bj * HALF + n * 16) = w; } }
                sq += __shfl_xor(sq, 16); sq += __shfl_xor(sq, 32);
                if (fq == 0) atomicAdd(ss + row, sq); }
    }
};

__device__ __forceinline__ float fexp2(float x) { return __builtin_amdgcn_exp2f(x); }
__device__ __forceinline__ float flog2(float x) { return __builtin_amdgcn_logf(x); }
__device__ __forceinline__ float frcp(float x) { return __builtin_amdgcn_rcpf(x); }
__device__ __forceinline__ float fsigmoid(float x) { return frcp(1.0f + fexp2(-1.4426950408889634f * x)); }
struct EpiPrep {
    static constexpr bool PERM = true, AFTER_DRAIN = false;
    bf16_t* RB; const float* ss; const float* LB; const float* ROPE; float* DVP; float* DVS;
    __device__ __forceinline__ void operator()(const f32x4 (&acc)[2][2][4][2], const Unit& u, int wr, int wc, int fr, int fq) const {
        asm volatile("" : "+v"(fr), "+v"(fq));
        const int kind = u.pn & 1, hp = u.pn >> 1;
        const int row0 = u.pm * BM + wr * 64 + fr, cp = wc * 32 + 8 * fq;
        const bool smp = u.pm >= 64;
        float r[2][4];
#pragma unroll
        for (int ai = 0; ai < 2; ++ai)
#pragma unroll
            for (int m = 0; m < 4; ++m) r[ai][m] = 1.0f / sqrtf(ss[row0 + ai * HALF + m * 16] * (1.0f / 1024.0f) + RMS_EPS);
        bf16_t* base = RB + (size_t)row0 * 4096 + u.pn * BM + cp;
        if (kind == 1) {
#pragma unroll
            for (int ai = 0; ai < 2; ++ai)
#pragma unroll
                for (int m = 0; m < 4; ++m) { bf16_t* rowp = base + (size_t)(ai * HALF + m * 16) * 4096; const float rr = r[ai][m];
                    { const f32x4 v0 = acc[ai][0][m][0] * rr, v1 = acc[ai][0][m][1] * rr;
                      u32x4 w; w.x = cvt_pk_bf16(v0[0], v0[1]); w.y = cvt_pk_bf16(v0[2], v0[3]); w.z = cvt_pk_bf16(v1[0], v1[1]); w.w = cvt_pk_bf16(v1[2], v1[3]); *(u32x4*)rowp = w; }
                    { f32x4 v0 = acc[ai][1][m][0] * rr, v1 = acc[ai][1][m][1] * rr;
#pragma unroll
                      for (int e = 0; e < 4; ++e) { v0[e] = v0[e] * fsigmoid(v0[e]); v1[e] = v1[e] * fsigmoid(v1[e]); }
                      u32x4 w; w.x = cvt_pk_bf16(v0[0], v0[1]); w.y = cvt_pk_bf16(v0[2], v0[3]); w.z = cvt_pk_bf16(v1[0], v1[1]); w.w = cvt_pk_bf16(v1[2], v1[3]); *(u32x4*)(rowp + HALF) = w; } }
        } else if (hp < 4) {
            float lbv[8];
#pragma unroll
            for (int c = 0; c < 8; ++c) lbv[c] = LB[hp * 128 + cp + c];
#pragma unroll
            for (int ai = 0; ai < 2; ++ai) {
                unsigned Qp[4][4], Kp[4][4];
#pragma unroll
                for (int cpair = 0; cpair < 4; ++cpair) {
                    float qo[2][4], ko[2][4];
#pragma unroll
                    for (int cc = 0; cc < 2; ++cc) { const int c = 2 * cpair + cc, n = c >> 2, e = c & 3;
                        float lf[4], kk[4];
#pragma unroll
                        for (int m = 0; m < 4; ++m) { const float fa = acc[ai][1][m][n][e] * r[ai][m]; const float f = lbv[c] + (1.0f - lbv[c]) * fsigmoid(fa); lf[m] = flog2(f); kk[m] = 1.0f - f; }
                        if (!smp) {
#pragma unroll
                            for (int m = 0; m < 4; ++m) {
#pragma unroll
                                for (int d = 1; d < 16; d <<= 1) { const float t = __shfl_up(lf[m], d, 16); if (fr >= d) lf[m] += t; } }
                            float carry = 0.f;
#pragma unroll
                            for (int m = 0; m < 4; ++m) { lf[m] += carry; carry = __shfl(lf[m], 15, 16); }
                            if (fr == 15) DVP[((size_t)((u.pm * 4 + ai * 2 + wr) * 4 + hp)) * 128 + cp + c] = fexp2(lf[3]);
                        } else {
#pragma unroll
                            for (int m = 0; m < 4; ++m) {
#pragma unroll
                                for (int d = 1; d < 8; d <<= 1) { const float t = __shfl_up(lf[m], d, 8); if ((fr & 7) >= d) lf[m] += t; }
                                if ((fr & 7) == 7) { const int seq = (u.pm - 64) * 32 + ai * 16 + wr * 8 + m * 2 + (fr >> 3); DVS[((size_t)(seq * 4 + hp)) * 128 + cp + c] = fexp2(lf[m]); } }
                        }
#pragma unroll
                        for (int m = 0; m < 4; ++m) { const float eb = fexp2(lf[m]); qo[cc][m] = acc[ai][0][m][n][e] * r[ai][m] * eb; ko[cc][m] = kk[m] * frcp(eb); }
                    }
#pragma unroll
                    for (int m = 0; m < 4; ++m) { Qp[m][cpair] = cvt_pk_bf16(qo[0][m], qo[1][m]); Kp[m][cpair] = cvt_pk_bf16(ko[0][m], ko[1][m]); }
                }
#pragma unroll
                for (int m = 0; m < 4; ++m) { bf16_t* rowp = base + (size_t)(ai * HALF + m * 16) * 4096;
                    u32x4 w; w.x = Qp[m][0]; w.y = Qp[m][1]; w.z = Qp[m][2]; w.w = Qp[m][3]; *(u32x4*)rowp = w;
                    u32x4 k; k.x = Kp[m][0]; k.y = Kp[m][1]; k.z = Kp[m][2]; k.w = Kp[m][3]; *(u32x4*)(rowp + HALF) = k; }
            }
        } else {
            const int h = hp - 4; const float lg = flog2(1.0f - fexp2(-5.0f - (float)h));
            const bool isk = wc >= 2; const int j0 = cp & 63;
            bf16_t* obase = RB + (size_t)row0 * 4096 + u.pn * BM + (isk ? 128 : 0) + j0;
#pragma unroll
            for (int ai = 0; ai < 2; ++ai)
#pragma unroll
                for (int m = 0; m < 4; ++m) { const int row = row0 + ai * HALF + m * 16; const int p = smp ? 2048 + (row & 7) : (row & 2047), tau = smp ? (row & 7) : (row & 63);
                    const float dec = fexp2((float)(tau + 1) * lg); const float sc = (isk ? 0.08838834764831845f * frcp(dec) : dec) * r[ai][m];
                    const f32x4* tp = (const f32x4*)(ROPE + ((size_t)p * 64 + j0) * 2); const f32x4 t0 = tp[0], t1 = tp[1], t2 = tp[2], t3 = tp[3];
                    const float cs[8] = {t0[0], t0[2], t1[0], t1[2], t2[0], t2[2], t3[0], t3[2]}, sn[8] = {t0[1], t0[3], t1[1], t1[3], t2[1], t2[3], t3[1], t3[3]};
                    float o1[8], o2[8];
#pragma unroll
                    for (int c = 0; c < 8; ++c) { const float x1 = acc[ai][0][m][c >> 2][c & 3] * sc, x2 = acc[ai][1][m][c >> 2][c & 3] * sc; o1[c] = x1 * cs[c] - x2 * sn[c]; o2[c] = x1 * sn[c] + x2 * cs[c]; }
                    bf16_t* rowp = obase + (size_t)(ai * HALF + m * 16) * 4096;
                    u32x4 w; w.x = cvt_pk_bf16(o1[0], o1[1]); w.y = cvt_pk_bf16(o1[2], o1[3]); w.z = cvt_pk_bf16(o1[4], o1[5]); w.w = cvt_pk_bf16(o1[6], o1[7]); *(u32x4*)rowp = w;
                    u32x4 k; k.x = cvt_pk_bf16(o2[0], o2[1]); k.y = cvt_pk_bf16(o2[2], o2[3]); k.z = cvt_pk_bf16(o2[4], o2[5]); k.w = cvt_pk_bf16(o2[6], o2[7]); *(u32x4*)(rowp + 64) = k; }
        }
    }
};

template <int CTRL> __device__ __forceinline__ float dpp_keep(float oldv, float src) {
    return __builtin_bit_cast(float, __builtin_amdgcn_update_dpp(__builtin_bit_cast(int, oldv), __builtin_bit_cast(int, src), CTRL, 0xf, 0xf, false)); }
struct EpiConvAct {
    static constexpr bool PERM = true, AFTER_DRAIN = false;
    bf16_t* ACT; const float* ss; const float* cw; const float* cb; const float* sconv; float* RAW; float* cvp; float* cvs;
    __device__ __forceinline__ void operator()(const f32x4 (&acc)[2][2][4][2], const Unit& u, int wr, int wc, int fr, int fq) const {
        asm volatile("" : "+v"(fr), "+v"(fq));
        const int row0 = u.pm * BM + wr * 64 + fr, cp = wc * 32 + 8 * fq;
        const bool smp = u.pm >= 64;
        float r[2][4];
#pragma unroll
        for (int ai = 0; ai < 2; ++ai)
#pragma unroll
            for (int m = 0; m < 4; ++m) r[ai][m] = __builtin_amdgcn_rsqf(ss[row0 + ai * HALF + m * 16] * (1.0f / 1024.0f) + RMS_EPS);
#pragma unroll
        for (int n = 0; n < 2; ++n) {
            const int ch0 = u.pn * 128 + cp + 4 * n;
            f32x4 wu[3], wg[3];
#pragma unroll
            for (int j = 0; j < 3; ++j) { wu[j] = *(const f32x4*)(cw + j * 5632 + ch0); wg[j] = *(const f32x4*)(cw + j * 5632 + 2816 + ch0); }
            const f32x4 bu = *(const f32x4*)(cb + ch0), bg = *(const f32x4*)(cb + 2816 + ch0);
#pragma unroll
            for (int ai = 0; ai < 2; ++ai) {
                f32x4 Up = {0.f, 0.f, 0.f, 0.f}, Gp = {0.f, 0.f, 0.f, 0.f};
#pragma unroll
                for (int m = 0; m < 4; ++m) {
                    const int row = row0 + ai * HALF + m * 16;
                    const f32x4 U = acc[ai][0][m][n] * r[ai][m], G = acc[ai][1][m][n] * r[ai][m];
                    f32x4 u1, u2, g1, g2;
#pragma unroll
                    for (int e = 0; e < 4; ++e) {
                        u1[e] = dpp_keep<0x111>(dpp_keep<0x121>(Up[e], Up[e]), U[e]); u2[e] = dpp_keep<0x112>(dpp_keep<0x122>(Up[e], Up[e]), U[e]);
                        g1[e] = dpp_keep<0x111>(dpp_keep<0x121>(Gp[e], Gp[e]), G[e]); g2[e] = dpp_keep<0x112>(dpp_keep<0x122>(Gp[e], Gp[e]), G[e]); }
                    if (smp) {
                        const int t = fr & 7, seq = (u.pm - 64) * 32 + ai * 16 + wr * 8 + m * 2 + (fr >> 3);
                        if (t < 2) { const float* sp = sconv + (size_t)(seq * 2) * 5632 + ch0;
                            const f32x4 b1u = *(const f32x4*)(sp + 5632), b1g = *(const f32x4*)(sp + 5632 + 2816);
                            if (t == 0) { u2 = *(const f32x4*)sp; g2 = *(const f32x4*)(sp + 2816); u1 = b1u; g1 = b1g; } else { u2 = b1u; g2 = b1g; } }
                        if (t >= 6) { float* cp_ = cvs + (size_t)(seq * 2 + (t - 6)) * 5632 + ch0; *(f32x4*)cp_ = U; *(f32x4*)(cp_ + 2816) = G; }
                    } else {
                        const int blk = u.pm * 4 + ai * 2 + wr;
                        if (m == 0 && fr < 2) { float* rp = RAW + (size_t)(blk * 4 + fr) * 5632 + u.pn * 256 + cp + 4 * n; *(f32x4*)rp = U; *(f32x4*)(rp + 128) = G; }
                        if (m == 3 && fr >= 14) { float* rp = RAW + (size_t)(blk * 4 + fr - 12) * 5632 + u.pn * 256 + cp + 4 * n; *(f32x4*)rp = U; *(f32x4*)(rp + 128) = G;
                            if ((blk & 31) == 31) { float* cp_ = cvp + (size_t)((blk >> 5) * 2 + (fr - 14)) * 5632 + ch0; *(f32x4*)cp_ = U; *(f32x4*)(cp_ + 2816) = G; } }
                    }
                    const f32x4 cu = bu + wu[0] * u2 + wu[1] * u1 + wu[2] * U, cg = bg + wg[0] * g2 + wg[1] * g1 + wg[2] * G;
                    f32x4 a;
#pragma unroll
                    for (int e = 0; e < 4; ++e) a[e] = cg[e] * fsigmoid(cg[e]) * cu[e];
                    u32x2 w; w.x = cvt_pk_bf16(a[0], a[1]); w.y = cvt_pk_bf16(a[2], a[3]);
                    if (smp || m > 0 || fr >= 2) *(u32x2*)(ACT + (size_t)row * 2816 + ch0) = w;
                    Up = U; Gp = G;
                }
            }
        }
    }
};
template <class Epi, class Sched, bool ALIGN_EPI = false, bool SP2 = false, bool ABLK = false>
__device__ __forceinline__ void gemm_phase(PG8_LAS unsigned char* lds, const Gemm g, const Sched& S, const Epi& E) {
    int tid = threadIdx.x; asm volatile("" : "+v"(tid));
    const int wid = __builtin_amdgcn_readfirstlane(tid >> 6), lane = tid & 63, wr = wid >> 2, wc = wid & 3, fr = lane & 15, fq = lane >> 4;
    const int K = g.K, nt = K / BK;
    unsigned voffA[2], voffB[2];
#pragma unroll
    for (int i = 0; i < 2; ++i) { int R, C; stage_rc(tid * 16 + i * 8192, R, C); const int Rb = Epi::PERM ? ((R & ~31) + perm32(R & 31)) : R;
        voffA[i] = ABLK ? (unsigned)(((R >> 4) * (K >> 3) + (C >> 3)) * 256 + (R & 15) * 16) : (unsigned)(R * K + C) * 2u; voffB[i] = (unsigned)(Rb * K + C) * 2u; }
    const size_t kstep = (size_t)(BK * 2), kstepA = ABLK ? (size_t)(BK / 8) * 256 : kstep;
    const size_t hstep = (size_t)HALF * K * 2;
    const size_t tstep = 2 * hstep;
    const unsigned ldsw = (unsigned)wid * 1024u;
    const int aoff = lds_byte(wr * 64 + fr, fq * 8), boff = lds_byte(wc * 32 + fr, fq * 8);
#define PG8_SA(b, h) (((b) * 2 + (h)) * HTB)
#define PG8_SB(b, h) ((4 + (b) * 2 + (h)) * HTB)
#define PG8_STAGE(bufoff, gbase, voff) do { _Pragma("unroll") for (int _i = 0; _i < 2; ++_i) \
        __builtin_amdgcn_global_load_lds((const unsigned*)((const char*)(gbase) + (voff)[_i]), (PG8_LAS unsigned*)(lds + (bufoff) + ldsw + _i * 8192), 16, 0, 0); } while (0)
#define PG8_LDA(dst, b, h) do { _Pragma("unroll") for (int m = 0; m < 4; ++m) _Pragma("unroll") for (int k = 0; k < 2; ++k) dst[m][k] = *(const PG8_LAS bf16x8*)(lds + PG8_SA(b, h) + aoff + m * 2048 + k * 1024); } while (0)
#define PG8_LDB(dst, b, h) do { _Pragma("unroll") for (int n = 0; n < 2; ++n) _Pragma("unroll") for (int k = 0; k < 2; ++k) dst[n][k] = *(const PG8_LAS bf16x8*)(lds + PG8_SB(b, h) + boff + n * 2048 + k * 1024); } while (0)
#define PG8_MMA(ai, bj, At, Bt) do { __builtin_amdgcn_s_setprio(1); _Pragma("unroll") for (int m = 0; m < 4; ++m) _Pragma("unroll") for (int n = 0; n < 2; ++n) _Pragma("unroll") for (int k = 0; k < 2; ++k) \
        acc[ai][bj][m][n] = __builtin_amdgcn_mfma_f32_16x16x32_bf16(Bt[n][k], At[m][k], acc[ai][bj][m][n], 0, 0, 0); __builtin_amdgcn_s_setprio(0); } while (0)
#define PG8_WAIT_V(n) asm volatile("s_waitcnt vmcnt(" #n ")" ::: "memory")
#define PG8_WAIT_L(n) asm volatile("s_waitcnt lgkmcnt(" #n ")" ::: "memory")
#define PG8_BAR __builtin_amdgcn_s_barrier()
#define PG8_SCHED __builtin_amdgcn_sched_barrier(0)
    Unit cur, nxt; int ui = 0;
    if (!S.next(0, cur)) return;
    f32x4 acc[2][2][4][2];
#pragma unroll
    for (int a = 0; a < 2; ++a)
#pragma unroll
        for (int b = 0; b < 2; ++b)
#pragma unroll
            for (int m = 0; m < 4; ++m)
#pragma unroll
                for (int n = 0; n < 2; ++n) acc[a][b][m][n] = (f32x4){0.f, 0.f, 0.f, 0.f};
    bf16x8 At[4][2], B0[2][2], B1[2][2];
    const char* cA = (const char*)g.A + (size_t)cur.pm * tstep; const char* cB = (const char*)g.Bt + (size_t)cur.pn * tstep;
    S.a_ready(cur);
    if constexpr (SP2) {
        PG8_STAGE(PG8_SB(0, 0), cB, voffB); PG8_STAGE(PG8_SB(0, 1), cB + hstep, voffB); PG8_STAGE(PG8_SA(0, 0), cA, voffA); PG8_STAGE(PG8_SA(0, 1), cA + hstep, voffA);
        if (wr == 1) PG8_BAR;
        PG8_WAIT_V(2); PG8_BAR;
        PG8_STAGE(PG8_SB(1, 0), cB + kstep, voffB); PG8_STAGE(PG8_SA(1, 0), cA + kstepA, voffA); PG8_STAGE(PG8_SB(1, 1), cB + hstep + kstep, voffB);
        PG8_WAIT_V(6); PG8_BAR;
    } else {
        PG8_STAGE(PG8_SB(0, 0), cB, voffB); PG8_STAGE(PG8_SA(0, 0), cA, voffA); PG8_STAGE(PG8_SB(0, 1), cB + hstep, voffB); PG8_STAGE(PG8_SA(0, 1), cA + hstep, voffA);
        if (wr == 1) PG8_BAR;
        PG8_WAIT_V(4); PG8_BAR;
        PG8_STAGE(PG8_SB(1, 0), cB + kstep, voffB); PG8_STAGE(PG8_SA(1, 0), cA + kstepA, voffA); PG8_STAGE(PG8_SB(1, 1), cB + hstep + kstep, voffB);
        PG8_WAIT_V(6); PG8_BAR;
    }
    for (;;) {
        const bool has_next = S.next(ui + 1, nxt);
        const char* nA = has_next ? (const char*)g.A + (size_t)nxt.pm * tstep : cA; const char* nB = has_next ? (const char*)g.Bt + (size_t)nxt.pn * tstep : cB;
        for (int t = 0; t < nt; t += 2) {
            const bool last = (t == nt - 2);
            const char* a1 = cA + (size_t)(t + 1) * kstepA;
            const char* a2 = last ? nA : cA + (size_t)(t + 2) * kstepA; const char* b2 = last ? nB : cB + (size_t)(t + 2) * kstep;
            const char* a3 = a2 + kstepA; const char* b3 = b2 + kstep;
            if (last && has_next) S.a_ready(nxt);
            if constexpr (SP2) {
            PG8_LDB(B0, 0, 0); PG8_LDB(B1, 0, 1); PG8_SCHED; PG8_LDA(At, 0, 0); PG8_STAGE(PG8_SA(1, 1), a1 + hstep, voffA);
            PG8_WAIT_V(8); PG8_WAIT_L(0); PG8_BAR; PG8_MMA(0, 0, At, B0); PG8_MMA(0, 1, At, B1); PG8_BAR; PG8_SCHED;
            PG8_LDA(At, 0, 1); PG8_STAGE(PG8_SB(0, 0), b2, voffB); PG8_STAGE(PG8_SB(0, 1), b2 + hstep, voffB); PG8_STAGE(PG8_SA(0, 0), a2, voffA);
            PG8_WAIT_V(8); PG8_WAIT_L(0); PG8_BAR; PG8_MMA(1, 0, At, B0); PG8_MMA(1, 1, At, B1); PG8_BAR; PG8_SCHED;
            PG8_LDB(B0, 1, 0); PG8_LDB(B1, 1, 1); PG8_SCHED; PG8_LDA(At, 1, 0); PG8_STAGE(PG8_SA(0, 1), a2 + hstep, voffA);
            PG8_WAIT_V(8); PG8_WAIT_L(0); PG8_BAR; PG8_MMA(0, 0, At, B0); PG8_MMA(0, 1, At, B1); PG8_BAR; PG8_SCHED;
            PG8_LDA(At, 1, 1); PG8_STAGE(PG8_SB(1, 0), b3, voffB); PG8_STAGE(PG8_SB(1, 1), b3 + hstep, voffB); PG8_STAGE(PG8_SA(1, 0), a3, voffA);
            PG8_WAIT_V(8); PG8_WAIT_L(0); PG8_BAR; PG8_MMA(1, 0, At, B0); PG8_MMA(1, 1, At, B1); PG8_BAR; PG8_SCHED;
            } else {
            PG8_LDB(B0, 0, 0); PG8_SCHED; PG8_LDA(At, 0, 0); PG8_STAGE(PG8_SA(1, 1), a1 + hstep, voffA);
            PG8_WAIT_L(8); PG8_BAR; PG8_WAIT_L(0); PG8_MMA(0, 0, At, B0); PG8_BAR; PG8_SCHED;
            PG8_LDB(B1, 0, 1); PG8_STAGE(PG8_SB(0, 0), b2, voffB);
            PG8_BAR; PG8_WAIT_L(0); PG8_MMA(0, 1, At, B1); PG8_BAR;
            PG8_LDA(At, 0, 1); PG8_STAGE(PG8_SA(0, 0), a2, voffA);
            PG8_BAR; PG8_WAIT_L(0); PG8_MMA(1, 0, At, B0); PG8_BAR; PG8_SCHED;
            PG8_STAGE(PG8_SB(0, 1), b2 + hstep, voffB);
            PG8_WAIT_V(6); PG8_BAR; PG8_MMA(1, 1, At, B1); PG8_BAR;
            PG8_LDB(B0, 1, 0); PG8_SCHED; PG8_LDA(At, 1, 0); PG8_STAGE(PG8_SA(0, 1), a2 + hstep, voffA);
            PG8_WAIT_L(8); PG8_BAR; PG8_WAIT_L(0); PG8_MMA(0, 0, At, B0); PG8_BAR; PG8_SCHED;
            PG8_LDB(B1, 1, 1); PG8_STAGE(PG8_SB(1, 0), b3, voffB);
            PG8_BAR; PG8_WAIT_L(0); PG8_MMA(0, 1, At, B1); PG8_BAR;
            PG8_LDA(At, 1, 1); PG8_STAGE(PG8_SA(1, 0), a3, voffA);
            PG8_BAR; PG8_WAIT_L(0); PG8_MMA(1, 0, At, B0); PG8_BAR; PG8_SCHED;
            PG8_STAGE(PG8_SB(1, 1), b3 + hstep, voffB);
            PG8_WAIT_V(6); PG8_BAR; PG8_MMA(1, 1, At, B1); PG8_BAR;
            }
        }
        if constexpr (ALIGN_EPI) { if (wr == 0) PG8_BAR; }
        if constexpr (!Epi::AFTER_DRAIN) { E(acc, cur, wr, wc, fr, fq); S.done(cur); }
        if (!has_next) break;
#pragma unroll
        for (int a = 0; a < 2; ++a)
#pragma unroll
            for (int b = 0; b < 2; ++b)
#pragma unroll
                for (int m = 0; m < 4; ++m)
#pragma unroll
                    for (int n = 0; n < 2; ++n) acc[a][b][m][n] = (f32x4){0.f, 0.f, 0.f, 0.f};
        cur = nxt; cA = nA; cB = nB; ++ui;
        if constexpr (ALIGN_EPI) { if (wr == 1) PG8_BAR; }
    }
    PG8_WAIT_V(0);
    if constexpr (!ALIGN_EPI) { if (wr == 0) PG8_BAR; }
    PG8_BAR;
    if constexpr (Epi::AFTER_DRAIN) { E.fused(acc, cur, wr, wc, fr, fq, lds, wid, lane); S.done(cur); }
#undef PG8_SA
#undef PG8_SB
#undef PG8_STAGE
#undef PG8_LDA
#undef PG8_LDB
#undef PG8_MMA
#undef PG8_WAIT_V
#undef PG8_WAIT_L
#undef PG8_BAR
#undef PG8_SCHED
}
}
constexpr int NWAVES = 8;
constexpr int D = 1024, MP = 16384, MS = 1024, M = MP + MS;
constexpr int TP = 2048, NBP = 8, TS = 8, NBS = 128, PAST = 16384;
constexpr int INW = 4096, DFF = 2816, UPW = 5632, HD = 128, NH = 4;
constexpr size_t MiB = 1u << 20, KiB = 1024;
constexpr size_t WS_CTL = 0, CTL_ZERO_BYTES = 320 * KiB;
constexpr size_t WS_SS2 = 64 * KiB, WS_SS3 = 192 * KiB;
constexpr size_t WS_WIN = 1 * MiB, WS_WOUT = 9 * MiB, WS_WUP = 11 * MiB, WS_WDN = 22 * MiB;
constexpr size_t WS_ROPE = 28 * MiB;
constexpr size_t WS_SS1 = 30 * MiB;
constexpr size_t WS_LB = 30 * MiB + 96 * KiB;
constexpr size_t WS_DVP = 30 * MiB + 128 * KiB;
constexpr size_t WS_DVS = 30 * MiB + 640 * KiB;
constexpr size_t WS_XB = 32 * MiB;
constexpr size_t WS_PROJ = 66 * MiB;
constexpr size_t WS_OHAT = 202 * MiB;
constexpr size_t WS_RAW = 66 * MiB, WS_ACT = 160 * MiB;
constexpr size_t WS_END = 256 * MiB;
static_assert(WS_WDN + (size_t)D * DFF * 2 <= WS_ROPE && WS_ROPE + 2056 * 64 * 8 <= WS_SS1 && WS_SS1 + M * 4 <= WS_XB && WS_XB + (size_t)M * D * 2 <= WS_PROJ, "ws map 1");
static_assert(WS_PROJ + (size_t)M * INW * 2 <= WS_OHAT && WS_OHAT + (size_t)M * D * 2 <= WS_END && WS_RAW + (size_t)(M / 64) * 4 * UPW * 4 <= WS_ACT && WS_ACT + (size_t)M * DFF * 2 <= WS_END, "ws map 2");
constexpr int CW_TMO = 0, CW_CODE = 1, CW_BAR = 4096;
constexpr int RING_OFF = 0, RING_BYTES = 131072;
constexpr int LDSCTL_OFF = RING_BYTES, MISC_OFF = LDSCTL_OFF + 320;
constexpr int LDS_BYTES = 163840;
constexpr int RQK_OFF = 0, RV_OFF = 98304, RP_OFF = MISC_OFF + 128, RP_STRIDE = 144, RP_BYTES = 64 * RP_STRIDE, RSTAT_OFF = RP_OFF + 2 * RP_BYTES, RSTAT_BYTES = 4096, RDVEC_OFF = RSTAT_OFF + 2 * RSTAT_BYTES, R_END = RDVEC_OFF + 1536;
static_assert(RP_OFF % 16 == 0 && R_END <= LDS_BYTES, "LDS map");
#define GAS __attribute__((address_space(1)))
#define LAS __attribute__((address_space(3)))
typedef unsigned short bf16;
typedef unsigned v4u __attribute__((ext_vector_type(4)));
typedef unsigned v2u __attribute__((ext_vector_type(2)));
typedef float f32x4 __attribute__((ext_vector_type(4)));
typedef GAS unsigned gu32;
#define RLX_AGENT __ATOMIC_RELAXED, __HIP_MEMORY_SCOPE_AGENT
#define LDS_WAIT() asm volatile("s_waitcnt lgkmcnt(0)" ::: "memory")
#define VM_WAIT() asm volatile("s_waitcnt vmcnt(0)" ::: "memory")
__device__ __forceinline__ unsigned f2bf(float f) { unsigned u = __builtin_bit_cast(unsigned, f); return (u + 0x7fffu + ((u >> 16) & 1u)) >> 16; }
__device__ __forceinline__ unsigned pk2(float lo, float hi) { return f2bf(lo) | (f2bf(hi) << 16); }
__device__ __forceinline__ float bf2f(unsigned short h) { return __builtin_bit_cast(float, (unsigned)h << 16); }
__device__ __forceinline__ float bflo(unsigned w) { return __builtin_bit_cast(float, w << 16); }
__device__ __forceinline__ float bfhi(unsigned w) { return __builtin_bit_cast(float, w & 0xffff0000u); }

#define XB_TMO      128
#define XB_XCNT(j)  (256  + 64 * (j))
#define XB_XSUB(j)  (1280 + 64 * (j))
#define XB_XGEN(j)  (2304 + 64 * (j))
#define XB_TOP      3328
#define XB_TOPGEN   3392
#define XCD_BAR_WORDS 3456
#define XB_SPIN_CAP (1u << 18)

__device__ __forceinline__ unsigned xb_ld(unsigned* p)              { return __hip_atomic_load(p, __ATOMIC_RELAXED, __HIP_MEMORY_SCOPE_AGENT); }
__device__ __forceinline__ unsigned xb_add(unsigned* p, unsigned v) { return __hip_atomic_fetch_add(p, v, __ATOMIC_RELAXED, __HIP_MEMORY_SCOPE_AGENT); }
__device__ __forceinline__ unsigned xb_xcc_id() { return (unsigned)__builtin_amdgcn_s_getreg((3 << 11) | 20) & 0xFu; }
#define XB_SPIN(cond, bar) do { unsigned _sp = 0; while (cond) { __builtin_amdgcn_s_sleep(1); \
    if ((++_sp & 255u) == 0u) { if (xb_ld(&(bar)[XB_TMO])) break; if (_sp > XB_SPIN_CAP) { atomicAdd(&(bar)[XB_TMO], 1u); break; } } } } while (0)

struct XcdBarrier {
    unsigned* bar; unsigned x;
    volatile LAS unsigned* st;
};

__device__ __forceinline__ XcdBarrier xcd_barrier_post(unsigned* bar, volatile LAS unsigned* st) {
    XcdBarrier b; b.bar = bar; b.x = xb_xcc_id(); b.st = st;
    if (threadIdx.x == 0) (void)xb_add(&bar[XB_XCNT(b.x)], 1u);
    return b;
}
__device__ __forceinline__ void xcd_barrier_complete(unsigned* bar, unsigned x, unsigned& nloc, unsigned& nx) {
    const unsigned G = gridDim.x * gridDim.y * gridDim.z;
    unsigned sum, cnt, mine, sp = 0u;
    for (;;) {
        sum = 0u; cnt = 0u; mine = 0u;
#pragma unroll
        for (unsigned j = 0; j < 16; ++j) { const unsigned c = xb_ld(&bar[XB_XCNT(j)]); sum += c; cnt += (c > 0u) ? 1u : 0u; mine = (j == x) ? c : mine; }
        if (sum == G) break;
        __builtin_amdgcn_s_sleep(1);
        if ((++sp & 255u) == 0u) { if (xb_ld(&bar[XB_TMO])) break; if (sp > XB_SPIN_CAP) { atomicAdd(&bar[XB_TMO], 1u); break; } }
    }
    nloc = mine > 0u ? mine : 1u; nx = cnt > 0u ? cnt : 1u;
}

__device__ __forceinline__ void xcd_barrier(const XcdBarrier& b) {
    asm volatile("s_waitcnt vmcnt(0)" ::: "memory");
    __syncthreads();
    if (threadIdx.x == 0) {
        unsigned* bar = b.bar;
        __builtin_amdgcn_s_waitcnt(0);
        unsigned nloc = b.st[0], nx = b.st[1];
        if (nloc == 0u) { xcd_barrier_complete(bar, b.x, nloc, nx); b.st[0] = nloc; b.st[1] = nx; }
        const unsigned old = xb_add(&bar[XB_XSUB(b.x)], 1u);
        const unsigned gen = old / nloc;
        if (old + 1u == (gen + 1u) * nloc) {
            __builtin_amdgcn_fence(__ATOMIC_RELEASE, "agent");
            asm volatile("s_waitcnt vmcnt(0)" ::: "memory");
            const unsigned og = xb_add(&bar[XB_TOP], 1u);
            const unsigned tg = og / nx;
            if (og + 1u == (tg + 1u) * nx) xb_add(&bar[XB_TOPGEN], 1u);
            else XB_SPIN(xb_ld(&bar[XB_TOPGEN]) == tg, bar);
            __builtin_amdgcn_fence(__ATOMIC_ACQUIRE, "agent");
            xb_add(&bar[XB_XGEN(b.x)], 1u);
            asm volatile("s_waitcnt vmcnt(0)" ::: "memory");
        } else {
            XB_SPIN(xb_ld(&bar[XB_XGEN(b.x)]) == gen, bar);
            __builtin_amdgcn_fence(__ATOMIC_ACQUIRE, "agent");
            asm volatile("s_waitcnt vmcnt(0)" ::: "memory");
        }
    }
    __syncthreads();
}
#ifndef PH_MASK
#define PH_MASK 127
#endif
#ifndef REP_MASK
#define REP_MASK 0
#endif
#define REPS(k) ((((REP_MASK) >> (k)) & 1) + 1)
#ifndef REP_ABL
#define REP_ABL 0
#endif
#ifndef REP_SEL
#define REP_SEL 3
#endif
__device__ __forceinline__ float wave_sum(float v) {
#pragma unroll
    for (int o = 1; o < 64; o <<= 1) v += __shfl_xor(v, o);
    return v;
}
__device__ __forceinline__ float silu_f(float x) { return x / (1.0f + expf(-x)); }
__device__ __forceinline__ void sincos_acc(double ang, float& c, float& s) {
    const double TWO_OVER_PI = 0.63661977236758134308, PIO2_HI = 1.57079632679489655800e+00, PIO2_LO = 6.12323399573676603587e-17;
    const double q = rint(ang * TWO_OVER_PI);
    double r = fma(-q, PIO2_HI, ang); r = fma(-q, PIO2_LO, r);
    const int n = ((int)q) & 3;
    const double z = r * r;
    const double S1 = -1.66666666666666324348e-01, S2 = 8.33333333332248946124e-03, S3 = -1.98412698298579493134e-04, S4 = 2.75573137070700676789e-06, S5 = -2.50507602534068634195e-08, S6 = 1.58969099521155010221e-10;
    const double C1 = 4.16666666666666019037e-02, C2 = -1.38888888888741095749e-03, C3 = 2.48015872894767294178e-05, C4 = -2.75573143513906633035e-07, C5 = 2.08757232129817482790e-09, C6 = -1.13596475577881948265e-11;
    const double sn = r + r * z * (S1 + z * (S2 + z * (S3 + z * (S4 + z * (S5 + z * S6)))));
    const double cs = 1.0 - 0.5 * z + z * z * (C1 + z * (C2 + z * (C3 + z * (C4 + z * (C5 + z * C6)))));
    double sv, cv;
    if (n == 0) { sv = sn; cv = cs; } else if (n == 1) { sv = cs; cv = -sn; } else if (n == 2) { sv = -sn; cv = -cs; } else { sv = -cs; cv = sn; }
    c = (float)cv; s = (float)sv;
}
__device__ __forceinline__ int up_col_map(int n) { const int g = n >= DFF ? 1 : 0, ch = n - g * DFF; return (ch >> 7) * 256 + g * 128 + (ch & 127); }
__device__ __forceinline__ int in_col_map(int n) {
    const int grp = n >> 11, part = (n >> 9) & 3, h = (n >> 7) & 3, c = n & 127, hp = grp * 4 + h;
    if (part >= 2) return (2 * hp + 1) * 256 + (part - 2) * 128 + c;
    if (grp == 0) return (2 * hp) * 256 + part * 128 + c;
    return (2 * hp) * 256 + (c >> 6) * 128 + part * 64 + (c & 63);
}
template <int MAPMODE>
__device__ __forceinline__ void p0_transpose_item(const float* W, int K, int N, bf16* WT, const float* kscale, LAS float* scr, int item, int lane) {
    const int nblk = N / 32, kb = item / nblk, nb = item % nblk, k0 = 64 * kb, n0 = 32 * nb;
#pragma unroll 8
    for (int i = 0; i < 32; ++i) { const int kk = 2 * i + (lane >> 5); const float sc = kscale ? kscale[k0 + kk] : 1.0f; scr[kk * 33 + (lane & 31)] = W[(size_t)(k0 + kk) * N + n0 + (lane & 31)] * sc; }
    LDS_WAIT(); asm volatile("" ::: "memory");
    const int c = lane & 7;
    const int r0 = MAPMODE == 1 ? up_col_map(n0) : MAPMODE == 2 ? in_col_map(n0) : n0;
#pragma unroll
    for (int j = 0; j < 4; ++j) { const int n = (lane >> 3) + 8 * j; const LAS float* s = scr + (8 * c) * 33 + n;
        v4u o; o.x = pk2(s[0 * 33], s[1 * 33]); o.y = pk2(s[2 * 33], s[3 * 33]); o.z = pk2(s[4 * 33], s[5 * 33]); o.w = pk2(s[6 * 33], s[7 * 33]);
        *(GAS v4u*)(WT + (size_t)(r0 + n) * K + k0 + 8 * c) = o; }
    LDS_WAIT(); asm volatile("" ::: "memory");
}
__device__ __forceinline__ void x_row_to_bf16(const float* xrow, bf16* orow, float* ss, int lane) {
    const GAS f32x4* xr = (const GAS f32x4*)xrow + lane;
    f32x4 v[4]; float s = 0.f;
#pragma unroll
    for (int j = 0; j < 4; ++j) { v[j] = xr[64 * j]; s += (v[j].x * v[j].x + v[j].y * v[j].y) + (v[j].z * v[j].z + v[j].w * v[j].w); }
    s = wave_sum(s);
    if (lane == 0) *ss = s;
    GAS unsigned long long* o8 = (GAS unsigned long long*)orow + lane;
#pragma unroll
    for (int j = 0; j < 4; ++j) o8[64 * j] = (unsigned long long)pk2(v[j].x, v[j].y) | ((unsigned long long)pk2(v[j].z, v[j].w) << 32);
}

typedef short bf16x8 __attribute__((ext_vector_type(8)));
typedef short s16x4 __attribute__((ext_vector_type(4)));
template <int CTRL> __device__ __forceinline__ float dppf(float x) { return __builtin_bit_cast(float, __builtin_amdgcn_update_dpp(0, __builtin_bit_cast(int, x), CTRL, 0xf, 0xf, true)); }
__device__ __forceinline__ float row16_sum(float x) { x += dppf<0xB1>(x); x += dppf<0x4E>(x); x += dppf<0x141>(x); x += dppf<0x140>(x); return x; }
__device__ __forceinline__ unsigned off_b(unsigned row, unsigned ch) { return 2048u * (row >> 3) + 512u * (ch >> 2) + 64u * (row & 7) + 16u * ((ch & 3) ^ ((row >> 2) & 3)); }
__device__ __forceinline__ unsigned row_read_addr_16(unsigned lane, unsigned rb, unsigned s) { return off_b((lane & 15) + 16 * rb, 4 * s + (lane >> 4)); }
__device__ __forceinline__ unsigned tr_read_addr_16(unsigned lane, unsigned c, unsigned ks, unsigned t) {
    const unsigned g = lane >> 4, q = (lane & 15) >> 2, p = lane & 3; return off_b(32 * ks + 8 * g + 4 * t + q, 2 * c + (p >> 1)) + 8 * (p & 1); }
__device__ __forceinline__ s16x4 lds_tr(LAS unsigned char* p) { return __builtin_amdgcn_ds_read_tr16_b64_v4i16((LAS s16x4*)p); }
__device__ __forceinline__ bf16x8 cat8(s16x4 a, s16x4 b) { bf16x8 r; r[0] = a[0]; r[1] = a[1]; r[2] = a[2]; r[3] = a[3]; r[4] = b[0]; r[5] = b[1]; r[6] = b[2]; r[7] = b[3]; return r; }
__device__ __forceinline__ bf16x8 pack8(f32x4 a, f32x4 b) { v4u w; w.x = pg8::cvt_pk_bf16(a[0], a[1]); w.y = pg8::cvt_pk_bf16(a[2], a[3]); w.z = pg8::cvt_pk_bf16(b[0], b[1]); w.w = pg8::cvt_pk_bf16(b[2], b[3]); return __builtin_bit_cast(bf16x8, w); }
#define RBAR() do { asm volatile("s_waitcnt lgkmcnt(0)" ::: "memory"); __builtin_amdgcn_s_barrier(); asm volatile("" ::: "memory"); } while (0)

template <bool RET, bool SMP, int ABL = 0>
__device__ __forceinline__ void rec_core(LAS unsigned char* lds, const bf16* RB, const float* DV, const float* normw, const float* s_in, float* s_out, bf16* OHAT, bf16* dummy, int h, int first, int stride, int count) {
    constexpr int NT = SMP ? 1 : 4, NKS = SMP ? 1 : 2, NQK = SMP ? 1 : 4, NV = SMP ? 1 : 2;
    int tid = threadIdx.x; asm volatile("" : "+v"(tid));
    const int w = __builtin_amdgcn_readfirstlane(tid >> 6), l = tid & 63, g = l >> 4, c16 = l & 15;
    const int hp = (RET ? 4 : 0) + h;
    const float dconst = RET ? exp2f((SMP ? 8.0f : 64.0f) * log2f(1.0f - exp2f(-5.0f - (float)h))) : 1.0f;
    const f32x4 nw = *(const f32x4*)(normw + 16 * w + 4 * g);
    const unsigned q_ = c16 >> 2, p_l = c16 & 3, p1_ = p_l >> 1;
    unsigned KB[2][2], VB[2], QB[2];
#pragma unroll
    for (int t = 0; t < 2; ++t) {
#pragma unroll
        for (int ib = 0; ib < 2; ++ib) KB[t][ib] = 2048u * g + 64u * q_ + 8u * (p_l & 1) + 256u * t + 32u * (ib ^ (g & 1)) + 16u * (p1_ ^ t);
        VB[t] = 2048u * g + 64u * q_ + 8u * (p_l & 1) + 256u * t + 32u * ((w & 1) ^ (g & 1)) + 16u * (p1_ ^ t) + 512u * (w >> 1);
    }
    const unsigned RR = 2048u * (c16 >> 3) + 64u * (c16 & 7) + 16u * (g ^ ((c16 >> 2) & 3));
#pragma unroll
    for (int e = 0; e < 2; ++e) QB[e] = 2048u * (c16 >> 3) + 64u * (c16 & 7) + 16u * ((2 * e + (g >> 1)) ^ ((c16 >> 2) & 3)) + 8u * (g & 1);
    const unsigned WQ = 2048u * (tid >> 8) + 512u * ((tid & 15) >> 2) + 64u * ((tid >> 5) & 7) + 16u * ((tid & 3) ^ ((tid >> 7) & 3)) + 16384u * ((tid & 31) >> 4);
    const unsigned WV = 2048u * (tid >> 7) + 512u * ((tid & 15) >> 2) + 64u * ((tid >> 4) & 7) + 16u * ((tid & 3) ^ ((tid >> 6) & 3));
    const unsigned PW = RP_STRIDE * c16 + 8u * g, PR = RP_STRIDE * c16 + 16u * g;
#define REC_ROW0(c) (SMP ? MP + (((first) + (c) * (stride)) >> 2) * TS : (first) * TP + (c) * 64)
#define REC_HEAD(c) (SMP ? (((first) + (c) * (stride)) & 3) : h)
    v4u pq[NQK], pv[NV]; v2u pg[NT]; f32x4 pfd = {0.f, 0.f, 0.f, 0.f};
    const bool ldq = SMP ? tid < 256 : true, ldv = SMP ? tid < 128 : true;
    const unsigned qoff = ((unsigned)(SMP ? (tid >> 5) & 7 : tid >> 5) * INW + (tid & 31) * 8) * 2u, voff = ((unsigned)(SMP ? (tid >> 4) & 7 : tid >> 4) * INW + 256 + (tid & 15) * 8) * 2u;
    const unsigned goff = ((unsigned)(SMP ? (c16 & 7) : c16) * INW + 384 + 16 * w + 4 * g) * 2u, ooff = (unsigned)(2 * w + (g >> 1)) * 256u + (unsigned)c16 * 16u + (g & 1) * 8u;
#define REC_UB(c) ((const char*)RB + ((size_t)REC_ROW0(c) * INW + (RET ? 2048 : 0) + REC_HEAD(c) * 512) * 2)
#define REC_LOADQK(c) do { { const char* ub_ = REC_UB(c); \
        _Pragma("unroll") for (int i_ = 0; i_ < NQK; ++i_) pq[i_] = *(const v4u*)(ub_ + (size_t)i_ * (16 * INW * 2) + qoff); } \
        if (!RET) pfd = *(const f32x4*)(DV + (SMP ? (size_t)((first) + (c) * (stride)) : (size_t)(((first) * 32 + (c)) * 4 + h)) * 128 + (tid & 31) * 4); } while (0)
#define REC_STOREQK(c) do { if (ldq) { _Pragma("unroll") for (int i_ = 0; i_ < NQK; ++i_) *(LAS v4u*)(lds + RQK_OFF + ((c) % 3) * 32768 + WQ + 4096 * i_) = pq[i_]; } \
        if (!RET && tid < 32) *(LAS f32x4*)(lds + RDVEC_OFF + ((c) % 3) * 512 + tid * 16) = pfd; } while (0)
#define REC_LOADV(c) do { { const char* ub_ = REC_UB(c); \
        _Pragma("unroll") for (int i_ = 0; i_ < NV; ++i_) pv[i_] = *(const v4u*)(ub_ + (size_t)i_ * (32 * INW * 2) + voff); } } while (0)
#define REC_STOREV(c) do { if (ldv) { _Pragma("unroll") for (int i_ = 0; i_ < NV; ++i_) *(LAS v4u*)(lds + RV_OFF + ((c) & 1) * 16384 + WV + 8192 * i_) = pv[i_]; } } while (0)
#define REC_LOADG(c) do { const char* ub_ = REC_UB(c); \
        _Pragma("unroll") for (int ti_ = 0; ti_ < NT; ++ti_) pg[ti_] = *(const v2u*)(ub_ + (size_t)ti_ * (16 * INW * 2) + goff); } while (0)
#define REC_PTILE(slot, pb, ti, si) do { f32x4 a_ = {0.f, 0.f, 0.f, 0.f}; \
        _Pragma("unroll") for (int ks_ = 0; ks_ < 4; ++ks_) { const bf16x8 ak_ = *(const LAS bf16x8*)(lds + RQK_OFF + (slot) * 32768 + 16384 + RR + 4096 * (si) + 512 * ks_); \
            const bf16x8 bq_ = *(const LAS bf16x8*)(lds + RQK_OFF + (slot) * 32768 + RR + 4096 * (ti) + 512 * ks_); a_ = __builtin_amdgcn_mfma_f32_16x16x32_bf16(ak_, bq_, a_, 0, 0, 0); } \
        if ((si) == (ti)) { _Pragma("unroll") for (int r_ = 0; r_ < 4; ++r_) a_[r_] = (4 * g + r_ <= c16) ? a_[r_] : 0.f; } \
        v2u pw_; pw_.x = pg8::cvt_pk_bf16(a_[0], a_[1]); pw_.y = pg8::cvt_pk_bf16(a_[2], a_[3]); \
        *(LAS v2u*)(lds + RP_OFF + (pb) * RP_BYTES + PW + 2304 * (ti) + 32 * (si)) = pw_; } while (0)
#define REC_PHASE1(slot, pb) do { if (SMP) { if (w == 0) REC_PTILE(slot, pb, 0, 0); } else { switch (w) { case 0: REC_PTILE(slot, pb, 0, 0); REC_PTILE(slot, pb, 3, 2); break; case 1: REC_PTILE(slot, pb, 1, 0); REC_PTILE(slot, pb, 3, 3); break; \
        case 2: REC_PTILE(slot, pb, 1, 1); break; case 3: REC_PTILE(slot, pb, 2, 0); break; case 4: REC_PTILE(slot, pb, 2, 1); break; case 5: REC_PTILE(slot, pb, 2, 2); break; case 6: REC_PTILE(slot, pb, 3, 0); break; default: REC_PTILE(slot, pb, 3, 1); break; } } } while (0)
    f32x4 S[8], Sn[8];
    if (tid < 256) { const int t = tid >> 2, q4 = tid & 3; const int ti = t >> 4; if (ti == 0 || ti == 2) { *(LAS v2u*)(lds + RP_OFF + t * RP_STRIDE + (16 * (ti + 1) + 4 * q4) * 2) = (v2u){0u, 0u}; *(LAS v2u*)(lds + RP_OFF + RP_BYTES + t * RP_STRIDE + (16 * (ti + 1) + 4 * q4) * 2) = (v2u){0u, 0u}; } }
    if (SMP) { for (int q = tid; q < 8 * 24 * 16; q += 512) { const int slot = q / (24 * 16), rr = 8 + (q / 16) % 24, ch = q & 15;
            const int base = slot < 6 ? RQK_OFF + (slot >> 1) * 32768 + (slot & 1) * 16384 : RV_OFF + (slot - 6) * 16384; *(LAS v4u*)(lds + base + off_b(rr, ch)) = (v4u){0u, 0u, 0u, 0u}; } }
    if (!SMP) {
#pragma unroll
        for (int i = 0; i < 8; ++i) S[i] = (f32x4){0.f, 0.f, 0.f, 0.f};
    }
#define REC_LOADS(dst, c) do { const float* p_ = s_in + (size_t)((first) + (c) * (stride)) * HD * HD + (size_t)(4 * g) * HD + 16 * w + c16; \
        _Pragma("unroll") for (int i_ = 0; i_ < 8; ++i_) { _Pragma("unroll") for (int r_ = 0; r_ < 4; ++r_) dst[i_][r_] = p_[(16 * i_ + r_) * HD]; } } while (0)
    const int last = count - 1; const bool never = count > (1 << 20);
#define ABL_ON(bit) (!(ABL & (bit)) || never)
    REC_LOADQK(0); REC_LOADV(0); REC_STOREQK(0); REC_STOREV(0);
    { const int c1 = last < 1 ? last : 1; REC_LOADQK(c1); REC_STOREQK(1); }
    if (SMP) REC_LOADS(S, 0);
    RBAR();
    REC_PHASE1(0, 0);
    RBAR();
#pragma clang loop unroll(disable)
    for (int c = 0; c < count; ++c) {
        const int c1 = c + 1 < count ? c + 1 : last, c2 = c + 2 < count ? c + 2 : last;
        if (ABL_ON(4)) { REC_LOADQK(c2); REC_LOADV(c1); REC_LOADG(c); }
        if (SMP) REC_LOADS(Sn, c1);
        LAS unsigned char* qb = lds + RQK_OFF + (c % 3) * 32768; LAS unsigned char* vb = lds + RV_OFF + (c & 1) * 16384; LAS unsigned char* pb = lds + RP_OFF + (c & 1) * RP_BYTES;
        const float dcur = (RET && SMP) ? exp2f(8.0f * log2f(1.0f - exp2f(-5.0f - (float)REC_HEAD(c)))) : dconst;
        bf16x8 bv[NKS];
#pragma unroll
        for (int ks = 0; ks < NKS; ++ks) bv[ks] = cat8(lds_tr(vb + VB[0] + 8192 * ks), lds_tr(vb + VB[1] + 8192 * ks));
        f32x4 O[NT];
#pragma unroll
        for (int ti = 0; ti < NT; ++ti) O[ti] = (f32x4){0.f, 0.f, 0.f, 0.f};
        if (ABL_ON(16))
#pragma unroll
        for (int k4 = 0; k4 < 4; ++k4) {
            const bf16x8 as = pack8(S[2 * k4], S[2 * k4 + 1]);
#pragma unroll
            for (int ti = 0; ti < NT; ++ti) {
                const s16x4 lo = *(const LAS s16x4*)(qb + QB[0] + 4096 * ti + 512 * k4), hi = *(const LAS s16x4*)(qb + QB[1] + 4096 * ti + 512 * k4);
                O[ti] = __builtin_amdgcn_mfma_f32_16x16x32_bf16(as, cat8(lo, hi), O[ti], 0, 0, 0); }
        }
#pragma unroll
        for (int ti = 0; ti < NT; ++ti)
#pragma unroll
            for (int ks = 0; ks < NKS; ++ks) if (ks <= (ti >> 1)) {
                const bf16x8 bp = *(const LAS bf16x8*)(pb + PR + 2304 * ti + 64 * ks);
                O[ti] = __builtin_amdgcn_mfma_f32_16x16x32_bf16(bv[ks], bp, O[ti], 0, 0, 0); }
        if (ABL_ON(8))
#pragma unroll
        for (int i = 0; i < 8; ++i) {
#pragma unroll
            for (int ks = 0; ks < NKS; ++ks) { const bf16x8 ak = cat8(lds_tr(qb + 16384 + KB[0][i & 1] + 8192 * ks + 512 * (i >> 1)), lds_tr(qb + 16384 + KB[1][i & 1] + 8192 * ks + 512 * (i >> 1)));
                S[i] = __builtin_amdgcn_mfma_f32_16x16x32_bf16(ak, bv[ks], S[i], 0, 0, 0); }
            if (RET) S[i] = S[i] * dcur; else S[i] = S[i] * *(const LAS f32x4*)(lds + RDVEC_OFF + (c % 3) * 512 + (16 * i + 4 * g) * 4);
            if (i & 1) __builtin_amdgcn_sched_barrier(0);
        }
        if (SMP) {
            float* p_ = s_out + (size_t)(first + c * stride) * HD * HD + (size_t)(4 * g) * HD + 16 * w + c16;
#pragma unroll
            for (int i = 0; i < 8; ++i) {
#pragma unroll
                for (int r = 0; r < 4; ++r) p_[(16 * i + r) * HD] = S[i][r]; }
#pragma unroll
            for (int i = 0; i < 8; ++i) S[i] = Sn[i];
        }
        { LAS float* st = (LAS float*)(lds + RSTAT_OFF + (c & 1) * RSTAT_BYTES);
#pragma unroll
          for (int ti = 0; ti < NT; ++ti) { const f32x4 o = O[ti]; float s2 = (o[0] * o[0] + o[1] * o[1]) + (o[2] * o[2] + o[3] * o[3]), s1 = (o[0] + o[1]) + (o[2] + o[3]);
              s2 += __shfl_xor(s2, 16); s2 += __shfl_xor(s2, 32); if (RET) { s1 += __shfl_xor(s1, 16); s1 += __shfl_xor(s1, 32); }
              if (g == 0 && ABL_ON(1)) { st[512 + (16 * ti + c16) * 8 + w] = s2; if (RET) st[(16 * ti + c16) * 8 + w] = s1; } } }
        if (ABL_ON(32)) REC_PHASE1((c + 1) % 3, (c + 1) & 1);
        REC_STOREQK(c + 2);
        REC_STOREV(c + 1);
        RBAR();
        { LAS float* st = (LAS float*)(lds + RSTAT_OFF + (c & 1) * RSTAT_BYTES);
          const int row0_ = REC_ROW0(c);
          char* ob = (char*)OHAT + ((size_t)(row0_ >> 4) * 128 + (RET ? 64 : 0) + REC_HEAD(c) * 16) * 256 + (SMP ? (row0_ & 8) * 16 : 0);
          if (SMP && c16 >= 8) ob = (char*)dummy;
#pragma unroll
          for (int ti = 0; ti < NT; ++ti) {
              const f32x4 a2 = *(const LAS f32x4*)(st + 512 + (16 * ti + c16) * 8), b2 = *(const LAS f32x4*)(st + 512 + (16 * ti + c16) * 8 + 4);
              const float m2 = ((a2[0] + a2[1]) + (a2[2] + a2[3])) + ((b2[0] + b2[1]) + (b2[2] + b2[3])); float mu = 0.f, rs;
              if (RET) { const f32x4 a1 = *(const LAS f32x4*)(st + (16 * ti + c16) * 8), b1 = *(const LAS f32x4*)(st + (16 * ti + c16) * 8 + 4);
                  mu = (((a1[0] + a1[1]) + (a1[2] + a1[3])) + ((b1[0] + b1[1]) + (b1[2] + b1[3]))) * (1.0f / HD); rs = __builtin_amdgcn_rsqf(fmaxf(m2 * (1.0f / HD) - mu * mu, 0.f) + 1e-6f); }
              else rs = __builtin_amdgcn_rsqf(m2 * (1.0f / HD) + 1e-6f);
              const f32x4 o = (O[ti] - mu) * rs * nw;
              v2u ow; ow.x = pg8::cvt_pk_bf16(o[0] * bflo(pg[ti].x), o[1] * bfhi(pg[ti].x)); ow.y = pg8::cvt_pk_bf16(o[2] * bflo(pg[ti].y), o[3] * bfhi(pg[ti].y));
              if (ABL_ON(2)) *(v2u*)(ob + (size_t)ti * (128 * 256) + ooff) = ow; } }
    }
    if (!SMP) {
#pragma unroll
        for (int i = 0; i < 8; ++i)
#pragma unroll
            for (int r = 0; r < 4; ++r) s_out[(size_t)(16 * i + 4 * g + r) * HD + 16 * w + c16] = S[i][r];
    }
    RBAR();
#undef ABL_ON
#undef REC_ROW0
#undef REC_UB
#undef REC_HEAD
#undef REC_LOADQK
#undef REC_STOREQK
#undef REC_LOADV
#undef REC_STOREV
#undef REC_LOADG
#undef REC_LOADS
#undef REC_PTILE
#undef REC_PHASE1
}

struct Args { const float* in[17]; float* out; unsigned char* ws; };
__global__ void __launch_bounds__(NWAVES * 64, 2) hyb_fwd(Args args) {
    extern __shared__ __attribute__((aligned(16))) unsigned char lds_raw[];
    LAS unsigned char* lds = (LAS unsigned char*)lds_raw;
    volatile LAS unsigned* MISC = (volatile LAS unsigned*)(lds + MISC_OFF);
    const int tid = threadIdx.x, lane = tid & 63, wave = __builtin_amdgcn_readfirstlane(tid >> 6);
    const int G = gridDim.x; const int bx = blockIdx.x; const int vcu = (G % 8 == 0) ? (bx % 8) * (G / 8) + bx / 8 : bx;
    unsigned char* ws = args.ws;
    gu32* ctl = (gu32*)(ws + WS_CTL);
    const float* x_prompt = args.in[0]; const float* x_sample = args.in[1]; const float* state_hgrn = args.in[2]; const float* state_ret = args.in[3]; const float* state_conv = args.in[4];
    const float* w_norm1 = args.in[5]; const float* w_in = args.in[6]; const float* hgrn_lb = args.in[7]; const float* hgrn_norm_w = args.in[8]; const float* ret_norm_w = args.in[9];
    const float* w_out = args.in[10]; const float* w_norm2 = args.in[11]; const float* w_ffn_in = args.in[12]; const float* conv_w = args.in[13]; const float* conv_b = args.in[14];
    const float* w_ffn_out = args.in[15]; const float* w_norm_f = args.in[16];
    float* out_y = args.out;
    float* out_hgp = out_y + (size_t)M * D; float* out_rtp = out_hgp + (size_t)NBP * NH * HD * HD; float* out_cvp = out_rtp + (size_t)NBP * NH * HD * HD;
    float* out_hgs = out_cvp + (size_t)NBP * 2 * UPW; float* out_rts = out_hgs + (size_t)NBS * NH * HD * HD; float* out_cvs = out_rts + (size_t)NBS * NH * HD * HD;
    bf16* WIN = (bf16*)(ws + WS_WIN); bf16* WOUT = (bf16*)(ws + WS_WOUT); bf16* WUP = (bf16*)(ws + WS_WUP); bf16* WDN = (bf16*)(ws + WS_WDN);
    float2* ROPE = (float2*)(ws + WS_ROPE); float* LBT = (float*)(ws + WS_LB); float* DVP = (float*)(ws + WS_DVP); float* DVS = (float*)(ws + WS_DVS); float* SS1 = (float*)(ws + WS_SS1); float* SS2 = (float*)(ws + WS_SS2); float* SS3 = (float*)(ws + WS_SS3);
    bf16* XB = (bf16*)(ws + WS_XB); bf16* PROJ = (bf16*)(ws + WS_PROJ); bf16* OHAT = (bf16*)(ws + WS_OHAT); float* RAW = (float*)(ws + WS_RAW); bf16* ACT = (bf16*)(ws + WS_ACT);

    for (int u = tid; u < (LDS_BYTES - LDSCTL_OFF) / 4; u += NWAVES * 64) ((LAS unsigned*)(lds + LDSCTL_OFF))[u] = 0u;
    __syncthreads();
    XcdBarrier bar = xcd_barrier_post((unsigned*)(ctl + CW_BAR), MISC + 8);
    const int gw = vcu * NWAVES + wave, NGW = G * NWAVES;

#if PH_MASK & 1
    _Pragma("unroll") for (int rep_ = 0; rep_ < REPS(0); ++rep_) {
    {
        LAS float* scr = (LAS float*)(lds + RING_OFF + wave * 16384);
        constexpr int I_IN = (D / 64) * (INW / 32), I_OUT = (D / 64) * (D / 32), I_UP = (D / 64) * (UPW / 32), I_DN = (DFF / 64) * (D / 32);
        constexpr int NITEMS = I_IN + I_OUT + I_UP + I_DN;
        for (int it = gw; it < NITEMS; it += NGW) {
            int r = it;
            if (r < I_IN) { p0_transpose_item<2>(w_in, D, INW, WIN, w_norm1, scr, r, lane); continue; } r -= I_IN;
            if (r < I_OUT) { p0_transpose_item<0>(w_out, D, D, WOUT, nullptr, scr, r, lane); continue; } r -= I_OUT;
            if (r < I_UP) { p0_transpose_item<1>(w_ffn_in, D, UPW, WUP, w_norm2, scr, r, lane); continue; } r -= I_UP;
            p0_transpose_item<0>(w_ffn_out, DFF, D, WDN, nullptr, scr, r, lane);
        }
        for (int m = gw; m < M; m += NGW) x_row_to_bf16(m < MP ? x_prompt + (size_t)m * D : x_sample + (size_t)(m - MP) * D, XB + (size_t)m * D, SS1 + m, lane);
        if (bx == 0) { const float a0 = hgrn_lb[tid], a1 = hgrn_lb[512 + tid]; const float mx = fmaxf(a0, a1), e0 = expf(a0 - mx), e1 = expf(a1 - mx); LBT[tid] = e0 / (e0 + e1); }
        for (int i = vcu * 512 + tid; i < 2056 * 64; i += G * 512) {
            const int p = i >> 6, j = i & 63; const int pos = p < 2048 ? p : PAST + (p - 2048);
            const double inv = exp2(-(double)j * (13.287712379549449 / 64.0));
            float c, s; sincos_acc((double)pos * inv, c, s); ROPE[i] = make_float2(c, s);
        }
    }
    xcd_barrier(bar);

    }
#endif
#if PH_MASK & 2
    _Pragma("unroll") for (int rep_ = 0; rep_ < REPS(1); ++rep_) {
    {
        pg8::Gemm g{XB, WIN, M, INW, D}; pg8::StaticOrder S; S.init(M, INW, G, bx);
        pg8::EpiPrep E{PROJ, SS1, LBT, (const float*)ROPE, DVP, DVS};
        pg8::gemm_phase<pg8::EpiPrep, pg8::StaticOrder, true, true>(lds + RING_OFF, g, S, E);
    }
    xcd_barrier(bar);

    }
#endif
#if PH_MASK & 4
    _Pragma("unroll") for (int rep_ = 0; rep_ < REPS(2); ++rep_) {
    {
        if (bx < 64) { if (rep_ == 0) {
            const int b = (bx >> 2) & 7, h = bx & 3;
            if (bx < 32) rec_core<false, false>(lds, PROJ, DVP, hgrn_norm_w, nullptr, out_hgp + (size_t)(b * 4 + h) * HD * HD, OHAT, (bf16*)SS1, h, b, 0, 32);
            else rec_core<true, false>(lds, PROJ, DVP, ret_norm_w, nullptr, out_rtp + (size_t)(b * 4 + h) * HD * HD, OHAT, (bf16*)SS1, h, b, 0, 32);
        } else if (REP_SEL & 1) {
            const int b = (bx >> 2) & 7, h = bx & 3; float* sdum = (float*)(ws + 236 * MiB) + (size_t)bx * HD * HD;
            if (bx < 32) rec_core<false, false, REP_ABL>(lds, PROJ, DVP, hgrn_norm_w, nullptr, sdum, XB, (bf16*)SS1, h, b, 0, 32);
            else rec_core<true, false, REP_ABL>(lds, PROJ, DVP, ret_norm_w, nullptr, sdum, XB, (bf16*)SS1, h, b, 0, 32);
        } } else if (rep_ == 0 || (REP_SEL & 2)) {
            const int idx = bx - 64, nw_ = G - 64;
            const int cnt = idx < 512 ? (512 - idx + nw_ - 1) / nw_ : 0;
            if (cnt > 0) { rec_core<false, true>(lds, PROJ, DVS, hgrn_norm_w, state_hgrn, out_hgs, OHAT, (bf16*)SS1, 0, idx, nw_, cnt);
                           rec_core<true, true>(lds, PROJ, DVS, ret_norm_w, state_ret, out_rts, OHAT, (bf16*)SS1, 0, idx, nw_, cnt); }
        }
    }
    xcd_barrier(bar);

    }
#endif
#if PH_MASK & 8
    {
        pg8::Gemm g{OHAT, WOUT, M, D, D}; pg8::StaticOrder S; S.init(M, D, G, bx);
        pg8::EpiResF32 E{x_prompt, x_sample, out_y, XB, SS2};
        pg8::gemm_phase<pg8::EpiResF32, pg8::StaticOrder, true, true, true>(lds + RING_OFF, g, S, E);
    }
    xcd_barrier(bar);

#endif
#if PH_MASK & 16
    _Pragma("unroll") for (int rep_ = 0; rep_ < REPS(4); ++rep_) {
    {
        pg8::Gemm g{XB, WUP, M, UPW, D}; pg8::StaticOrder S; S.init(M, UPW, G, bx);
        pg8::EpiConvAct E{ACT, SS2, conv_w, conv_b, state_conv, RAW, out_cvp, out_cvs};
        pg8::gemm_phase<pg8::EpiConvAct, pg8::StaticOrder, true, true>(lds + RING_OFF, g, S, E);
    }
    xcd_barrier(bar);
    }

#endif
#if PH_MASK & 32
    {
        pg8::Gemm g{ACT, WDN, M, D, DFF}; pg8::StaticOrder S; S.init(M, D, G, bx);
        {
            pg8::Unit u0; const bool has = S.next(0, u0);
            if (has && u0.pm < 64) {
                for (int it = tid; it < 8 * 704; it += NWAVES * 64) {
                    const int cgp = it % 704, kj = it / 704, k = kj >> 1, j = kj & 1, blk = u0.pm * 4 + k;
                    const int tile = cgp >> 5, c4 = (cgp & 31) * 4, pcol = tile * 256 + c4, ch = tile * 128 + c4;
                    const bool first = (blk & 31) == 0;
                    const float* cur = RAW + (size_t)(blk * 4 + j) * UPW + pcol;
                    const float* p1 = first ? cur : (j == 0 ? RAW + (size_t)((blk - 1) * 4 + 3) * UPW + pcol : RAW + (size_t)(blk * 4) * UPW + pcol);
                    const float* p2 = first ? cur : (j == 0 ? RAW + (size_t)((blk - 1) * 4 + 2) * UPW + pcol : RAW + (size_t)((blk - 1) * 4 + 3) * UPW + pcol);
                    if (first && j == 1) p1 = RAW + (size_t)(blk * 4) * UPW + pcol;
                    const float z1 = (first && j == 0) ? 0.f : 1.f, z2 = first ? 0.f : 1.f;
                    const f32x4 cu_ = *(const f32x4*)cur, cg_ = *(const f32x4*)(cur + 128), u1 = *(const f32x4*)p1 * z1, g1 = *(const f32x4*)(p1 + 128) * z1, u2 = *(const f32x4*)p2 * z2, g2 = *(const f32x4*)(p2 + 128) * z2;
                    const f32x4 cu = *(const f32x4*)(conv_b + ch) + *(const f32x4*)(conv_w + ch) * u2 + *(const f32x4*)(conv_w + UPW + ch) * u1 + *(const f32x4*)(conv_w + 2 * UPW + ch) * cu_;
                    const f32x4 cg = *(const f32x4*)(conv_b + DFF + ch) + *(const f32x4*)(conv_w + DFF + ch) * g2 + *(const f32x4*)(conv_w + UPW + DFF + ch) * g1 + *(const f32x4*)(conv_w + 2 * UPW + DFF + ch) * cg_;
                    v2u ow; ow.x = pk2(silu_f(cg[0]) * cu[0], silu_f(cg[1]) * cu[1]); ow.y = pk2(silu_f(cg[2]) * cu[2], silu_f(cg[3]) * cu[3]);
                    *(v2u*)(ACT + (size_t)(blk * 64 + j) * DFF + ch) = ow;
                }
            }
            VM_WAIT(); __syncthreads();
        }
        pg8::EpiResF32 E{out_y, out_y + (size_t)MP * D, out_y, nullptr, SS3};
        pg8::gemm_phase<pg8::EpiResF32, pg8::StaticOrder, true, true>(lds + RING_OFF, g, S, E);
    }
    xcd_barrier(bar);

#endif
#if PH_MASK & 64
    for (int m = gw; m < M; m += NGW) {
        const float r = 1.0f / sqrtf(SS3[m] * (1.0f / D) + 1e-6f);
        GAS f32x4* xr = (GAS f32x4*)(out_y + (size_t)m * D) + lane; const GAS f32x4* wf = (const GAS f32x4*)w_norm_f + lane;
#pragma unroll
        for (int j = 0; j < 4; ++j) { const f32x4 v = xr[64 * j], w = wf[64 * j]; xr[64 * j] = v * r * w; }
    }
#endif
}

extern "C" void kernel_launch(void* const* d_in, const int* in_sizes, int n_in, void* d_out, int out_size, void* d_ws, size_t ws_size, hipStream_t stream) {
    static int grid = 0;
    if (grid == 0) {
        if (n_in != 17 || ws_size < WS_END) { fprintf(stderr, "kernel_launch: unexpected inputs (n_in %d, ws %zu); nothing launched\n", n_in, ws_size); grid = -1; return; }
        int dev = 0, cus = 0, per_cu = 0;
        if (hipGetDevice(&dev) != hipSuccess || hipDeviceGetAttribute(&cus, hipDeviceAttributeMultiprocessorCount, dev) != hipSuccess) { grid = -1; return; }
        if (hipFuncSetAttribute((const void*)hyb_fwd, hipFuncAttributeMaxDynamicSharedMemorySize, LDS_BYTES) != hipSuccess) { fprintf(stderr, "kernel_launch: hipFuncSetAttribute failed\n"); grid = -1; return; }
        if (hipOccupancyMaxActiveBlocksPerMultiprocessor(&per_cu, (const void*)hyb_fwd, NWAVES * 64, LDS_BYTES) != hipSuccess || per_cu < 1)
            fprintf(stderr, "kernel_launch: note: occupancy query reports %d workgroups per CU\n", per_cu);
        (void)hipGetLastError();
        grid = cus;
    }
    if (grid < 0) return;
    if (hipMemsetAsync((char*)d_ws + WS_CTL, 0, CTL_ZERO_BYTES, stream) != hipSuccess) return;
    Args a{};
    for (int i = 0; i < 17; ++i) a.in[i] = (const float*)d_in[i];
    a.out = (float*)d_out; a.ws = (unsigned char*)d_ws;
    hipLaunchKernelGGL(hyb_fwd, dim3(grid), dim3(NWAVES * 64), LDS_BYTES, stream, a);
}
```

```cpp
#include <hip/hip_runtime.h>
#include <cstdio>
#include <cstdint>
namespace pg8 {
#define PG8_LAS __attribute__((address_space(3)))
typedef unsigned short bf16_t;
typedef short bf16x8 __attribute__((ext_vector_type(8)));
typedef float f32x4 __attribute__((ext_vector_type(4)));
typedef unsigned u32x4 __attribute__((ext_vector_type(4)));
typedef unsigned u32x2 __attribute__((ext_vector_type(2)));
constexpr int BM = 256, BK = 64, HALF = 128, HTB = HALF * BK * 2  , STAGE_BYTES = 8 * HTB, NXCD = 8, WGM = 8;

__host__ __device__ __forceinline__ int lds_byte(int r, int c) { const int st = (r >> 4) * 2 + (c >> 5), rr = r & 15, cc = c & 31, ob = rr * 64 + cc * 2; return st * 1024 + (ob ^ (((ob >> 9) & 1) << 5)); }
__host__ __device__ __forceinline__ void stage_rc(int b, int& R, int& C) { const int st = b / 1024, sb = b % 1024, swz = sb ^ (((sb >> 9) & 1) << 5); R = (st >> 1) * 16 + swz / 64; C = (st & 1) * 32 + (swz % 64) / 2; }
__host__ __device__ __forceinline__ int perm32(int rho) { const int n = rho >> 4, i = rho & 15; return 8 * (i >> 2) + 4 * n + (i & 3); }

struct Unit { int pm, pn, ks; };
struct Gemm { const bf16_t* A; const bf16_t* Bt; int M, N, K, ld; };

struct StaticOrder {
    int nM, nN, nwg, G, c;
    __host__ __device__ __forceinline__ void init(int M, int N, int G_, int c_) { nM = M / BM; nN = N / BM; nwg = nM * nN; G = G_; c = c_; }
    __host__ __device__ __forceinline__ bool next(int i, Unit& u) const {
        const long L = (long)i * G + c; if (L >= nwg) return false;
        int wgid = (int)L; { const int q = nwg / NXCD, r = nwg % NXCD, xcd = wgid % NXCD, off = wgid / NXCD; wgid = (xcd < r ? xcd * (q + 1) : r * (q + 1) + (xcd - r) * q) + off; }
        const int nig = WGM * nN, gid = wgid / nig, fm = gid * WGM, gsz = (nM - fm) < WGM ? (nM - fm) : WGM;
        u.pm = fm + ((wgid % nig) % gsz); u.pn = (wgid % nig) / gsz; u.ks = 0; return true;
    }
    __device__ __forceinline__ void a_ready(const Unit&) const {}
    __device__ __forceinline__ void done(const Unit&) const {}
};
struct SplitKOrder {
    int pm0, nm, nn, nks, G, c;
    __device__ __forceinline__ bool next(int i, Unit& u) const { const int L = i * G + c; if (L >= nm * nn * nks) return false; u.ks = L % nks; const int t = L / nks; u.pn = t % nn; u.pm = pm0 + t / nn; return true; }
    __device__ __forceinline__ void a_ready(const Unit&) const {}
    __device__ __forceinline__ void done(const Unit&) const {}
};
typedef __bf16 bf16x2_t __attribute__((ext_vector_type(2)));
typedef float f32x2_t __attribute__((ext_vector_type(2)));
__device__ __forceinline__ unsigned cvt_pk_bf16(float lo, float hi) { const f32x2_t v = {lo, hi}; return __builtin_bit_cast(unsigned, __builtin_convertvector(v, bf16x2_t)); }
constexpr float RMS_EPS = 1e-6f;
struct EpiScaleBf16 {
    static constexpr bool PERM = true, AFTER_DRAIN = false;
    bf16_t* O; int ldc; const float* ss;
    __device__ __forceinline__ void operator()(const f32x4 (&acc)[2][2][4][2], const Unit& u, int wr, int wc, int fr, int fq) const {
        const int row0 = u.pm * BM + wr * 64 + fr, col0 = u.pn * BM + wc * 32 + 8 * fq;
#pragma unroll
        for (int ai = 0; ai < 2; ++ai)
#pragma unroll
            for (int m = 0; m < 4; ++m) { const int row = row0 + ai * HALF + m * 16; const float r = 1.0f / sqrtf(ss[row] * (1.0f / 1024.0f) + RMS_EPS);
                bf16_t* rowp = O + (size_t)row * ldc + col0;
#pragma unroll
                for (int bj = 0; bj < 2; ++bj) { const f32x4 v0 = acc[ai][bj][m][0] * r, v1 = acc[ai][bj][m][1] * r;
                    u32x4 w; w.x = cvt_pk_bf16(v0[0], v0[1]); w.y = cvt_pk_bf16(v0[2], v0[3]); w.z = cvt_pk_bf16(v1[0], v1[1]); w.w = cvt_pk_bf16(v1[2], v1[3]);
                    *(u32x4*)(rowp + bj * HALF) = w; } }
    }
};
struct EpiResF32 {
    static constexpr bool PERM = false, AFTER_DRAIN = false;
    const float* Xp; const float* Xs; float* out; bf16_t* xb; float* ss;
    __device__ __forceinline__ void operator()(const f32x4 (&acc)[2][2][4][2], const Unit& u, int wr, int wc, int fr, int fq) const {
        const int row0 = u.pm * BM + wr * 64 + fr, col0 = u.pn * BM + wc * 32 + 4 * fq;
        const float* X = u.pm < 64 ? Xp : Xs - (size_t)16384 * 1024;
#pragma unroll
        for (int ai = 0; ai < 2; ++ai)
#pragma unroll
            for (int m = 0; m < 4; ++m) { const int row = row0 + ai * HALF + m * 16; const size_t off = (size_t)row * 1024 + col0; float sq = 0.f;
#pragma unroll
                for (int bj = 0; bj < 2; ++bj)
#pragma unroll
                    for (int n = 0; n < 2; ++n) { const f32x4 x = *(const f32x4*)(X + off + bj * HALF + n * 16) + acc[ai][bj][m][n];
                        *(f32x4*)(out + off + bj * HALF + n * 16) = x; sq += (x[0] * x[0] + x[1] * x[1]) + (x[2] * x[2] + x[3] * x[3]);
                        if (xb) { u32x2 w; w.x = cvt_pk_bf16(x[0], x[1]); w.y = cvt_pk_bf16(x[2], x[3]); *(u32x2*)(xb + off + bj * HALF + n * 16) = w; } }
                if (ss) { sq += __shfl_xor(sq, 16); sq += __shfl_xor(sq, 32); if (fq == 0) atomicAdd(ss + row, sq); } }
    }
};

__device__ __forceinline__ float fexp2(float x) { return __builtin_amdgcn_exp2f(x); }
__device__ __forceinline__ float flog2(float x) { return __builtin_amdgcn_logf(x); }
__device__ __forceinline__ float frcp(float x) { return __builtin_amdgcn_rcpf(x); }
__device__ __forceinline__ float fsigmoid(float x) { return frcp(1.0f + fexp2(-1.4426950408889634f * x)); }
struct EpiPrep {
    static constexpr bool PERM = true, AFTER_DRAIN = false;
    bf16_t* RB; const float* ss; const float* LB; const float* ROPE; float* DVP; float* DVS;
    __device__ __forceinline__ void operator()(const f32x4 (&acc)[2][2][4][2], const Unit& u, int wr, int wc, int fr, int fq) const {
        asm volatile("" : "+v"(fr), "+v"(fq));
        const int kind = u.pn & 1, hp = u.pn >> 1;
        const int row0 = u.pm * BM + wr * 64 + fr, cp = wc * 32 + 8 * fq;
        const bool smp = u.pm >= 64;
        float r[2][4];
#pragma unroll
        for (int ai = 0; ai < 2; ++ai)
#pragma unroll
            for (int m = 0; m < 4; ++m) r[ai][m] = 1.0f / sqrtf(ss[row0 + ai * HALF + m * 16] * (1.0f / 1024.0f) + RMS_EPS);
        bf16_t* base = RB + (size_t)row0 * 4096 + u.pn * BM + cp;
        if (kind == 1) {
#pragma unroll
            for (int ai = 0; ai < 2; ++ai)
#pragma unroll
                for (int m = 0; m < 4; ++m) { bf16_t* rowp = base + (size_t)(ai * HALF + m * 16) * 4096; const float rr = r[ai][m];
                    { const f32x4 v0 = acc[ai][0][m][0] * rr, v1 = acc[ai][0][m][1] * rr;
                      u32x4 w; w.x = cvt_pk_bf16(v0[0], v0[1]); w.y = cvt_pk_bf16(v0[2], v0[3]); w.z = cvt_pk_bf16(v1[0], v1[1]); w.w = cvt_pk_bf16(v1[2], v1[3]); *(u32x4*)rowp = w; }
                    { f32x4 v0 = acc[ai][1][m][0] * rr, v1 = acc[ai][1][m][1] * rr;
#pragma unroll
                      for (int e = 0; e < 4; ++e) { v0[e] = v0[e] * fsigmoid(v0[e]); v1[e] = v1[e] * fsigmoid(v1[e]); }
                      u32x4 w; w.x = cvt_pk_bf16(v0[0], v0[1]); w.y = cvt_pk_bf16(v0[2], v0[3]); w.z = cvt_pk_bf16(v1[0], v1[1]); w.w = cvt_pk_bf16(v1[2], v1[3]); *(u32x4*)(rowp + HALF) = w; } }
        } else if (hp < 4) {
            float lbv[8];
#pragma unroll
            for (int c = 0; c < 8; ++c) lbv[c] = LB[hp * 128 + cp + c];
#pragma unroll
            for (int ai = 0; ai < 2; ++ai) {
                unsigned Qp[4][4], Kp[4][4];
#pragma unroll
                for (int cpair = 0; cpair < 4; ++cpair) {
                    float qo[2][4], ko[2][4];
#pragma unroll
                    for (int cc = 0; cc < 2; ++cc) { const int c = 2 * cpair + cc, n = c >> 2, e = c & 3;
                        float lf[4], kk[4];
#pragma unroll
                        for (int m = 0; m < 4; ++m) { const float fa = acc[ai][1][m][n][e] * r[ai][m]; const float f = lbv[c] + (1.0f - lbv[c]) * fsigmoid(fa); lf[m] = flog2(f); kk[m] = 1.0f - f; }
                        if (!smp) {
#pragma unroll
                            for (int m = 0; m < 4; ++m) {
#pragma unroll
                                for (int d = 1; d < 16; d <<= 1) { const float t = __shfl_up(lf[m], d, 16); if (fr >= d) lf[m] += t; } }
                            float carry = 0.f;
#pragma unroll
                            for (int m = 0; m < 4; ++m) { lf[m] += carry; carry = __shfl(lf[m], 15, 16); }
                            if (fr == 15) DVP[((size_t)((u.pm * 4 + ai * 2 + wr) * 4 + hp)) * 128 + cp + c] = fexp2(lf[3]);
                        } else {
#pragma unroll
                            for (int m = 0; m < 4; ++m) {
#pragma unroll
                                for (int d = 1; d < 8; d <<= 1) { const float t = __shfl_up(lf[m], d, 8); if ((fr & 7) >= d) lf[m] += t; }
                                if ((fr & 7) == 7) { const int seq = (u.pm - 64) * 32 + ai * 16 + wr * 8 + m * 2 + (fr >> 3); DVS[((size_t)(seq * 4 + hp)) * 128 + cp + c] = fexp2(lf[m]); } }
                        }
#pragma unroll
                        for (int m = 0; m < 4; ++m) { const float eb = fexp2(lf[m]); qo[cc][m] = acc[ai][0][m][n][e] * r[ai][m] * eb; ko[cc][m] = kk[m] * frcp(eb); }
                    }
#pragma unroll
                    for (int m = 0; m < 4; ++m) { Qp[m][cpair] = cvt_pk_bf16(qo[0][m], qo[1][m]); Kp[m][cpair] = cvt_pk_bf16(ko[0][m], ko[1][m]); }
                }
#pragma unroll
                for (int m = 0; m < 4; ++m) { bf16_t* rowp = base + (size_t)(ai * HALF + m * 16) * 4096;
                    u32x4 w; w.x = Qp[m][0]; w.y = Qp[m][1]; w.z = Qp[m][2]; w.w = Qp[m][3]; *(u32x4*)rowp = w;
                    u32x4 k; k.x = Kp[m][0]; k.y = Kp[m][1]; k.z = Kp[m][2]; k.w = Kp[m][3]; *(u32x4*)(rowp + HALF) = k; }
            }
        } else {
            const int h = hp - 4; const float lg = flog2(1.0f - fexp2(-5.0f - (float)h));
            const bool isk = wc >= 2; const int j0 = cp & 63;
            bf16_t* obase = RB + (size_t)row0 * 4096 + u.pn * BM + (isk ? 128 : 0) + j0;
#pragma unroll
            for (int ai = 0; ai < 2; ++ai)
#pragma unroll
                for (int m = 0; m < 4; ++m) { const int row = row0 + ai * HALF + m * 16; const int p = smp ? 2048 + (row & 7) : (row & 2047), tau = smp ? (row & 7) : (row & 63);
                    const float dec = fexp2((float)(tau + 1) * lg); const float sc = (isk ? 0.08838834764831845f * frcp(dec) : dec) * r[ai][m];
                    const f32x4* tp = (const f32x4*)(ROPE + ((size_t)p * 64 + j0) * 2); const f32x4 t0 = tp[0], t1 = tp[1], t2 = tp[2], t3 = tp[3];
                    const float cs[8] = {t0[0], t0[2], t1[0], t1[2], t2[0], t2[2], t3[0], t3[2]}, sn[8] = {t0[1], t0[3], t1[1], t1[3], t2[1], t2[3], t3[1], t3[3]};
                    float o1[8], o2[8];
#pragma unroll
                    for (int c = 0; c < 8; ++c) { const float x1 = acc[ai][0][m][c >> 2][c & 3] * sc, x2 = acc[ai][1][m][c >> 2][c & 3] * sc; o1[c] = x1 * cs[c] - x2 * sn[c]; o2[c] = x1 * sn[c] + x2 * cs[c]; }
                    bf16_t* rowp = obase + (size_t)(ai * HALF + m * 16) * 4096;
                    u32x4 w; w.x = cvt_pk_bf16(o1[0], o1[1]); w.y = cvt_pk_bf16(o1[2], o1[3]); w.z = cvt_pk_bf16(o1[4], o1[5]); w.w = cvt_pk_bf16(o1[6], o1[7]); *(u32x4*)rowp = w;
                    u32x4 k; k.x = cvt_pk_bf16(o2[0], o2[1]); k.y = cvt_pk_bf16(o2[2], o2[3]); k.z = cvt_pk_bf16(o2[4], o2[5]); k.w = cvt_pk_bf16(o2[6], o2[7]); *(u32x4*)(rowp + 64) = k; }
        }
    }
};

template <int CTRL> __device__ __forceinline__ float dpp_keep(float oldv, float src) {
    return __builtin_bit_cast(float, __builtin_amdgcn_update_dpp(__builtin_bit_cast(int, oldv), __builtin_bit_cast(int, src), CTRL, 0xf, 0xf, false)); }
struct EpiConvAct {
    static constexpr bool PERM = true, AFTER_DRAIN = false;
    bf16_t* ACT; const float* ss; const float* cw; const float* cb; const float* sconv; float* RAW; float* cvp; float* cvs;
    __device__ __forceinline__ void operator()(const f32x4 (&acc)[2][2][4][2], const Unit& u, int wr, int wc, int fr, int fq) const {
        asm volatile("" : "+v"(fr), "+v"(fq));
        const int row0 = u.pm * BM + wr * 64 + fr, cp = wc * 32 + 8 * fq;
        const bool smp = u.pm >= 64;
        float r[2][4];
#pragma unroll
        for (int ai = 0; ai < 2; ++ai)
#pragma unroll
            for (int m = 0; m < 4; ++m) r[ai][m] = __builtin_amdgcn_rsqf(ss[row0 + ai * HALF + m * 16] * (1.0f / 1024.0f) + RMS_EPS);
#pragma unroll
        for (int n = 0; n < 2; ++n) {
            const int ch0 = u.pn * 128 + cp + 4 * n;
            f32x4 wu[3], wg[3];
#pragma unroll
            for (int j = 0; j < 3; ++j) { wu[j] = *(const f32x4*)(cw + j * 5632 + ch0); wg[j] = *(const f32x4*)(cw + j * 5632 + 2816 + ch0); }
            const f32x4 bu = *(const f32x4*)(cb + ch0), bg = *(const f32x4*)(cb + 2816 + ch0);
#pragma unroll
            for (int ai = 0; ai < 2; ++ai) {
                f32x4 Up = {0.f, 0.f, 0.f, 0.f}, Gp = {0.f, 0.f, 0.f, 0.f};
#pragma unroll
                for (int m = 0; m < 4; ++m) {
                    const int row = row0 + ai * HALF + m * 16;
                    const f32x4 U = acc[ai][0][m][n] * r[ai][m], G = acc[ai][1][m][n] * r[ai][m];
                    f32x4 u1, u2, g1, g2;
#pragma unroll
                    for (int e = 0; e < 4; ++e) {
                        u1[e] = dpp_keep<0x111>(dpp_keep<0x121>(Up[e], Up[e]), U[e]); u2[e] = dpp_keep<0x112>(dpp_keep<0x122>(Up[e], Up[e]), U[e]);
                        g1[e] = dpp_keep<0x111>(dpp_keep<0x121>(Gp[e], Gp[e]), G[e]); g2[e] = dpp_keep<0x112>(dpp_keep<0x122>(Gp[e], Gp[e]), G[e]); }
                    if (smp) {
                        const int t = fr & 7, seq = (u.pm - 64) * 32 + ai * 16 + wr * 8 + m * 2 + (fr >> 3);
                        if (t < 2) { const float* sp = sconv + (size_t)(seq * 2) * 5632 + ch0;
                            const f32x4 b1u = *(const f32x4*)(sp + 5632), b1g = *(const f32x4*)(sp + 5632 + 2816);
                            if (t == 0) { u2 = *(const f32x4*)sp; g2 = *(const f32x4*)(sp + 2816); u1 = b1u; g1 = b1g; } else { u2 = b1u; g2 = b1g; } }
                        if (t >= 6) { float* cp_ = cvs + (size_t)(seq * 2 + (t - 6)) * 5632 + ch0; *(f32x4*)cp_ = U; *(f32x4*)(cp_ + 2816) = G; }
                    } else {
                        const int blk = u.pm * 4 + ai * 2 + wr;
                        if (m == 0 && fr < 2) { float* rp = RAW + (size_t)(blk * 4 + fr) * 5632 + u.pn * 256 + cp + 4 * n; *(f32x4*)rp = U; *(f32x4*)(rp + 128) = G; }
                        if (m == 3 && fr >= 14) { float* rp = RAW + (size_t)(blk * 4 + fr - 12) * 5632 + u.pn * 256 + cp + 4 * n; *(f32x4*)rp = U; *(f32x4*)(rp + 128) = G;
                            if ((blk & 31) == 31) { float* cp_ = cvp + (size_t)((blk >> 5) * 2 + (fr - 14)) * 5632 + ch0; *(f32x4*)cp_ = U; *(f32x4*)(cp_ + 2816) = G; } }
                    }
                    const f32x4 cu = bu + wu[0] * u2 + wu[1] * u1 + wu[2] * U, cg = bg + wg[0] * g2 + wg[1] * g1 + wg[2] * G;
                    f32x4 a;
#pragma unroll
                    for (int e = 0; e < 4; ++e) a[e] = cg[e] * fsigmoid(cg[e]) * cu[e];
                    u32x2 w; w.x = cvt_pk_bf16(a[0], a[1]); w.y = cvt_pk_bf16(a[2], a[3]);
                    if (smp || m > 0 || fr >= 2) *(u32x2*)(ACT + (size_t)row * 2816 + ch0) = w;
                    Up = U; Gp = G;
                }
            }
        }
    }
};

struct EpiSlab {
    static constexpr bool PERM = false, AFTER_DRAIN = false;
    float* slab; int pm0, ldc; size_t slab_stride;
    __device__ __forceinline__ void operator()(const f32x4 (&acc)[2][2][4][2], const Unit& u, int wr, int wc, int fr, int fq) const {
        const int row0 = (u.pm - pm0) * BM + wr * 64 + fr, col0 = u.pn * BM + wc * 32 + 4 * fq;
        float* base = slab + (size_t)u.ks * slab_stride;
#pragma unroll
        for (int ai = 0; ai < 2; ++ai)
#pragma unroll
            for (int m = 0; m < 4; ++m) { float* rowp = base + (size_t)(row0 + ai * HALF + m * 16) * ldc + col0;
#pragma unroll
                for (int bj = 0; bj < 2; ++bj)
#pragma unroll
                    for (int n = 0; n < 2; ++n) *(f32x4*)(rowp + bj * HALF + n * 16) = acc[ai][bj][m][n]; }
    }
};
template <class Epi, class Sched, bool ALIGN_EPI = false, bool SP2 = false, bool ABLK = false>
__device__ __forceinline__ void gemm_phase(PG8_LAS unsigned char* lds, const Gemm g, const Sched& S, const Epi& E) {
    int tid = threadIdx.x; asm volatile("" : "+v"(tid));
    const int wid = __builtin_amdgcn_readfirstlane(tid >> 6), lane = tid & 63, wr = wid >> 2, wc = wid & 3, fr = lane & 15, fq = lane >> 4;
    const int K = g.K, ld = g.ld, nt = K / BK;
    unsigned voffA[2], voffB[2];
#pragma unroll
    for (int i = 0; i < 2; ++i) { int R, C; stage_rc(tid * 16 + i * 8192, R, C); const int Rb = Epi::PERM ? ((R & ~31) + perm32(R & 31)) : R;
        voffA[i] = ABLK ? (unsigned)(((R >> 4) * (ld >> 3) + (C >> 3)) * 256 + (R & 15) * 16) : (unsigned)(R * ld + C) * 2u; voffB[i] = (unsigned)(Rb * ld + C) * 2u; }
    const size_t kstep = (size_t)(BK * 2), kstepA = ABLK ? (size_t)(BK / 8) * 256 : kstep;
    const size_t hstep = (size_t)HALF * ld * 2, sstep = (size_t)K * 2;
    const size_t tstep = 2 * hstep;
    const unsigned ldsw = (unsigned)wid * 1024u;
    const int aoff = lds_byte(wr * 64 + fr, fq * 8), boff = lds_byte(wc * 32 + fr, fq * 8);
#define PG8_SA(b, h) (((b) * 2 + (h)) * HTB)
#define PG8_SB(b, h) ((4 + (b) * 2 + (h)) * HTB)
#define PG8_STAGE(bufoff, gbase, voff) do { _Pragma("unroll") for (int _i = 0; _i < 2; ++_i) \
        __builtin_amdgcn_global_load_lds((const unsigned*)((const char*)(gbase) + (voff)[_i]), (PG8_LAS unsigned*)(lds + (bufoff) + ldsw + _i * 8192), 16, 0, 0); } while (0)
#define PG8_LDA(dst, b, h) do { _Pragma("unroll") for (int m = 0; m < 4; ++m) _Pragma("unroll") for (int k = 0; k < 2; ++k) dst[m][k] = *(const PG8_LAS bf16x8*)(lds + PG8_SA(b, h) + aoff + m * 2048 + k * 1024); } while (0)
#define PG8_LDB(dst, b, h) do { _Pragma("unroll") for (int n = 0; n < 2; ++n) _Pragma("unroll") for (int k = 0; k < 2; ++k) dst[n][k] = *(const PG8_LAS bf16x8*)(lds + PG8_SB(b, h) + boff + n * 2048 + k * 1024); } while (0)
#define PG8_MMA(ai, bj, At, Bt) do { __builtin_amdgcn_s_setprio(1); _Pragma("unroll") for (int m = 0; m < 4; ++m) _Pragma("unroll") for (int n = 0; n < 2; ++n) _Pragma("unroll") for (int k = 0; k < 2; ++k) \
        acc[ai][bj][m][n] = __builtin_amdgcn_mfma_f32_16x16x32_bf16(Bt[n][k], At[m][k], acc[ai][bj][m][n], 0, 0, 0); __builtin_amdgcn_s_setprio(0); } while (0)
#define PG8_WAIT_V(n) asm volatile("s_waitcnt vmcnt(" #n ")" ::: "memory")
#define PG8_WAIT_L(n) asm volatile("s_waitcnt lgkmcnt(" #n ")" ::: "memory")
#define PG8_BAR __builtin_amdgcn_s_barrier()
#define PG8_SCHED __builtin_amdgcn_sched_barrier(0)
    Unit cur, nxt; int ui = 0;
    if (!S.next(0, cur)) return;
    f32x4 acc[2][2][4][2];
#pragma unroll
    for (int a = 0; a < 2; ++a)
#pragma unroll
        for (int b = 0; b < 2; ++b)
#pragma unroll
            for (int m = 0; m < 4; ++m)
#pragma unroll
                for (int n = 0; n < 2; ++n) acc[a][b][m][n] = (f32x4){0.f, 0.f, 0.f, 0.f};
    bf16x8 At[4][2], B0[2][2], B1[2][2];
    const char* cA = (const char*)g.A + (size_t)cur.pm * tstep + (size_t)cur.ks * sstep; const char* cB = (const char*)g.Bt + (size_t)cur.pn * tstep + (size_t)cur.ks * sstep;
    S.a_ready(cur);
    if constexpr (SP2) {
        PG8_STAGE(PG8_SB(0, 0), cB, voffB); PG8_STAGE(PG8_SB(0, 1), cB + hstep, voffB); PG8_STAGE(PG8_SA(0, 0), cA, voffA); PG8_STAGE(PG8_SA(0, 1), cA + hstep, voffA);
        if (wr == 1) PG8_BAR;
        PG8_WAIT_V(2); PG8_BAR;
        PG8_STAGE(PG8_SB(1, 0), cB + kstep, voffB); PG8_STAGE(PG8_SA(1, 0), cA + kstepA, voffA); PG8_STAGE(PG8_SB(1, 1), cB + hstep + kstep, voffB);
        PG8_WAIT_V(6); PG8_BAR;
    } else {
        PG8_STAGE(PG8_SB(0, 0), cB, voffB); PG8_STAGE(PG8_SA(0, 0), cA, voffA); PG8_STAGE(PG8_SB(0, 1), cB + hstep, voffB); PG8_STAGE(PG8_SA(0, 1), cA + hstep, voffA);
        if (wr == 1) PG8_BAR;
        PG8_WAIT_V(4); PG8_BAR;
        PG8_STAGE(PG8_SB(1, 0), cB + kstep, voffB); PG8_STAGE(PG8_SA(1, 0), cA + kstepA, voffA); PG8_STAGE(PG8_SB(1, 1), cB + hstep + kstep, voffB);
        PG8_WAIT_V(6); PG8_BAR;
    }
    for (;;) {
        const bool has_next = S.next(ui + 1, nxt);
        const char* nA = has_next ? (const char*)g.A + (size_t)nxt.pm * tstep + (size_t)nxt.ks * sstep : cA; const char* nB = has_next ? (const char*)g.Bt + (size_t)nxt.pn * tstep + (size_t)nxt.ks * sstep : cB;
        for (int t = 0; t < nt; t += 2) {
            const bool last = (t == nt - 2);
            const char* a1 = cA + (size_t)(t + 1) * kstepA;
            const char* a2 = last ? nA : cA + (size_t)(t + 2) * kstepA; const char* b2 = last ? nB : cB + (size_t)(t + 2) * kstep;
            const char* a3 = a2 + kstepA; const char* b3 = b2 + kstep;
            if (last && has_next) S.a_ready(nxt);
            if constexpr (SP2) {
            PG8_LDB(B0, 0, 0); PG8_LDB(B1, 0, 1); PG8_SCHED; PG8_LDA(At, 0, 0); PG8_STAGE(PG8_SA(1, 1), a1 + hstep, voffA);
            PG8_WAIT_V(8); PG8_WAIT_L(0); PG8_BAR; PG8_MMA(0, 0, At, B0); PG8_MMA(0, 1, At, B1); PG8_BAR; PG8_SCHED;
            PG8_LDA(At, 0, 1); PG8_STAGE(PG8_SB(0, 0), b2, voffB); PG8_STAGE(PG8_SB(0, 1), b2 + hstep, voffB); PG8_STAGE(PG8_SA(0, 0), a2, voffA);
            PG8_WAIT_V(8); PG8_WAIT_L(0); PG8_BAR; PG8_MMA(1, 0, At, B0); PG8_MMA(1, 1, At, B1); PG8_BAR; PG8_SCHED;
            PG8_LDB(B0, 1, 0); PG8_LDB(B1, 1, 1); PG8_SCHED; PG8_LDA(At, 1, 0); PG8_STAGE(PG8_SA(0, 1), a2 + hstep, voffA);
            PG8_WAIT_V(8); PG8_WAIT_L(0); PG8_BAR; PG8_MMA(0, 0, At, B0); PG8_MMA(0, 1, At, B1); PG8_BAR; PG8_SCHED;
            PG8_LDA(At, 1, 1); PG8_STAGE(PG8_SB(1, 0), b3, voffB); PG8_STAGE(PG8_SB(1, 1), b3 + hstep, voffB); PG8_STAGE(PG8_SA(1, 0), a3, voffA);
            PG8_WAIT_V(8); PG8_WAIT_L(0); PG8_BAR; PG8_MMA(1, 0, At, B0); PG8_MMA(1, 1, At, B1); PG8_BAR; PG8_SCHED;
            } else {
            PG8_LDB(B0, 0, 0); PG8_SCHED; PG8_LDA(At, 0, 0); PG8_STAGE(PG8_SA(1, 1), a1 + hstep, voffA);
            PG8_WAIT_L(8); PG8_BAR; PG8_WAIT_L(0); PG8_MMA(0, 0, At, B0); PG8_BAR; PG8_SCHED;
            PG8_LDB(B1, 0, 1); PG8_STAGE(PG8_SB(0, 0), b2, voffB);
            PG8_BAR; PG8_WAIT_L(0); PG8_MMA(0, 1, At, B1); PG8_BAR;
            PG8_LDA(At, 0, 1); PG8_STAGE(PG8_SA(0, 0), a2, voffA);
            PG8_BAR; PG8_WAIT_L(0); PG8_MMA(1, 0, At, B0); PG8_BAR; PG8_SCHED;
            PG8_STAGE(PG8_SB(0, 1), b2 + hstep, voffB);
            PG8_WAIT_V(6); PG8_BAR; PG8_MMA(1, 1, At, B1); PG8_BAR;
            PG8_LDB(B0, 1, 0); PG8_SCHED; PG8_LDA(At, 1, 0); PG8_STAGE(PG8_SA(0, 1), a2 + hstep, voffA);
            PG8_WAIT_L(8); PG8_BAR; PG8_WAIT_L(0); PG8_MMA(0, 0, At, B0); PG8_BAR; PG8_SCHED;
            PG8_LDB(B1, 1, 1); PG8_STAGE(PG8_SB(1, 0), b3, voffB);
            PG8_BAR; PG8_WAIT_L(0); PG8_MMA(0, 1, At, B1); PG8_BAR;
            PG8_LDA(At, 1, 1); PG8_STAGE(PG8_SA(1, 0), a3, voffA);
            PG8_BAR; PG8_WAIT_L(0); PG8_MMA(1, 0, At, B0); PG8_BAR; PG8_SCHED;
            PG8_STAGE(PG8_SB(1, 1), b3 + hstep, voffB);
            PG8_WAIT_V(6); PG8_BAR; PG8_MMA(1, 1, At, B1); PG8_BAR;
            }
        }
        if constexpr (ALIGN_EPI) { if (wr == 0) PG8_BAR; }
        if constexpr (!Epi::AFTER_DRAIN) { E(acc, cur, wr, wc, fr, fq); S.done(cur); }
        if (!has_next) break;
#pragma unroll
        for (int a = 0; a < 2; ++a)
#pragma unroll
            for (int b = 0; b < 2; ++b)
#pragma unroll
                for (int m = 0; m < 4; ++m)
#pragma unroll
                    for (int n = 0; n < 2; ++n) acc[a][b][m][n] = (f32x4){0.f, 0.f, 0.f, 0.f};
        cur = nxt; cA = nA; cB = nB; ++ui;
        if constexpr (ALIGN_EPI) { if (wr == 1) PG8_BAR; }
    }
    PG8_WAIT_V(0);
    if constexpr (!ALIGN_EPI) { if (wr == 0) PG8_BAR; }
    PG8_BAR;
    if constexpr (Epi::AFTER_DRAIN) { E.fused(acc, cur, wr, wc, fr, fq, lds, wid, lane); S.done(cur); }
#undef PG8_SA
#undef PG8_SB
#undef PG8_STAGE
#undef PG8_LDA
#undef PG8_LDB
#undef PG8_MMA
#undef PG8_WAIT_V
#undef PG8_WAIT_L
#undef PG8_BAR
#undef PG8_SCHED
}
}
constexpr int NWAVES = 8;
constexpr int D = 1024, MP = 16384, MS = 1024, M = MP + MS;
constexpr int TP = 2048, NBP = 8, TS = 8, NBS = 128, PAST = 16384;
constexpr int INW = 4096, DFF = 2816, UPW = 5632, HD = 128, NH = 4;
constexpr size_t MiB = 1u << 20, KiB = 1024;
constexpr size_t WS_CTL = 0, CTL_ZERO_BYTES = 320 * KiB;
constexpr size_t WS_SS2 = 64 * KiB, WS_SS3 = 192 * KiB;
constexpr size_t WS_WIN = 1 * MiB, WS_WOUT = 9 * MiB, WS_WUP = 11 * MiB, WS_WDN = 22 * MiB;
constexpr size_t WS_ROPE = 28 * MiB;
constexpr size_t WS_SS1 = 30 * MiB;
constexpr size_t WS_LB = 30 * MiB + 96 * KiB;
constexpr size_t WS_DVP = 30 * MiB + 128 * KiB;
constexpr size_t WS_DVS = 30 * MiB + 640 * KiB;
constexpr size_t WS_XB = 32 * MiB;
constexpr size_t WS_PROJ = 66 * MiB;
constexpr size_t WS_OHAT = 202 * MiB;
constexpr size_t WS_RAW = 66 * MiB, WS_ACT = 160 * MiB;
constexpr size_t WS_SLAB = 96 * MiB;
constexpr size_t WS_END = 256 * MiB;
static_assert(WS_WDN + (size_t)D * DFF * 2 <= WS_ROPE && WS_ROPE + 2056 * 64 * 8 <= WS_SS1 && WS_SS1 + M * 4 <= WS_XB && WS_XB + (size_t)M * D * 2 <= WS_PROJ, "ws map 1");
static_assert(WS_PROJ + (size_t)M * INW * 2 <= WS_OHAT && WS_OHAT + (size_t)M * D * 2 <= WS_END && WS_RAW + (size_t)(M / 64) * 4 * UPW * 4 <= WS_ACT && WS_ACT + (size_t)M * DFF * 2 <= WS_END, "ws map 2");
static_assert(WS_RAW + (size_t)(M / 64) * 4 * UPW * 4 <= WS_SLAB && WS_SLAB + (size_t)11 * MS * D * 4 <= WS_ACT, "ws map 3");
constexpr int CW_TMO = 0, CW_CODE = 1, CW_BAR = 4096, CW_SUB = 8192;
constexpr int RING_OFF = 0, RING_BYTES = 131072;
constexpr int LDSCTL_OFF = RING_BYTES, MISC_OFF = LDSCTL_OFF + 320;
constexpr int LDS_BYTES = 163840;
constexpr int RQK_OFF = 0, RV_OFF = 98304, RP_OFF = MISC_OFF + 128, RP_STRIDE = 144, RP_BYTES = 64 * RP_STRIDE, RSTAT_OFF = RP_OFF + 2 * RP_BYTES, RSTAT_BYTES = 4096, RDVEC_OFF = RSTAT_OFF + 2 * RSTAT_BYTES, R_END = RDVEC_OFF + 1536;
static_assert(RP_OFF % 16 == 0 && R_END <= LDS_BYTES, "LDS map");
#define GAS __attribute__((address_space(1)))
#define LAS __attribute__((address_space(3)))
typedef unsigned short bf16;
typedef unsigned v4u __attribute__((ext_vector_type(4)));
typedef unsigned v2u __attribute__((ext_vector_type(2)));
typedef float f32x4 __attribute__((ext_vector_type(4)));
typedef GAS unsigned gu32;
#define RLX_AGENT __ATOMIC_RELAXED, __HIP_MEMORY_SCOPE_AGENT
#define LDS_WAIT() asm volatile("s_waitcnt lgkmcnt(0)" ::: "memory")
#define VM_WAIT() asm volatile("s_waitcnt vmcnt(0)" ::: "memory")
__device__ __forceinline__ unsigned f2bf(float f) { unsigned u = __builtin_bit_cast(unsigned, f); return (u + 0x7fffu + ((u >> 16) & 1u)) >> 16; }
__device__ __forceinline__ unsigned pk2(float lo, float hi) { return f2bf(lo) | (f2bf(hi) << 16); }
__device__ __forceinline__ float bf2f(unsigned short h) { return __builtin_bit_cast(float, (unsigned)h << 16); }
__device__ __forceinline__ float bflo(unsigned w) { return __builtin_bit_cast(float, w << 16); }
__device__ __forceinline__ float bfhi(unsigned w) { return __builtin_bit_cast(float, w & 0xffff0000u); }

#define XB_TMO      128
#define XB_XCNT(j)  (256  + 64 * (j))
#define XB_XSUB(j)  (1280 + 64 * (j))
#define XB_XGEN(j)  (2304 + 64 * (j))
#define XB_TOP      3328
#define XB_TOPGEN   3392
#define XCD_BAR_WORDS 3456
#define XB_SPIN_CAP (1u << 18)

__device__ __forceinline__ unsigned xb_ld(unsigned* p)              { return __hip_atomic_load(p, __ATOMIC_RELAXED, __HIP_MEMORY_SCOPE_AGENT); }
__device__ __forceinline__ unsigned xb_add(unsigned* p, unsigned v) { return __hip_atomic_fetch_add(p, v, __ATOMIC_RELAXED, __HIP_MEMORY_SCOPE_AGENT); }
__device__ __forceinline__ unsigned xb_xcc_id() { return (unsigned)__builtin_amdgcn_s_getreg((3 << 11) | 20) & 0xFu; }
#define XB_SPIN(cond, bar) do { unsigned _sp = 0; while (cond) { __builtin_amdgcn_s_sleep(1); \
    if ((++_sp & 255u) == 0u) { if (xb_ld(&(bar)[XB_TMO])) break; if (_sp > XB_SPIN_CAP) { atomicAdd(&(bar)[XB_TMO], 1u); break; } } } } while (0)

struct XcdBarrier {
    unsigned* bar; unsigned x;
    volatile LAS unsigned* st;
};

__device__ __forceinline__ XcdBarrier xcd_barrier_post(unsigned* bar, volatile LAS unsigned* st) {
    XcdBarrier b; b.bar = bar; b.x = xb_xcc_id(); b.st = st;
    if (threadIdx.x == 0) (void)xb_add(&bar[XB_XCNT(b.x)], 1u);
    return b;
}
__device__ __forceinline__ void xcd_barrier_complete(unsigned* bar, unsigned x, unsigned& nloc, unsigned& nx) {
    const unsigned G = gridDim.x * gridDim.y * gridDim.z;
    unsigned sum, cnt, mine, sp = 0u;
    for (;;) {
        sum = 0u; cnt = 0u; mine = 0u;
#pragma unroll
        for (unsigned j = 0; j < 16; ++j) { const unsigned c = xb_ld(&bar[XB_XCNT(j)]); sum += c; cnt += (c > 0u) ? 1u : 0u; mine = (j == x) ? c : mine; }
        if (sum == G) break;
        __builtin_amdgcn_s_sleep(1);
        if ((++sp & 255u) == 0u) { if (xb_ld(&bar[XB_TMO])) break; if (sp > XB_SPIN_CAP) { atomicAdd(&bar[XB_TMO], 1u); break; } }
    }
    nloc = mine > 0u ? mine : 1u; nx = cnt > 0u ? cnt : 1u;
}

__device__ __forceinline__ void xcd_barrier(const XcdBarrier& b) {
    asm volatile("s_waitcnt vmcnt(0)" ::: "memory");
    __syncthreads();
    if (threadIdx.x == 0) {
        unsigned* bar = b.bar;
        __builtin_amdgcn_s_waitcnt(0);
        unsigned nloc = b.st[0], nx = b.st[1];
        if (nloc == 0u) { xcd_barrier_complete(bar, b.x, nloc, nx); b.st[0] = nloc; b.st[1] = nx; }
        const unsigned old = xb_add(&bar[XB_XSUB(b.x)], 1u);
        const unsigned gen = old / nloc;
        if (old + 1u == (gen + 1u) * nloc) {
            __builtin_amdgcn_fence(__ATOMIC_RELEASE, "agent");
            asm volatile("s_waitcnt vmcnt(0)" ::: "memory");
            const unsigned og = xb_add(&bar[XB_TOP], 1u);
            const unsigned tg = og / nx;
            if (og + 1u == (tg + 1u) * nx) xb_add(&bar[XB_TOPGEN], 1u);
            else XB_SPIN(xb_ld(&bar[XB_TOPGEN]) == tg, bar);
            __builtin_amdgcn_fence(__ATOMIC_ACQUIRE, "agent");
            xb_add(&bar[XB_XGEN(b.x)], 1u);
            asm volatile("s_waitcnt vmcnt(0)" ::: "memory");
        } else {
            XB_SPIN(xb_ld(&bar[XB_XGEN(b.x)]) == gen, bar);
            __builtin_amdgcn_fence(__ATOMIC_ACQUIRE, "agent");
            asm volatile("s_waitcnt vmcnt(0)" ::: "memory");
        }
    }
    __syncthreads();
}
#ifndef PH_MASK
#define PH_MASK 127
#endif
#ifndef REP_MASK
#define REP_MASK 0
#endif
#define REPS(k) ((((REP_MASK) >> (k)) & 1) + 1)
#ifndef REP_ABL
#define REP_ABL 0
#endif
#ifndef REP_SEL
#define REP_SEL 3
#endif
__device__ __forceinline__ float wave_sum(float v) {
#pragma unroll
    for (int o = 1; o < 64; o <<= 1) v += __shfl_xor(v, o);
    return v;
}
__device__ __forceinline__ float silu_f(float x) { return x / (1.0f + expf(-x)); }
__device__ __forceinline__ void sincos_acc(double ang, float& c, float& s) {
    const double TWO_OVER_PI = 0.63661977236758134308, PIO2_HI = 1.57079632679489655800e+00, PIO2_LO = 6.12323399573676603587e-17;
    const double q = rint(ang * TWO_OVER_PI);
    double r = fma(-q, PIO2_HI, ang); r = fma(-q, PIO2_LO, r);
    const int n = ((int)q) & 3;
    const double z = r * r;
    const double S1 = -1.66666666666666324348e-01, S2 = 8.33333333332248946124e-03, S3 = -1.98412698298579493134e-04, S4 = 2.75573137070700676789e-06, S5 = -2.50507602534068634195e-08, S6 = 1.58969099521155010221e-10;
    const double C1 = 4.16666666666666019037e-02, C2 = -1.38888888888741095749e-03, C3 = 2.48015872894767294178e-05, C4 = -2.75573143513906633035e-07, C5 = 2.08757232129817482790e-09, C6 = -1.13596475577881948265e-11;
    const double sn = r + r * z * (S1 + z * (S2 + z * (S3 + z * (S4 + z * (S5 + z * S6)))));
    const double cs = 1.0 - 0.5 * z + z * z * (C1 + z * (C2 + z * (C3 + z * (C4 + z * (C5 + z * C6)))));
    double sv, cv;
    if (n == 0) { sv = sn; cv = cs; } else if (n == 1) { sv = cs; cv = -sn; } else if (n == 2) { sv = -sn; cv = -cs; } else { sv = -cs; cv = sn; }
    c = (float)cv; s = (float)sv;
}
__device__ __forceinline__ int up_col_map(int n) { const int g = n >= DFF ? 1 : 0, ch = n - g * DFF; return (ch >> 7) * 256 + g * 128 + (ch & 127); }
__device__ __forceinline__ int in_col_map(int n) {
    const int grp = n >> 11, part = (n >> 9) & 3, h = (n >> 7) & 3, c = n & 127, hp = grp * 4 + h;
    if (part >= 2) return (2 * hp + 1) * 256 + (part - 2) * 128 + c;
    if (grp == 0) return (2 * hp) * 256 + part * 128 + c;
    return (2 * hp) * 256 + (c >> 6) * 128 + part * 64 + (c & 63);
}
template <int MAPMODE>
__device__ __forceinline__ void p0_transpose_item(const float* W, int K, int N, bf16* WT, const float* kscale, LAS float* scr, int item, int lane) {
    const int nblk = N / 32, kb = item / nblk, nb = item % nblk, k0 = 64 * kb, n0 = 32 * nb;
#pragma unroll 8
    for (int i = 0; i < 32; ++i) { const int kk = 2 * i + (lane >> 5); const float sc = kscale ? kscale[k0 + kk] : 1.0f; scr[kk * 33 + (lane & 31)] = W[(size_t)(k0 + kk) * N + n0 + (lane & 31)] * sc; }
    LDS_WAIT(); asm volatile("" ::: "memory");
    const int c = lane & 7;
    const int r0 = MAPMODE == 1 ? up_col_map(n0) : MAPMODE == 2 ? in_col_map(n0) : n0;
#pragma unroll
    for (int j = 0; j < 4; ++j) { const int n = (lane >> 3) + 8 * j; const LAS float* s = scr + (8 * c) * 33 + n;
        v4u o; o.x = pk2(s[0 * 33], s[1 * 33]); o.y = pk2(s[2 * 33], s[3 * 33]); o.z = pk2(s[4 * 33], s[5 * 33]); o.w = pk2(s[6 * 33], s[7 * 33]);
        *(GAS v4u*)(WT + (size_t)(r0 + n) * K + k0 + 8 * c) = o; }
    LDS_WAIT(); asm volatile("" ::: "memory");
}
__device__ __forceinline__ void x_row_to_bf16(const float* xrow, bf16* orow, float* ss, int lane) {
    const GAS f32x4* xr = (const GAS f32x4*)xrow + lane;
    f32x4 v[4]; float s = 0.f;
#pragma unroll
    for (int j = 0; j < 4; ++j) { v[j] = xr[64 * j]; s += (v[j].x * v[j].x + v[j].y * v[j].y) + (v[j].z * v[j].z + v[j].w * v[j].w); }
    s = wave_sum(s);
    if (lane == 0) *ss = s;
    GAS unsigned long long* o8 = (GAS unsigned long long*)orow + lane;
#pragma unroll
    for (int j = 0; j < 4; ++j) o8[64 * j] = (unsigned long long)pk2(v[j].x, v[j].y) | ((unsigned long long)pk2(v[j].z, v[j].w) << 32);
}

typedef short bf16x8 __attribute__((ext_vector_type(8)));
typedef short s16x4 __attribute__((ext_vector_type(4)));
template <int CTRL> __device__ __forceinline__ float dppf(float x) { return __builtin_bit_cast(float, __builtin_amdgcn_update_dpp(0, __builtin_bit_cast(int, x), CTRL, 0xf, 0xf, true)); }
__device__ __forceinline__ float row16_sum(float x) { x += dppf<0xB1>(x); x += dppf<0x4E>(x); x += dppf<0x141>(x); x += dppf<0x140>(x); return x; }
__device__ __forceinline__ unsigned off_b(unsigned row, unsigned ch) { return 2048u * (row >> 3) + 512u * (ch >> 2) + 64u * (row & 7) + 16u * ((ch & 3) ^ ((row >> 2) & 3)); }
__device__ __forceinline__ unsigned row_read_addr_16(unsigned lane, unsigned rb, unsigned s) { return off_b((lane & 15) + 16 * rb, 4 * s + (lane >> 4)); }
__device__ __forceinline__ unsigned tr_read_addr_16(unsigned lane, unsigned c, unsigned ks, unsigned t) {
    const unsigned g = lane >> 4, q = (lane & 15) >> 2, p = lane & 3; return off_b(32 * ks + 8 * g + 4 * t + q, 2 * c + (p >> 1)) + 8 * (p & 1); }
__device__ __forceinline__ s16x4 lds_tr(LAS unsigned char* p) { return __builtin_amdgcn_ds_read_tr16_b64_v4i16((LAS s16x4*)p); }
__device__ __forceinline__ bf16x8 cat8(s16x4 a, s16x4 b) { bf16x8 r; r[0] = a[0]; r[1] = a[1]; r[2] = a[2]; r[3] = a[3]; r[4] = b[0]; r[5] = b[1]; r[6] = b[2]; r[7] = b[3]; return r; }
__device__ __forceinline__ bf16x8 pack8(f32x4 a, f32x4 b) { v4u w; w.x = pg8::cvt_pk_bf16(a[0], a[1]); w.y = pg8::cvt_pk_bf16(a[2], a[3]); w.z = pg8::cvt_pk_bf16(b[0], b[1]); w.w = pg8::cvt_pk_bf16(b[2], b[3]); return __builtin_bit_cast(bf16x8, w); }
#define RBAR() do { asm volatile("s_waitcnt lgkmcnt(0)" ::: "memory"); __builtin_amdgcn_s_barrier(); asm volatile("" ::: "memory"); } while (0)

template <bool RET, bool SMP, int ABL = 0>
__device__ __forceinline__ void rec_core(LAS unsigned char* lds, const bf16* RB, const float* DV, const float* normw, const float* s_in, float* s_out, bf16* OHAT, bf16* dummy, int h, int first, int stride, int count) {
    constexpr int NT = SMP ? 1 : 4, NKS = SMP ? 1 : 2, NQK = SMP ? 1 : 4, NV = SMP ? 1 : 2;
    int tid = threadIdx.x; asm volatile("" : "+v"(tid));
    const int w = __builtin_amdgcn_readfirstlane(tid >> 6), l = tid & 63, g = l >> 4, c16 = l & 15;
    const int hp = (RET ? 4 : 0) + h;
    const float dconst = RET ? exp2f((SMP ? 8.0f : 64.0f) * log2f(1.0f - exp2f(-5.0f - (float)h))) : 1.0f;
    const f32x4 nw = *(const f32x4*)(normw + 16 * w + 4 * g);
    const unsigned q_ = c16 >> 2, p_l = c16 & 3, p1_ = p_l >> 1;
    unsigned KB[2][2], VB[2], QB[2];
#pragma unroll
    for (int t = 0; t < 2; ++t) {
#pragma unroll
        for (int ib = 0; ib < 2; ++ib) KB[t][ib] = 2048u * g + 64u * q_ + 8u * (p_l & 1) + 256u * t + 32u * (ib ^ (g & 1)) + 16u * (p1_ ^ t);
        VB[t] = 2048u * g + 64u * q_ + 8u * (p_l & 1) + 256u * t + 32u * ((w & 1) ^ (g & 1)) + 16u * (p1_ ^ t) + 512u * (w >> 1);
    }
    const unsigned RR = 2048u * (c16 >> 3) + 64u * (c16 & 7) + 16u * (g ^ ((c16 >> 2) & 3));
#pragma unroll
    for (int e = 0; e < 2; ++e) QB[e] = 2048u * (c16 >> 3) + 64u * (c16 & 7) + 16u * ((2 * e + (g >> 1)) ^ ((c16 >> 2) & 3)) + 8u * (g & 1);
    const unsigned WQ = 2048u * (tid >> 8) + 512u * ((tid & 15) >> 2) + 64u * ((tid >> 5) & 7) + 16u * ((tid & 3) ^ ((tid >> 7) & 3)) + 16384u * ((tid & 31) >> 4);
    const unsigned WV = 2048u * (tid >> 7) + 512u * ((tid & 15) >> 2) + 64u * ((tid >> 4) & 7) + 16u * ((tid & 3) ^ ((tid >> 6) & 3));
    const unsigned PW = RP_STRIDE * c16 + 8u * g, PR = RP_STRIDE * c16 + 16u * g;
#define REC_ROW0(c) (SMP ? MP + (((first) + (c) * (stride)) >> 2) * TS : (first) * TP + (c) * 64)
#define REC_HEAD(c) (SMP ? (((first) + (c) * (stride)) & 3) : h)
    v4u pq[NQK], pv[NV]; v2u pg[NT]; f32x4 pfd = {0.f, 0.f, 0.f, 0.f};
    const bool ldq = SMP ? tid < 256 : true, ldv = SMP ? tid < 128 : true;
    const unsigned qoff = ((unsigned)(SMP ? (tid >> 5) & 7 : tid >> 5) * INW + (tid & 31) * 8) * 2u, voff = ((unsigned)(SMP ? (tid >> 4) & 7 : tid >> 4) * INW + 256 + (tid & 15) * 8) * 2u;
    const unsigned goff = ((unsigned)(SMP ? (c16 & 7) : c16) * INW + 384 + 16 * w + 4 * g) * 2u, ooff = (unsigned)(2 * w + (g >> 1)) * 256u + (unsigned)c16 * 16u + (g & 1) * 8u;
#define REC_UB(c) ((const char*)RB + ((size_t)REC_ROW0(c) * INW + (RET ? 2048 : 0) + REC_HEAD(c) * 512) * 2)
#define REC_LOADQK(c) do { { const char* ub_ = REC_UB(c); \
        _Pragma("unroll") for (int i_ = 0; i_ < NQK; ++i_) pq[i_] = *(const v4u*)(ub_ + (size_t)i_ * (16 * INW * 2) + qoff); } \
        if (!RET) pfd = *(const f32x4*)(DV + (SMP ? (size_t)((first) + (c) * (stride)) : (size_t)(((first) * 32 + (c)) * 4 + h)) * 128 + (tid & 31) * 4); } while (0)
#define REC_STOREQK(c) do { if (ldq) { _Pragma("unroll") for (int i_ = 0; i_ < NQK; ++i_) *(LAS v4u*)(lds + RQK_OFF + ((c) % 3) * 32768 + WQ + 4096 * i_) = pq[i_]; } \
        if (!RET && tid < 32) *(LAS f32x4*)(lds + RDVEC_OFF + ((c) % 3) * 512 + tid * 16) = pfd; } while (0)
#define REC_LOADV(c) do { { const char* ub_ = REC_UB(c); \
        _Pragma("unroll") for (int i_ = 0; i_ < NV; ++i_) pv[i_] = *(const v4u*)(ub_ + (size_t)i_ * (32 * INW * 2) + voff); } } while (0)
#define REC_STOREV(c) do { if (ldv) { _Pragma("unroll") for (int i_ = 0; i_ < NV; ++i_) *(LAS v4u*)(lds + RV_OFF + ((c) & 1) * 16384 + WV + 8192 * i_) = pv[i_]; } } while (0)
#define REC_LOADG(c) do { const char* ub_ = REC_UB(c); \
        _Pragma("unroll") for (int ti_ = 0; ti_ < NT; ++ti_) pg[ti_] = *(const v2u*)(ub_ + (size_t)ti_ * (16 * INW * 2) + goff); } while (0)
#define REC_PTILE(slot, pb, ti, si) do { f32x4 a_ = {0.f, 0.f, 0.f, 0.f}; \
        _Pragma("unroll") for (int ks_ = 0; ks_ < 4; ++ks_) { const bf16x8 ak_ = *(const LAS bf16x8*)(lds + RQK_OFF + (slot) * 32768 + 16384 + RR + 4096 * (si) + 512 * ks_); \
            const bf16x8 bq_ = *(const LAS bf16x8*)(lds + RQK_OFF + (slot) * 32768 + RR + 4096 * (ti) + 512 * ks_); a_ = __builtin_amdgcn_mfma_f32_16x16x32_bf16(ak_, bq_, a_, 0, 0, 0); } \
        if ((si) == (ti)) { _Pragma("unroll") for (int r_ = 0; r_ < 4; ++r_) a_[r_] = (4 * g + r_ <= c16) ? a_[r_] : 0.f; } \
        v2u pw_; pw_.x = pg8::cvt_pk_bf16(a_[0], a_[1]); pw_.y = pg8::cvt_pk_bf16(a_[2], a_[3]); \
        *(LAS v2u*)(lds + RP_OFF + (pb) * RP_BYTES + PW + 2304 * (ti) + 32 * (si)) = pw_; } while (0)
#define REC_PHASE1(slot, pb) do { if (SMP) { if (w == 0) REC_PTILE(slot, pb, 0, 0); } else { switch (w) { case 0: REC_PTILE(slot, pb, 0, 0); REC_PTILE(slot, pb, 3, 2); break; case 1: REC_PTILE(slot, pb, 1, 0); REC_PTILE(slot, pb, 3, 3); break; \
        case 2: REC_PTILE(slot, pb, 1, 1); break; case 3: REC_PTILE(slot, pb, 2, 0); break; case 4: REC_PTILE(slot, pb, 2, 1); break; case 5: REC_PTILE(slot, pb, 2, 2); break; case 6: REC_PTILE(slot, pb, 3, 0); break; default: REC_PTILE(slot, pb, 3, 1); break; } } } while (0)
    f32x4 S[8], Sn[8];
    if (tid < 256) { const int t = tid >> 2, q4 = tid & 3; const int ti = t >> 4; if (ti == 0 || ti == 2) { *(LAS v2u*)(lds + RP_OFF + t * RP_STRIDE + (16 * (ti + 1) + 4 * q4) * 2) = (v2u){0u, 0u}; *(LAS v2u*)(lds + RP_OFF + RP_BYTES + t * RP_STRIDE + (16 * (ti + 1) + 4 * q4) * 2) = (v2u){0u, 0u}; } }
    if (SMP) { for (int q = tid; q < 8 * 24 * 16; q += 512) { const int slot = q / (24 * 16), rr = 8 + (q / 16) % 24, ch = q & 15;
            const int base = slot < 6 ? RQK_OFF + (slot >> 1) * 32768 + (slot & 1) * 16384 : RV_OFF + (slot - 6) * 16384; *(LAS v4u*)(lds + base + off_b(rr, ch)) = (v4u){0u, 0u, 0u, 0u}; } }
    if (!SMP) {
#pragma unroll
        for (int i = 0; i < 8; ++i) S[i] = (f32x4){0.f, 0.f, 0.f, 0.f};
    }
#define REC_LOADS(dst, c) do { const float* p_ = s_in + (size_t)((first) + (c) * (stride)) * HD * HD + (size_t)(4 * g) * HD + 16 * w + c16; \
        _Pragma("unroll") for (int i_ = 0; i_ < 8; ++i_) { _Pragma("unroll") for (int r_ = 0; r_ < 4; ++r_) dst[i_][r_] = p_[(16 * i_ + r_) * HD]; } } while (0)
    const int last = count - 1; const bool never = count > (1 << 20);
#define ABL_ON(bit) (!(ABL & (bit)) || never)
    REC_LOADQK(0); REC_LOADV(0); REC_STOREQK(0); REC_STOREV(0);
    { const int c1 = last < 1 ? last : 1; REC_LOADQK(c1); REC_STOREQK(1); }
    if (SMP) REC_LOADS(S, 0);
    RBAR();
    REC_PHASE1(0, 0);
    RBAR();
#pragma clang loop unroll(disable)
    for (int c = 0; c < count; ++c) {
        const int c1 = c + 1 < count ? c + 1 : last, c2 = c + 2 < count ? c + 2 : last;
        if (ABL_ON(4)) { REC_LOADQK(c2); REC_LOADV(c1); REC_LOADG(c); }
        if (SMP) REC_LOADS(Sn, c1);
        LAS unsigned char* qb = lds + RQK_OFF + (c % 3) * 32768; LAS unsigned char* vb = lds + RV_OFF + (c & 1) * 16384; LAS unsigned char* pb = lds + RP_OFF + (c & 1) * RP_BYTES;
        const float dcur = (RET && SMP) ? exp2f(8.0f * log2f(1.0f - exp2f(-5.0f - (float)REC_HEAD(c)))) : dconst;
        bf16x8 bv[NKS];
#pragma unroll
        for (int ks = 0; ks < NKS; ++ks) bv[ks] = cat8(lds_tr(vb + VB[0] + 8192 * ks), lds_tr(vb + VB[1] + 8192 * ks));
        f32x4 O[NT];
#pragma unroll
        for (int ti = 0; ti < NT; ++ti) O[ti] = (f32x4){0.f, 0.f, 0.f, 0.f};
        if (ABL_ON(16))
#pragma unroll
        for (int k4 = 0; k4 < 4; ++k4) {
            const bf16x8 as = pack8(S[2 * k4], S[2 * k4 + 1]);
#pragma unroll
            for (int ti = 0; ti < NT; ++ti) {
                const s16x4 lo = *(const LAS s16x4*)(qb + QB[0] + 4096 * ti + 512 * k4), hi = *(const LAS s16x4*)(qb + QB[1] + 4096 * ti + 512 * k4);
                O[ti] = __builtin_amdgcn_mfma_f32_16x16x32_bf16(as, cat8(lo, hi), O[ti], 0, 0, 0); }
        }
#pragma unroll
        for (int ti = 0; ti < NT; ++ti)
#pragma unroll
            for (int ks = 0; ks < NKS; ++ks) if (ks <= (ti >> 1)) {
                const bf16x8 bp = *(const LAS bf16x8*)(pb + PR + 2304 * ti + 64 * ks);
                O[ti] = __builtin_amdgcn_mfma_f32_16x16x32_bf16(bv[ks], bp, O[ti], 0, 0, 0); }
        if (ABL_ON(8))
#pragma unroll
        for (int i = 0; i < 8; ++i) {
#pragma unroll
            for (int ks = 0; ks < NKS; ++ks) { const bf16x8 ak = cat8(lds_tr(qb + 16384 + KB[0][i & 1] + 8192 * ks + 512 * (i >> 1)), lds_tr(qb + 16384 + KB[1][i & 1] + 8192 * ks + 512 * (i >> 1)));
                S[i] = __builtin_amdgcn_mfma_f32_16x16x32_bf16(ak, bv[ks], S[i], 0, 0, 0); }
            if (RET) S[i] = S[i] * dcur; else S[i] = S[i] * *(const LAS f32x4*)(lds + RDVEC_OFF + (c % 3) * 512 + (16 * i + 4 * g) * 4);
            if (i & 1) __builtin_amdgcn_sched_barrier(0);
        }
        if (SMP) {
            float* p_ = s_out + (size_t)(first + c * stride) * HD * HD + (size_t)(4 * g) * HD + 16 * w + c16;
#pragma unroll
            for (int i = 0; i < 8; ++i) {
#pragma unroll
                for (int r = 0; r < 4; ++r) p_[(16 * i + r) * HD] = S[i][r]; }
#pragma unroll
            for (int i = 0; i < 8; ++i) S[i] = Sn[i];
        }
        { LAS float* st = (LAS float*)(lds + RSTAT_OFF + (c & 1) * RSTAT_BYTES);
#pragma unroll
          for (int ti = 0; ti < NT; ++ti) { const f32x4 o = O[ti]; float s2 = (o[0] * o[0] + o[1] * o[1]) + (o[2] * o[2] + o[3] * o[3]), s1 = (o[0] + o[1]) + (o[2] + o[3]);
              s2 += __shfl_xor(s2, 16); s2 += __shfl_xor(s2, 32); if (RET) { s1 += __shfl_xor(s1, 16); s1 += __shfl_xor(s1, 32); }
              if (g == 0 && ABL_ON(1)) { st[512 + (16 * ti + c16) * 8 + w] = s2; if (RET) st[(16 * ti + c16) * 8 + w] = s1; } } }
        if (ABL_ON(32)) REC_PHASE1((c + 1) % 3, (c + 1) & 1);
        REC_STOREQK(c + 2);
        REC_STOREV(c + 1);
        RBAR();
        { LAS float* st = (LAS float*)(lds + RSTAT_OFF + (c & 1) * RSTAT_BYTES);
          const int row0_ = REC_ROW0(c);
          char* ob = (char*)OHAT + ((size_t)(row0_ >> 4) * 128 + (RET ? 64 : 0) + REC_HEAD(c) * 16) * 256 + (SMP ? (row0_ & 8) * 16 : 0);
          if (SMP && c16 >= 8) ob = (char*)dummy;
#pragma unroll
          for (int ti = 0; ti < NT; ++ti) {
              const f32x4 a2 = *(const LAS f32x4*)(st + 512 + (16 * ti + c16) * 8), b2 = *(const LAS f32x4*)(st + 512 + (16 * ti + c16) * 8 + 4);
              const float m2 = ((a2[0] + a2[1]) + (a2[2] + a2[3])) + ((b2[0] + b2[1]) + (b2[2] + b2[3])); float mu = 0.f, rs;
              if (RET) { const f32x4 a1 = *(const LAS f32x4*)(st + (16 * ti + c16) * 8), b1 = *(const LAS f32x4*)(st + (16 * ti + c16) * 8 + 4);
                  mu = (((a1[0] + a1[1]) + (a1[2] + a1[3])) + ((b1[0] + b1[1]) + (b1[2] + b1[3]))) * (1.0f / HD); rs = __builtin_amdgcn_rsqf(fmaxf(m2 * (1.0f / HD) - mu * mu, 0.f) + 1e-6f); }
              else rs = __builtin_amdgcn_rsqf(m2 * (1.0f / HD) + 1e-6f);
              const f32x4 o = (O[ti] - mu) * rs * nw;
              v2u ow; ow.x = pg8::cvt_pk_bf16(o[0] * bflo(pg[ti].x), o[1] * bfhi(pg[ti].x)); ow.y = pg8::cvt_pk_bf16(o[2] * bflo(pg[ti].y), o[3] * bfhi(pg[ti].y));
              if (ABL_ON(2)) *(v2u*)(ob + (size_t)ti * (128 * 256) + ooff) = ow; } }
    }
    if (!SMP) {
#pragma unroll
        for (int i = 0; i < 8; ++i)
#pragma unroll
            for (int r = 0; r < 4; ++r) s_out[(size_t)(16 * i + 4 * g + r) * HD + 16 * w + c16] = S[i][r];
    }
    RBAR();
#undef ABL_ON
#undef REC_ROW0
#undef REC_UB
#undef REC_HEAD
#undef REC_LOADQK
#undef REC_STOREQK
#undef REC_LOADV
#undef REC_STOREV
#undef REC_LOADG
#undef REC_LOADS
#undef REC_PTILE
#undef REC_PHASE1
}

__device__ __forceinline__ void sub_barrier(gu32* word, unsigned want) {
    VM_WAIT(); __syncthreads();
    if (threadIdx.x == 0) {
        __builtin_amdgcn_fence(__ATOMIC_RELEASE, "agent"); asm volatile("s_waitcnt vmcnt(0)" ::: "memory");
        __hip_atomic_fetch_add(word, 1u, RLX_AGENT);
        unsigned sp = 0; while (__hip_atomic_load(word, RLX_AGENT) < want) { __builtin_amdgcn_s_sleep(2); if (++sp > (1u << 22)) break; }
        __builtin_amdgcn_fence(__ATOMIC_ACQUIRE, "agent"); asm volatile("s_waitcnt vmcnt(0)" ::: "memory");
    }
    __syncthreads();
}
struct Args { const float* in[17]; float* out; unsigned char* ws; };
__global__ void __launch_bounds__(NWAVES * 64, 2) hyb_fwd(Args args) {
    extern __shared__ __attribute__((aligned(16))) unsigned char lds_raw[];
    LAS unsigned char* lds = (LAS unsigned char*)lds_raw;
    volatile LAS unsigned* MISC = (volatile LAS unsigned*)(lds + MISC_OFF);
    const int tid = threadIdx.x, lane = tid & 63, wave = __builtin_amdgcn_readfirstlane(tid >> 6);
    const int G = gridDim.x; const int bx = blockIdx.x; const int vcu = (G % 8 == 0) ? (bx % 8) * (G / 8) + bx / 8 : bx;
    unsigned char* ws = args.ws;
    gu32* ctl = (gu32*)(ws + WS_CTL);
    const float* x_prompt = args.in[0]; const float* x_sample = args.in[1]; const float* state_hgrn = args.in[2]; const float* state_ret = args.in[3]; const float* state_conv = args.in[4];
    const float* w_norm1 = args.in[5]; const float* w_in = args.in[6]; const float* hgrn_lb = args.in[7]; const float* hgrn_norm_w = args.in[8]; const float* ret_norm_w = args.in[9];
    const float* w_out = args.in[10]; const float* w_norm2 = args.in[11]; const float* w_ffn_in = args.in[12]; const float* conv_w = args.in[13]; const float* conv_b = args.in[14];
    const float* w_ffn_out = args.in[15]; const float* w_norm_f = args.in[16];
    float* out_y = args.out;
    float* out_hgp = out_y + (size_t)M * D; float* out_rtp = out_hgp + (size_t)NBP * NH * HD * HD; float* out_cvp = out_rtp + (size_t)NBP * NH * HD * HD;
    float* out_hgs = out_cvp + (size_t)NBP * 2 * UPW; float* out_rts = out_hgs + (size_t)NBS * NH * HD * HD; float* out_cvs = out_rts + (size_t)NBS * NH * HD * HD;
    bf16* WIN = (bf16*)(ws + WS_WIN); bf16* WOUT = (bf16*)(ws + WS_WOUT); bf16* WUP = (bf16*)(ws + WS_WUP); bf16* WDN = (bf16*)(ws + WS_WDN);
    float2* ROPE = (float2*)(ws + WS_ROPE); float* LBT = (float*)(ws + WS_LB); float* DVP = (float*)(ws + WS_DVP); float* DVS = (float*)(ws + WS_DVS); float* SS1 = (float*)(ws + WS_SS1); float* SS2 = (float*)(ws + WS_SS2); float* SS3 = (float*)(ws + WS_SS3);
    bf16* XB = (bf16*)(ws + WS_XB); bf16* PROJ = (bf16*)(ws + WS_PROJ); bf16* OHAT = (bf16*)(ws + WS_OHAT); float* RAW = (float*)(ws + WS_RAW); bf16* ACT = (bf16*)(ws + WS_ACT); float* SLAB = (float*)(ws + WS_SLAB);

    for (int u = tid; u < (LDS_BYTES - LDSCTL_OFF) / 4; u += NWAVES * 64) ((LAS unsigned*)(lds + LDSCTL_OFF))[u] = 0u;
    __syncthreads();
    XcdBarrier bar = xcd_barrier_post((unsigned*)(ctl + CW_BAR), MISC + 8);
    const int gw = vcu * NWAVES + wave, NGW = G * NWAVES;

#if PH_MASK & 1
    _Pragma("unroll") for (int rep_ = 0; rep_ < REPS(0); ++rep_) {
    {
        LAS float* scr = (LAS float*)(lds + RING_OFF + wave * 16384);
        constexpr int I_IN = (D / 64) * (INW / 32);
        for (int it = gw; it < I_IN; it += NGW) p0_transpose_item<2>(w_in, D, INW, WIN, w_norm1, scr, it, lane);
        for (int m = gw; m < M; m += NGW) x_row_to_bf16(m < MP ? x_prompt + (size_t)m * D : x_sample + (size_t)(m - MP) * D, XB + (size_t)m * D, SS1 + m, lane);
        if (bx == 0) { const float a0 = hgrn_lb[tid], a1 = hgrn_lb[512 + tid]; const float mx = fmaxf(a0, a1), e0 = expf(a0 - mx), e1 = expf(a1 - mx); LBT[tid] = e0 / (e0 + e1); }
        for (int i = vcu * 512 + tid; i < 2056 * 64; i += G * 512) {
            const int p = i >> 6, j = i & 63; const int pos = p < 2048 ? p : PAST + (p - 2048);
            const double inv = exp2(-(double)j * (13.287712379549449 / 64.0));
            float c, s; sincos_acc((double)pos * inv, c, s); ROPE[i] = make_float2(c, s);
        }
    }
    xcd_barrier(bar);

    }
#endif
#if PH_MASK & 2
    _Pragma("unroll") for (int rep_ = 0; rep_ < REPS(1); ++rep_) {
    {
        pg8::Gemm g{XB, WIN, MP, INW, D, D}; pg8::StaticOrder S; S.init(MP, INW, G, bx);
        pg8::EpiPrep E{PROJ, SS1, LBT, (const float*)ROPE, DVP, DVS};
        pg8::gemm_phase<pg8::EpiPrep, pg8::StaticOrder, true, true>(lds + RING_OFF, g, S, E);
    }
    xcd_barrier(bar);

    }
#endif
#if PH_MASK & 4
    _Pragma("unroll") for (int rep_ = 0; rep_ < REPS(2); ++rep_) {
    {
        if (bx < 64) { if (rep_ == 0) {
            const int b = (bx >> 2) & 7, h = bx & 3;
            if (bx < 32) rec_core<false, false>(lds, PROJ, DVP, hgrn_norm_w, nullptr, out_hgp + (size_t)(b * 4 + h) * HD * HD, OHAT, (bf16*)(ws + 240 * MiB), h, b, 0, 32);
            else rec_core<true, false>(lds, PROJ, DVP, ret_norm_w, nullptr, out_rtp + (size_t)(b * 4 + h) * HD * HD, OHAT, (bf16*)(ws + 240 * MiB), h, b, 0, 32);
        } else if (REP_SEL & 1) {
            const int b = (bx >> 2) & 7, h = bx & 3; float* sdum = (float*)(ws + 236 * MiB) + (size_t)bx * HD * HD;
            if (bx < 32) rec_core<false, false, REP_ABL>(lds, PROJ, DVP, hgrn_norm_w, nullptr, sdum, XB, (bf16*)SS1, h, b, 0, 32);
            else rec_core<true, false, REP_ABL>(lds, PROJ, DVP, ret_norm_w, nullptr, sdum, XB, (bf16*)SS1, h, b, 0, 32);
        } } else if (rep_ == 0) {
            const int idx = bx - 64, nw_ = G - 64;
            {
                LAS float* scr = (LAS float*)(lds + RING_OFF + wave * 16384);
                constexpr int I_OUT = (D / 64) * (D / 32), I_UP = (D / 64) * (UPW / 32), I_DN = (DFF / 64) * (D / 32);
                for (int it = idx * NWAVES + wave; it < I_OUT + I_UP + I_DN; it += nw_ * NWAVES) {
                    int r = it;
                    if (r < I_OUT) { p0_transpose_item<0>(w_out, D, D, WOUT, nullptr, scr, r, lane); continue; } r -= I_OUT;
                    if (r < I_UP) { p0_transpose_item<1>(w_ffn_in, D, UPW, WUP, w_norm2, scr, r, lane); continue; } r -= I_UP;
                    p0_transpose_item<0>(w_ffn_out, DFF, D, WDN, nullptr, scr, r, lane);
                }
                __syncthreads();
            }
            {
                pg8::Gemm g{XB, WIN, M, INW, D, D}; pg8::SplitKOrder S{64, 4, 16, 1, nw_, idx};
                pg8::EpiPrep E{PROJ, SS1, LBT, (const float*)ROPE, DVP, DVS};
                pg8::gemm_phase<pg8::EpiPrep, pg8::SplitKOrder, true, true>(lds + RING_OFF, g, S, E);
            }
            sub_barrier(ctl + CW_SUB, (unsigned)nw_);
            {
                const int cnt = idx < 512 ? (512 - idx + nw_ - 1) / nw_ : 0;
                if (cnt > 0) { rec_core<false, true>(lds, PROJ, DVS, hgrn_norm_w, state_hgrn, out_hgs, OHAT, (bf16*)(ws + 240 * MiB), 0, idx, nw_, cnt);
                               rec_core<true, true>(lds, PROJ, DVS, ret_norm_w, state_ret, out_rts, OHAT, (bf16*)(ws + 240 * MiB), 0, idx, nw_, cnt); }
            }
            sub_barrier(ctl + CW_SUB, 2u * (unsigned)nw_);
            {
                pg8::Gemm g{OHAT, WOUT, M, D, D, D}; pg8::SplitKOrder S{64, 4, 4, 1, nw_, idx};
                pg8::EpiResF32 E{x_prompt, x_sample, out_y, XB, SS2};
                pg8::gemm_phase<pg8::EpiResF32, pg8::SplitKOrder, true, true, true>(lds + RING_OFF, g, S, E);
            }
        }
    }
    xcd_barrier(bar);

    }
#endif
#if PH_MASK & 8
    {
        pg8::Gemm g{OHAT, WOUT, MP, D, D, D}; pg8::StaticOrder S; S.init(MP, D, G, bx);
        pg8::EpiResF32 E{x_prompt, x_sample, out_y, XB, SS2};
        pg8::gemm_phase<pg8::EpiResF32, pg8::StaticOrder, true, true, true>(lds + RING_OFF, g, S, E);
    }
    xcd_barrier(bar);
#if REP_MASK & 8
    {
        pg8::Gemm g{OHAT, WOUT, M, D, D, D}; pg8::StaticOrder S; S.init(M, D, G, bx);
        pg8::EpiResF32 E{x_prompt, x_sample, (float*)(ws + WS_PROJ), nullptr, nullptr};
        pg8::gemm_phase<pg8::EpiResF32, pg8::StaticOrder, true, true, true>(lds + RING_OFF, g, S, E);
    }
    xcd_barrier(bar);
#endif

#endif
#if PH_MASK & 16
    _Pragma("unroll") for (int rep_ = 0; rep_ < REPS(4); ++rep_) {
    {
        pg8::Gemm g{XB, WUP, M, UPW, D, D}; pg8::StaticOrder S; S.init(M, UPW, G, bx);
        pg8::EpiConvAct E{ACT, SS2, conv_w, conv_b, state_conv, RAW, out_cvp, out_cvs};
        pg8::gemm_phase<pg8::EpiConvAct, pg8::StaticOrder, true, true>(lds + RING_OFF, g, S, E);
    }
    xcd_barrier(bar);
    }

#endif
#if PH_MASK & 32
    {
        pg8::Gemm g{ACT, WDN, MP, D, DFF, DFF}; pg8::StaticOrder S; S.init(MP, D, G, bx);
        {
            pg8::Unit u0; const bool has = S.next(0, u0);
            if (has && u0.pm < 64) {
                for (int it = tid; it < 8 * 704; it += NWAVES * 64) {
                    const int cgp = it % 704, kj = it / 704, k = kj >> 1, j = kj & 1, blk = u0.pm * 4 + k;
                    const int tile = cgp >> 5, c4 = (cgp & 31) * 4, pcol = tile * 256 + c4, ch = tile * 128 + c4;
                    const bool first = (blk & 31) == 0;
                    const float* cur = RAW + (size_t)(blk * 4 + j) * UPW + pcol;
                    const float* p1 = first ? cur : (j == 0 ? RAW + (size_t)((blk - 1) * 4 + 3) * UPW + pcol : RAW + (size_t)(blk * 4) * UPW + pcol);
                    const float* p2 = first ? cur : (j == 0 ? RAW + (size_t)((blk - 1) * 4 + 2) * UPW + pcol : RAW + (size_t)((blk - 1) * 4 + 3) * UPW + pcol);
                    if (first && j == 1) p1 = RAW + (size_t)(blk * 4) * UPW + pcol;
                    const float z1 = (first && j == 0) ? 0.f : 1.f, z2 = first ? 0.f : 1.f;
                    const f32x4 cu_ = *(const f32x4*)cur, cg_ = *(const f32x4*)(cur + 128), u1 = *(const f32x4*)p1 * z1, g1 = *(const f32x4*)(p1 + 128) * z1, u2 = *(const f32x4*)p2 * z2, g2 = *(const f32x4*)(p2 + 128) * z2;
                    const f32x4 cu = *(const f32x4*)(conv_b + ch) + *(const f32x4*)(conv_w + ch) * u2 + *(const f32x4*)(conv_w + UPW + ch) * u1 + *(const f32x4*)(conv_w + 2 * UPW + ch) * cu_;
                    const f32x4 cg = *(const f32x4*)(conv_b + DFF + ch) + *(const f32x4*)(conv_w + DFF + ch) * g2 + *(const f32x4*)(conv_w + UPW + DFF + ch) * g1 + *(const f32x4*)(conv_w + 2 * UPW + DFF + ch) * cg_;
                    v2u ow; ow.x = pk2(silu_f(cg[0]) * cu[0], silu_f(cg[1]) * cu[1]); ow.y = pk2(silu_f(cg[2]) * cu[2], silu_f(cg[3]) * cu[3]);
                    *(v2u*)(ACT + (size_t)(blk * 64 + j) * DFF + ch) = ow;
                }
            }
            VM_WAIT(); __syncthreads();
        }
        pg8::EpiResF32 E{out_y, out_y + (size_t)MP * D, out_y, nullptr, nullptr};
        pg8::gemm_phase<pg8::EpiResF32, pg8::StaticOrder, true, true>(lds + RING_OFF, g, S, E);
    }
    {
        pg8::Gemm g{ACT, WDN, M, D, 256, DFF}; pg8::SplitKOrder S{64, 4, 4, 11, G, bx};
        pg8::EpiSlab E{SLAB, 64, D, (size_t)MS * D};
        pg8::gemm_phase<pg8::EpiSlab, pg8::SplitKOrder, true, true>(lds + RING_OFF, g, S, E);
    }
    xcd_barrier(bar);
#if REP_MASK & 32
    {
        pg8::Gemm g{ACT, WDN, MP, D, DFF, DFF}; pg8::StaticOrder S; S.init(MP, D, G, bx);
        pg8::EpiResF32 E{out_y, out_y + (size_t)MP * D, (float*)(ws + WS_XB), nullptr, nullptr};
        pg8::gemm_phase<pg8::EpiResF32, pg8::StaticOrder, true, true>(lds + RING_OFF, g, S, E);
    }
    xcd_barrier(bar);
#endif
#if REP_MASK & 64
    {
        pg8::Gemm g{ACT, WDN, M, D, 256, DFF}; pg8::SplitKOrder S{64, 4, 4, 11, G, bx};
        pg8::EpiSlab E{SLAB, 64, D, (size_t)MS * D};
        pg8::gemm_phase<pg8::EpiSlab, pg8::SplitKOrder, true, true>(lds + RING_OFF, g, S, E);
    }
    xcd_barrier(bar);
#endif

#endif
#if PH_MASK & 64
    for (int m = gw; m < M; m += NGW) {
        GAS f32x4* xr = (GAS f32x4*)(out_y + (size_t)m * D) + lane; const GAS f32x4* wf = (const GAS f32x4*)w_norm_f + lane;
        f32x4 v[4]; float s = 0.f;
#pragma unroll
        for (int j = 0; j < 4; ++j) v[j] = xr[64 * j];
        if (m >= MP) {
#pragma unroll
            for (int ks = 0; ks < 11; ++ks) { const GAS f32x4* sl = (const GAS f32x4*)(SLAB + (size_t)ks * MS * D + (size_t)(m - MP) * D) + lane;
#pragma unroll
                for (int j = 0; j < 4; ++j) v[j] += sl[64 * j]; } }
#pragma unroll
        for (int j = 0; j < 4; ++j) s += (v[j].x * v[j].x + v[j].y * v[j].y) + (v[j].z * v[j].z + v[j].w * v[j].w);
        const float r = 1.0f / sqrtf(wave_sum(s) * (1.0f / D) + 1e-6f);
#pragma unroll
        for (int j = 0; j < 4; ++j) xr[64 * j] = v[j] * r * wf[64 * j];
    }
#endif
}

extern "C" void kernel_launch(void* const* d_in, const int* in_sizes, int n_in, void* d_out, int out_size, void* d_ws, size_t ws_size, hipStream_t stream) {
    static int grid = 0;
    if (grid == 0) {
        if (n_in != 17 || ws_size < WS_END) { fprintf(stderr, "kernel_launch: unexpected inputs (n_in %d, ws %zu); nothing launched\n", n_in, ws_size); grid = -1; return; }
        int dev = 0, cus = 0, per_cu = 0;
        if (hipGetDevice(&dev) != hipSuccess || hipDeviceGetAttribute(&cus, hipDeviceAttributeMultiprocessorCount, dev) != hipSuccess) { grid = -1; return; }
        if (hipFuncSetAttribute((const void*)hyb_fwd, hipFuncAttributeMaxDynamicSharedMemorySize, LDS_BYTES) != hipSuccess) { fprintf(stderr, "kernel_launch: hipFuncSetAttribute failed\n"); grid = -1; return; }
        if (hipOccupancyMaxActiveBlocksPerMultiprocessor(&per_cu, (const void*)hyb_fwd, NWAVES * 64, LDS_BYTES) != hipSuccess || per_cu < 1)
            fprintf(stderr, "kernel_launch: note: occupancy query reports %d workgroups per CU\n", per_cu);
        (void)hipGetLastError();
        grid = cus;
    }
    if (grid < 0) return;
    if (hipMemsetAsync((char*)d_ws + WS_CTL, 0, CTL_ZERO_BYTES, stream) != hipSuccess) return;
    Args a{};
    for (int i = 0; i < 17; ++i) a.in[i] = (const float*)d_in[i];
    a.out = (float*)d_out; a.ws = (unsigned char*)d_ws;
    hipLaunchKernelGGL(hyb_fwd, dim3(grid), dim3(NWAVES * 64), LDS_BYTES, stream, a);
}
```

```cpp
#include <hip/hip_runtime.h>
#include <cstdio>
#include <cstdint>
namespace pg8 {
#define PG8_LAS __attribute__((address_space(3)))
typedef unsigned short bf16_t;
typedef short bf16x8 __attribute__((ext_vector_type(8)));
typedef float f32x4 __attribute__((ext_vector_type(4)));
typedef unsigned u32x4 __attribute__((ext_vector_type(4)));
typedef unsigned u32x2 __attribute__((ext_vector_type(2)));
constexpr int BM = 256, BK = 64, HALF = 128, HTB = HALF * BK * 2  , STAGE_BYTES = 8 * HTB, NXCD = 8, WGM = 8;

__host__ __device__ __forceinline__ int lds_byte(int r, int c) { const int st = (r >> 4) * 2 + (c >> 5), rr = r & 15, cc = c & 31, ob = rr * 64 + cc * 2; return st * 1024 + (ob ^ (((ob >> 9) & 1) << 5)); }
__host__ __device__ __forceinline__ void stage_rc(int b, int& R, int& C) { const int st = b / 1024, sb = b % 1024, swz = sb ^ (((sb >> 9) & 1) << 5); R = (st >> 1) * 16 + swz / 64; C = (st & 1) * 32 + (swz % 64) / 2; }
__host__ __device__ __forceinline__ int perm32(int rho) { const int n = rho >> 4, i = rho & 15; return 8 * (i >> 2) + 4 * n + (i & 3); }

struct Unit { int pm, pn, ks; };
struct Gemm { const bf16_t* A; const bf16_t* Bt; int M, N, K, ld; };

struct StaticOrder {
    int nM, nN, nwg, G, c;
    __host__ __device__ __forceinline__ void init(int M, int N, int G_, int c_) { nM = M / BM; nN = N / BM; nwg = nM * nN; G = G_; c = c_; }
    __host__ __device__ __forceinline__ bool next(int i, Unit& u) const {
        const long L = (long)i * G + c; if (L >= nwg) return false;
        int wgid = (int)L; { const int q = nwg / NXCD, r = nwg % NXCD, xcd = wgid % NXCD, off = wgid / NXCD; wgid = (xcd < r ? xcd * (q + 1) : r * (q + 1) + (xcd - r) * q) + off; }
        const int nig = WGM * nN, gid = wgid / nig, fm = gid * WGM, gsz = (nM - fm) < WGM ? (nM - fm) : WGM;
        u.pm = fm + ((wgid % nig) % gsz); u.pn = (wgid % nig) / gsz; u.ks = 0; return true;
    }
    __device__ __forceinline__ void a_ready(const Unit&) const {}
    __device__ __forceinline__ void done(const Unit&) const {}
};
struct SplitKOrder {
    int pm0, nm, nn, nks, G, c;
    __device__ __forceinline__ bool next(int i, Unit& u) const { const int L = i * G + c; if (L >= nm * nn * nks) return false; u.ks = L % nks; const int t = L / nks; u.pn = t % nn; u.pm = pm0 + t / nn; return true; }
    __device__ __forceinline__ void a_ready(const Unit&) const {}
    __device__ __forceinline__ void done(const Unit&) const {}
};
typedef __bf16 bf16x2_t __attribute__((ext_vector_type(2)));
typedef float f32x2_t __attribute__((ext_vector_type(2)));
__device__ __forceinline__ unsigned cvt_pk_bf16(float lo, float hi) { const f32x2_t v = {lo, hi}; return __builtin_bit_cast(unsigned, __builtin_convertvector(v, bf16x2_t)); }
constexpr float RMS_EPS = 1e-6f;
struct EpiScaleBf16 {
    static constexpr bool PERM = true, AFTER_DRAIN = false;
    bf16_t* O; int ldc; const float* ss;
    __device__ __forceinline__ void operator()(const f32x4 (&acc)[2][2][4][2], const Unit& u, int wr, int wc, int fr, int fq) const {
        const int row0 = u.pm * BM + wr * 64 + fr, col0 = u.pn * BM + wc * 32 + 8 * fq;
#pragma unroll
        for (int ai = 0; ai < 2; ++ai)
#pragma unroll
            for (int m = 0; m < 4; ++m) { const int row = row0 + ai * HALF + m * 16; const float r = 1.0f / sqrtf(ss[row] * (1.0f / 1024.0f) + RMS_EPS);
                bf16_t* rowp = O + (size_t)row * ldc + col0;
#pragma unroll
                for (int bj = 0; bj < 2; ++bj) { const f32x4 v0 = acc[ai][bj][m][0] * r, v1 = acc[ai][bj][m][1] * r;
                    u32x4 w; w.x = cvt_pk_bf16(v0[0], v0[1]); w.y = cvt_pk_bf16(v0[2], v0[3]); w.z = cvt_pk_bf16(v1[0], v1[1]); w.w = cvt_pk_bf16(v1[2], v1[3]);
                    *(u32x4*)(rowp + bj * HALF) = w; } }
    }
};
struct EpiResF32 {
    static constexpr bool PERM = false, AFTER_DRAIN = false;
    const float* Xp; const float* Xs; float* out; bf16_t* xb; float* ss;
    __device__ __forceinline__ void operator()(const f32x4 (&acc)[2][2][4][2], const Unit& u, int wr, int wc, int fr, int fq) const {
        const int row0 = u.pm * BM + wr * 64 + fr, col0 = u.pn * BM + wc * 32 + 4 * fq;
        const float* X = u.pm < 64 ? Xp : Xs - (size_t)16384 * 1024;
#pragma unroll
        for (int ai = 0; ai < 2; ++ai)
#pragma unroll
            for (int m = 0; m < 4; ++m) { const int row = row0 + ai * HALF + m * 16; const size_t off = (size_t)row * 1024 + col0; float sq = 0.f;
#pragma unroll
                for (int bj = 0; bj < 2; ++bj)
#pragma unroll
                    for (int n = 0; n < 2; ++n) { const f32x4 x = *(const f32x4*)(X + off + bj * HALF + n * 16) + acc[ai][bj][m][n];
                        *(f32x4*)(out + off + bj * HALF + n * 16) = x; sq += (x[0] * x[0] + x[1] * x[1]) + (x[2] * x[2] + x[3] * x[3]);
                        if (xb) { u32x2 w; w.x = cvt_pk_bf16(x[0], x[1]); w.y = cvt_pk_bf16(x[2], x[3]); *(u32x2*)(xb + off + bj * HALF + n * 16) = w; } }
                if (ss) { sq += __shfl_xor(sq, 16); sq += __shfl_xor(sq, 32); if (fq == 0) atomicAdd(ss + row, sq); } }
    }
};

__device__ __forceinline__ float fexp2(float x) { return __builtin_amdgcn_exp2f(x); }
__device__ __forceinline__ float flog2(float x) { return __builtin_amdgcn_logf(x); }
__device__ __forceinline__ float frcp(float x) { return __builtin_amdgcn_rcpf(x); }
__device__ __forceinline__ float fsigmoid(float x) { return frcp(1.0f + fexp2(-1.4426950408889634f * x)); }
struct EpiPrep {
    static constexpr bool PERM = true, AFTER_DRAIN = false;
    bf16_t* RB; const float* ss; const float* LB; const float* ROPE; float* DVP; float* DVS;
    __device__ __forceinline__ void operator()(const f32x4 (&acc)[2][2][4][2], const Unit& u, int wr, int wc, int fr, int fq) const {
        asm volatile("" : "+v"(fr), "+v"(fq));
        const int kind = u.pn & 1, hp = u.pn >> 1;
        const int row0 = u.pm * BM + wr * 64 + fr, cp = wc * 32 + 8 * fq;
        const bool smp = u.pm >= 64;
        float r[2][4];
#pragma unroll
        for (int ai = 0; ai < 2; ++ai)
#pragma unroll
            for (int m = 0; m < 4; ++m) r[ai][m] = 1.0f / sqrtf(ss[row0 + ai * HALF + m * 16] * (1.0f / 1024.0f) + RMS_EPS);
        bf16_t* base = RB + (size_t)row0 * 4096 + u.pn * BM + cp;
        if (kind == 1) {
#pragma unroll
            for (int ai = 0; ai < 2; ++ai)
#pragma unroll
                for (int m = 0; m < 4; ++m) { bf16_t* rowp = base + (size_t)(ai * HALF + m * 16) * 4096; const float rr = r[ai][m];
                    { const f32x4 v0 = acc[ai][0][m][0] * rr, v1 = acc[ai][0][m][1] * rr;
                      u32x4 w; w.x = cvt_pk_bf16(v0[0], v0[1]); w.y = cvt_pk_bf16(v0[2], v0[3]); w.z = cvt_pk_bf16(v1[0], v1[1]); w.w = cvt_pk_bf16(v1[2], v1[3]); *(u32x4*)rowp = w; }
                    { f32x4 v0 = acc[ai][1][m][0] * rr, v1 = acc[ai][1][m][1] * rr;
#pragma unroll
                      for (int e = 0; e < 4; ++e) { v0[e] = v0[e] * fsigmoid(v0[e]); v1[e] = v1[e] * fsigmoid(v1[e]); }
                      u32x4 w; w.x = cvt_pk_bf16(v0[0], v0[1]); w.y = cvt_pk_bf16(v0[2], v0[3]); w.z = cvt_pk_bf16(v1[0], v1[1]); w.w = cvt_pk_bf16(v1[2], v1[3]); *(u32x4*)(rowp + HALF) = w; } }
        } else if (hp < 4) {
            float lbv[8];
#pragma unroll
            for (int c = 0; c < 8; ++c) lbv[c] = LB[hp * 128 + cp + c];
#pragma unroll
            for (int ai = 0; ai < 2; ++ai) {
                unsigned Qp[4][4], Kp[4][4];
#pragma unroll
                for (int cpair = 0; cpair < 4; ++cpair) {
                    float qo[2][4], ko[2][4];
#pragma unroll
                    for (int cc = 0; cc < 2; ++cc) { const int c = 2 * cpair + cc, n = c >> 2, e = c & 3;
                        float lf[4], kk[4];
#pragma unroll
                        for (int m = 0; m < 4; ++m) { const float fa = acc[ai][1][m][n][e] * r[ai][m]; const float f = lbv[c] + (1.0f - lbv[c]) * fsigmoid(fa); lf[m] = flog2(f); kk[m] = 1.0f - f; }
                        if (!smp) {
#pragma unroll
                            for (int m = 0; m < 4; ++m) {
#pragma unroll
                                for (int d = 1; d < 16; d <<= 1) { const float t = __shfl_up(lf[m], d, 16); if (fr >= d) lf[m] += t; } }
                            float carry = 0.f;
#pragma unroll
                            for (int m = 0; m < 4; ++m) { lf[m] += carry; carry = __shfl(lf[m], 15, 16); }
                            if (fr == 15) DVP[((size_t)((u.pm * 4 + ai * 2 + wr) * 4 + hp)) * 128 + cp + c] = fexp2(lf[3]);
                        } else {
#pragma unroll
                            for (int m = 0; m < 4; ++m) {
#pragma unroll
                                for (int d = 1; d < 8; d <<= 1) { const float t = __shfl_up(lf[m], d, 8); if ((fr & 7) >= d) lf[m] += t; }
                                if ((fr & 7) == 7) { const int seq = (u.pm - 64) * 32 + ai * 16 + wr * 8 + m * 2 + (fr >> 3); DVS[((size_t)(seq * 4 + hp)) * 128 + cp + c] = fexp2(lf[m]); } }
                        }
#pragma unroll
                        for (int m = 0; m < 4; ++m) { const float eb = fexp2(lf[m]); qo[cc][m] = acc[ai][0][m][n][e] * r[ai][m] * eb; ko[cc][m] = kk[m] * frcp(eb); }
                    }
#pragma unroll
                    for (int m = 0; m < 4; ++m) { Qp[m][cpair] = cvt_pk_bf16(qo[0][m], qo[1][m]); Kp[m][cpair] = cvt_pk_bf16(ko[0][m], ko[1][m]); }
                }
#pragma unroll
                for (int m = 0; m < 4; ++m) { bf16_t* rowp = base + (size_t)(ai * HALF + m * 16) * 4096;
                    u32x4 w; w.x = Qp[m][0]; w.y = Qp[m][1]; w.z = Qp[m][2]; w.w = Qp[m][3]; *(u32x4*)rowp = w;
                    u32x4 k; k.x = Kp[m][0]; k.y = Kp[m][1]; k.z = Kp[m][2]; k.w = Kp[m][3]; *(u32x4*)(rowp + HALF) = k; }
            }
        } else {
            const int h = hp - 4; const float lg = flog2(1.0f - fexp2(-5.0f - (float)h));
            const bool isk = wc >= 2; const int j0 = cp & 63;
            bf16_t* obase = RB + (size_t)row0 * 4096 + u.pn * BM + (isk ? 128 : 0) + j0;
#pragma unroll
            for (int ai = 0; ai < 2; ++ai)
#pragma unroll
                for (int m = 0; m < 4; ++m) { const int row = row0 + ai * HALF + m * 16; const int p = smp ? 2048 + (row & 7) : (row & 2047), tau = smp ? (row & 7) : (row & 63);
                    const float dec = fexp2((float)(tau + 1) * lg); const float sc = (isk ? 0.08838834764831845f * frcp(dec) : dec) * r[ai][m];
                    const f32x4* tp = (const f32x4*)(ROPE + ((size_t)p * 64 + j0) * 2); const f32x4 t0 = tp[0], t1 = tp[1], t2 = tp[2], t3 = tp[3];
                    const float cs[8] = {t0[0], t0[2], t1[0], t1[2], t2[0], t2[2], t3[0], t3[2]}, sn[8] = {t0[1], t0[3], t1[1], t1[3], t2[1], t2[3], t3[1], t3[3]};
                    float o1[8], o2[8];
#pragma unroll
                    for (int c = 0; c < 8; ++c) { const float x1 = acc[ai][0][m][c >> 2][c & 3] * sc, x2 = acc[ai][1][m][c >> 2][c & 3] * sc; o1[c] = x1 * cs[c] - x2 * sn[c]; o2[c] = x1 * sn[c] + x2 * cs[c]; }
                    bf16_t* rowp = obase + (size_t)(ai * HALF + m * 16) * 4096;
                    u32x4 w; w.x = cvt_pk_bf16(o1[0], o1[1]); w.y = cvt_pk_bf16(o1[2], o1[3]); w.z = cvt_pk_bf16(o1[4], o1[5]); w.w = cvt_pk_bf16(o1[6], o1[7]); *(u32x4*)rowp = w;
                    u32x4 k; k.x = cvt_pk_bf16(o2[0], o2[1]); k.y = cvt_pk_bf16(o2[2], o2[3]); k.z = cvt_pk_bf16(o2[4], o2[5]); k.w = cvt_pk_bf16(o2[6], o2[7]); *(u32x4*)(rowp + 64) = k; }
        }
    }
};

template <int CTRL> __device__ __forceinline__ float dpp_keep(float oldv, float src) {
    return __builtin_bit_cast(float, __builtin_amdgcn_update_dpp(__builtin_bit_cast(int, oldv), __builtin_bit_cast(int, src), CTRL, 0xf, 0xf, false)); }
struct EpiConvAct {
    static constexpr bool PERM = true, AFTER_DRAIN = false;
    bf16_t* ACT; const float* ss; const float* cw; const float* cb; const float* sconv; float* RAW; float* cvp; float* cvs;
    __device__ __forceinline__ void operator()(const f32x4 (&acc)[2][2][4][2], const Unit& u, int wr, int wc, int fr, int fq) const {
        asm volatile("" : "+v"(fr), "+v"(fq));
        const int row0 = u.pm * BM + wr * 64 + fr, cp = wc * 32 + 8 * fq;
        const bool smp = u.pm >= 64;
        float r[2][4];
#pragma unroll
        for (int ai = 0; ai < 2; ++ai)
#pragma unroll
            for (int m = 0; m < 4; ++m) r[ai][m] = __builtin_amdgcn_rsqf(ss[row0 + ai * HALF + m * 16] * (1.0f / 1024.0f) + RMS_EPS);
#pragma unroll
        for (int n = 0; n < 2; ++n) {
            const int ch0 = u.pn * 128 + cp + 4 * n;
            f32x4 wu[3], wg[3];
#pragma unroll
            for (int j = 0; j < 3; ++j) { wu[j] = *(const f32x4*)(cw + j * 5632 + ch0); wg[j] = *(const f32x4*)(cw + j * 5632 + 2816 + ch0); }
            const f32x4 bu = *(const f32x4*)(cb + ch0), bg = *(const f32x4*)(cb + 2816 + ch0);
#pragma unroll
            for (int ai = 0; ai < 2; ++ai) {
                f32x4 Up = {0.f, 0.f, 0.f, 0.f}, Gp = {0.f, 0.f, 0.f, 0.f};
#pragma unroll
                for (int m = 0; m < 4; ++m) {
                    const int row = row0 + ai * HALF + m * 16;
                    const f32x4 U = acc[ai][0][m][n] * r[ai][m], G = acc[ai][1][m][n] * r[ai][m];
                    f32x4 u1, u2, g1, g2;
#pragma unroll
                    for (int e = 0; e < 4; ++e) {
                        u1[e] = dpp_keep<0x111>(dpp_keep<0x121>(Up[e], Up[e]), U[e]); u2[e] = dpp_keep<0x112>(dpp_keep<0x122>(Up[e], Up[e]), U[e]);
                        g1[e] = dpp_keep<0x111>(dpp_keep<0x121>(Gp[e], Gp[e]), G[e]); g2[e] = dpp_keep<0x112>(dpp_keep<0x122>(Gp[e], Gp[e]), G[e]); }
                    if (smp) {
                        const int t = fr & 7, seq = (u.pm - 64) * 32 + ai * 16 + wr * 8 + m * 2 + (fr >> 3);
                        if (t < 2) { const float* sp = sconv + (size_t)(seq * 2) * 5632 + ch0;
                            const f32x4 b1u = *(const f32x4*)(sp + 5632), b1g = *(const f32x4*)(sp + 5632 + 2816);
                            if (t == 0) { u2 = *(const f32x4*)sp; g2 = *(const f32x4*)(sp + 2816); u1 = b1u; g1 = b1g; } else { u2 = b1u; g2 = b1g; } }
                        if (t >= 6) { float* cp_ = cvs + (size_t)(seq * 2 + (t - 6)) * 5632 + ch0; *(f32x4*)cp_ = U; *(f32x4*)(cp_ + 2816) = G; }
                    } else {
                        const int blk = u.pm * 4 + ai * 2 + wr;
                        if (m == 0 && fr < 2) { float* rp = RAW + (size_t)(blk * 4 + fr) * 5632 + u.pn * 256 + cp + 4 * n; *(f32x4*)rp = U; *(f32x4*)(rp + 128) = G; }
                        if (m == 3 && fr >= 14) { float* rp = RAW + (size_t)(blk * 4 + fr - 12) * 5632 + u.pn * 256 + cp + 4 * n; *(f32x4*)rp = U; *(f32x4*)(rp + 128) = G;
                            if ((blk & 31) == 31) { float* cp_ = cvp + (size_t)((blk >> 5) * 2 + (fr - 14)) * 5632 + ch0; *(f32x4*)cp_ = U; *(f32x4*)(cp_ + 2816) = G; } }
                    }
                    const f32x4 cu = bu + wu[0] * u2 + wu[1] * u1 + wu[2] * U, cg = bg + wg[0] * g2 + wg[1] * g1 + wg[2] * G;
                    f32x4 a;
#pragma unroll
                    for (int e = 0; e < 4; ++e) a[e] = cg[e] * fsigmoid(cg[e]) * cu[e];
                    u32x2 w; w.x = cvt_pk_bf16(a[0], a[1]); w.y = cvt_pk_bf16(a[2], a[3]);
                    if (smp || m > 0 || fr >= 2) *(u32x2*)(ACT + (size_t)row * 2816 + ch0) = w;
                    Up = U; Gp = G;
                }
            }
        }
    }
};

struct EpiSlab {
    static constexpr bool PERM = false, AFTER_DRAIN = false;
    float* slab; int pm0, ldc; size_t slab_stride;
    __device__ __forceinline__ void operator()(const f32x4 (&acc)[2][2][4][2], const Unit& u, int wr, int wc, int fr, int fq) const {
        const int row0 = (u.pm - pm0) * BM + wr * 64 + fr, col0 = u.pn * BM + wc * 32 + 4 * fq;
        float* base = slab + (size_t)u.ks * slab_stride;
#pragma unroll
        for (int ai = 0; ai < 2; ++ai)
#pragma unroll
            for (int m = 0; m < 4; ++m) { float* rowp = base + (size_t)(row0 + ai * HALF + m * 16) * ldc + col0;
#pragma unroll
                for (int bj = 0; bj < 2; ++bj)
#pragma unroll
                    for (int n = 0; n < 2; ++n) *(f32x4*)(rowp + bj * HALF + n * 16) = acc[ai][bj][m][n]; }
    }
};
template <class Epi, class Sched, bool ALIGN_EPI = false, bool SP2 = false, bool ABLK = false>
__device__ __forceinline__ void gemm_phase(PG8_LAS unsigned char* lds, const Gemm g, const Sched& S, const Epi& E) {
    int tid = threadIdx.x; asm volatile("" : "+v"(tid));
    const int wid = __builtin_amdgcn_readfirstlane(tid >> 6), lane = tid & 63, wr = wid >> 2, wc = wid & 3, fr = lane & 15, fq = lane >> 4;
    const int K = g.K, ld = g.ld, nt = K / BK;
    unsigned voffA[2], voffB[2];
#pragma unroll
    for (int i = 0; i < 2; ++i) { int R, C; stage_rc(tid * 16 + i * 8192, R, C); const int Rb = Epi::PERM ? ((R & ~31) + perm32(R & 31)) : R;
        voffA[i] = ABLK ? (unsigned)(((R >> 4) * (ld >> 3) + (C >> 3)) * 256 + (R & 15) * 16) : (unsigned)(R * ld + C) * 2u; voffB[i] = (unsigned)(Rb * ld + C) * 2u; }
    const size_t kstep = (size_t)(BK * 2), kstepA = ABLK ? (size_t)(BK / 8) * 256 : kstep;
    const size_t hstep = (size_t)HALF * ld * 2, sstep = (size_t)K * 2, sstepA = ABLK ? (size_t)(K / 8) * 256 : sstep;
    const size_t tstep = 2 * hstep;
    const unsigned ldsw = (unsigned)wid * 1024u;
    const int aoff = lds_byte(wr * 64 + fr, fq * 8), boff = lds_byte(wc * 32 + fr, fq * 8);
#define PG8_SA(b, h) (((b) * 2 + (h)) * HTB)
#define PG8_SB(b, h) ((4 + (b) * 2 + (h)) * HTB)
#define PG8_STAGE(bufoff, gbase, voff) do { _Pragma("unroll") for (int _i = 0; _i < 2; ++_i) \
        __builtin_amdgcn_global_load_lds((const unsigned*)((const char*)(gbase) + (voff)[_i]), (PG8_LAS unsigned*)(lds + (bufoff) + ldsw + _i * 8192), 16, 0, 0); } while (0)
#define PG8_LDA(dst, b, h) do { _Pragma("unroll") for (int m = 0; m < 4; ++m) _Pragma("unroll") for (int k = 0; k < 2; ++k) dst[m][k] = *(const PG8_LAS bf16x8*)(lds + PG8_SA(b, h) + aoff + m * 2048 + k * 1024); } while (0)
#define PG8_LDB(dst, b, h) do { _Pragma("unroll") for (int n = 0; n < 2; ++n) _Pragma("unroll") for (int k = 0; k < 2; ++k) dst[n][k] = *(const PG8_LAS bf16x8*)(lds + PG8_SB(b, h) + boff + n * 2048 + k * 1024); } while (0)
#define PG8_MMA(ai, bj, At, Bt) do { __builtin_amdgcn_s_setprio(1); _Pragma("unroll") for (int m = 0; m < 4; ++m) _Pragma("unroll") for (int n = 0; n < 2; ++n) _Pragma("unroll") for (int k = 0; k < 2; ++k) \
        acc[ai][bj][m][n] = __builtin_amdgcn_mfma_f32_16x16x32_bf16(Bt[n][k], At[m][k], acc[ai][bj][m][n], 0, 0, 0); __builtin_amdgcn_s_setprio(0); } while (0)
#define PG8_WAIT_V(n) asm volatile("s_waitcnt vmcnt(" #n ")" ::: "memory")
#define PG8_WAIT_L(n) asm volatile("s_waitcnt lgkmcnt(" #n ")" ::: "memory")
#define PG8_BAR __builtin_amdgcn_s_barrier()
#define PG8_SCHED __builtin_amdgcn_sched_barrier(0)
    Unit cur, nxt; int ui = 0;
    if (!S.next(0, cur)) return;
    f32x4 acc[2][2][4][2];
#pragma unroll
    for (int a = 0; a < 2; ++a)
#pragma unroll
        for (int b = 0; b < 2; ++b)
#pragma unroll
            for (int m = 0; m < 4; ++m)
#pragma unroll
                for (int n = 0; n < 2; ++n) acc[a][b][m][n] = (f32x4){0.f, 0.f, 0.f, 0.f};
    bf16x8 At[4][2], B0[2][2], B1[2][2];
    const char* cA = (const char*)g.A + (size_t)cur.pm * tstep + (size_t)cur.ks * sstepA; const char* cB = (const char*)g.Bt + (size_t)cur.pn * tstep + (size_t)cur.ks * sstep;
    S.a_ready(cur);
    if constexpr (SP2) {
        PG8_STAGE(PG8_SB(0, 0), cB, voffB); PG8_STAGE(PG8_SB(0, 1), cB + hstep, voffB); PG8_STAGE(PG8_SA(0, 0), cA, voffA); PG8_STAGE(PG8_SA(0, 1), cA + hstep, voffA);
        if (wr == 1) PG8_BAR;
        PG8_WAIT_V(2); PG8_BAR;
        PG8_STAGE(PG8_SB(1, 0), cB + kstep, voffB); PG8_STAGE(PG8_SA(1, 0), cA + kstepA, voffA); PG8_STAGE(PG8_SB(1, 1), cB + hstep + kstep, voffB);
        PG8_WAIT_V(6); PG8_BAR;
    } else {
        PG8_STAGE(PG8_SB(0, 0), cB, voffB); PG8_STAGE(PG8_SA(0, 0), cA, voffA); PG8_STAGE(PG8_SB(0, 1), cB + hstep, voffB); PG8_STAGE(PG8_SA(0, 1), cA + hstep, voffA);
        if (wr == 1) PG8_BAR;
        PG8_WAIT_V(4); PG8_BAR;
        PG8_STAGE(PG8_SB(1, 0), cB + kstep, voffB); PG8_STAGE(PG8_SA(1, 0), cA + kstepA, voffA); PG8_STAGE(PG8_SB(1, 1), cB + hstep + kstep, voffB);
        PG8_WAIT_V(6); PG8_BAR;
    }
    for (;;) {
        const bool has_next = S.next(ui + 1, nxt);
        const char* nA = has_next ? (const char*)g.A + (size_t)nxt.pm * tstep + (size_t)nxt.ks * sstepA : cA; const char* nB = has_next ? (const char*)g.Bt + (size_t)nxt.pn * tstep + (size_t)nxt.ks * sstep : cB;
        for (int t = 0; t < nt; t += 2) {
            const bool last = (t == nt - 2);
            const char* a1 = cA + (size_t)(t + 1) * kstepA;
            const char* a2 = last ? nA : cA + (size_t)(t + 2) * kstepA; const char* b2 = last ? nB : cB + (size_t)(t + 2) * kstep;
            const char* a3 = a2 + kstepA; const char* b3 = b2 + kstep;
            if (last && has_next) S.a_ready(nxt);
            if constexpr (SP2) {
            PG8_LDB(B0, 0, 0); PG8_LDB(B1, 0, 1); PG8_SCHED; PG8_LDA(At, 0, 0); PG8_STAGE(PG8_SA(1, 1), a1 + hstep, voffA);
            PG8_WAIT_V(8); PG8_WAIT_L(0); PG8_BAR; PG8_MMA(0, 0, At, B0); PG8_MMA(0, 1, At, B1); PG8_BAR; PG8_SCHED;
            PG8_LDA(At, 0, 1); PG8_STAGE(PG8_SB(0, 0), b2, voffB); PG8_STAGE(PG8_SB(0, 1), b2 + hstep, voffB); PG8_STAGE(PG8_SA(0, 0), a2, voffA);
            PG8_WAIT_V(8); PG8_WAIT_L(0); PG8_BAR; PG8_MMA(1, 0, At, B0); PG8_MMA(1, 1, At, B1); PG8_BAR; PG8_SCHED;
            PG8_LDB(B0, 1, 0); PG8_LDB(B1, 1, 1); PG8_SCHED; PG8_LDA(At, 1, 0); PG8_STAGE(PG8_SA(0, 1), a2 + hstep, voffA);
            PG8_WAIT_V(8); PG8_WAIT_L(0); PG8_BAR; PG8_MMA(0, 0, At, B0); PG8_MMA(0, 1, At, B1); PG8_BAR; PG8_SCHED;
            PG8_LDA(At, 1, 1); PG8_STAGE(PG8_SB(1, 0), b3, voffB); PG8_STAGE(PG8_SB(1, 1), b3 + hstep, voffB); PG8_STAGE(PG8_SA(1, 0), a3, voffA);
            PG8_WAIT_V(8); PG8_WAIT_L(0); PG8_BAR; PG8_MMA(1, 0, At, B0); PG8_MMA(1, 1, At, B1); PG8_BAR; PG8_SCHED;
            } else {
            PG8_LDB(B0, 0, 0); PG8_SCHED; PG8_LDA(At, 0, 0); PG8_STAGE(PG8_SA(1, 1), a1 + hstep, voffA);
            PG8_WAIT_L(8); PG8_BAR; PG8_WAIT_L(0); PG8_MMA(0, 0, At, B0); PG8_BAR; PG8_SCHED;
            PG8_LDB(B1, 0, 1); PG8_STAGE(PG8_SB(0, 0), b2, voffB);
            PG8_BAR; PG8_WAIT_L(0); PG8_MMA(0, 1, At, B1); PG8_BAR;
            PG8_LDA(At, 0, 1); PG8_STAGE(PG8_SA(0, 0), a2, voffA);
            PG8_BAR; PG8_WAIT_L(0); PG8_MMA(1, 0, At, B0); PG8_BAR; PG8_SCHED;
            PG8_STAGE(PG8_SB(0, 1), b2 + hstep, voffB);
            PG8_WAIT_V(6); PG8_BAR; PG8_MMA(1, 1, At, B1); PG8_BAR;
            PG8_LDB(B0, 1, 0); PG8_SCHED; PG8_LDA(At, 1, 0); PG8_STAGE(PG8_SA(0, 1), a2 + hstep, voffA);
            PG8_WAIT_L(8); PG8_BAR; PG8_WAIT_L(0); PG8_MMA(0, 0, At, B0); PG8_BAR; PG8_SCHED;
            PG8_LDB(B1, 1, 1); PG8_STAGE(PG8_SB(1, 0), b3, voffB);
            PG8_BAR; PG8_WAIT_L(0); PG8_MMA(0, 1, At, B1); PG8_BAR;
            PG8_LDA(At, 1, 1); PG8_STAGE(PG8_SA(1, 0), a3, voffA);
            PG8_BAR; PG8_WAIT_L(0); PG8_MMA(1, 0, At, B0); PG8_BAR; PG8_SCHED;
            PG8_STAGE(PG8_SB(1, 1), b3 + hstep, voffB);
            PG8_WAIT_V(6); PG8_BAR; PG8_MMA(1, 1, At, B1); PG8_BAR;
            }
        }
        if constexpr (ALIGN_EPI) { if (wr == 0) PG8_BAR; }
        if constexpr (!Epi::AFTER_DRAIN) { E(acc, cur, wr, wc, fr, fq); S.done(cur); }
        if (!has_next) break;
#pragma unroll
        for (int a = 0; a < 2; ++a)
#pragma unroll
            for (int b = 0; b < 2; ++b)
#pragma unroll
                for (int m = 0; m < 4; ++m)
#pragma unroll
                    for (int n = 0; n < 2; ++n) acc[a][b][m][n] = (f32x4){0.f, 0.f, 0.f, 0.f};
        cur = nxt; cA = nA; cB = nB; ++ui;
        if constexpr (ALIGN_EPI) { if (wr == 1) PG8_BAR; }
    }
    PG8_WAIT_V(0);
    if constexpr (!ALIGN_EPI) { if (wr == 0) PG8_BAR; }
    PG8_BAR;
    if constexpr (Epi::AFTER_DRAIN) { E.fused(acc, cur, wr, wc, fr, fq, lds, wid, lane); S.done(cur); }
#undef PG8_SA
#undef PG8_SB
#undef PG8_STAGE
#undef PG8_LDA
#undef PG8_LDB
#undef PG8_MMA
#undef PG8_WAIT_V
#undef PG8_WAIT_L
#undef PG8_BAR
#undef PG8_SCHED
}
}
constexpr int NWAVES = 8;
constexpr int D = 1024, MP = 16384, MS = 1024, M = MP + MS;
constexpr int TP = 2048, NBP = 8, TS = 8, NBS = 128, PAST = 16384;
constexpr int INW = 4096, DFF = 2816, UPW = 5632, HD = 128, NH = 4;
constexpr size_t MiB = 1u << 20, KiB = 1024;
constexpr size_t WS_CTL = 0, CTL_ZERO_BYTES = 320 * KiB;
constexpr size_t WS_SS2 = 64 * KiB, WS_SS3 = 192 * KiB;
constexpr size_t WS_WIN = 1 * MiB, WS_WOUT = 9 * MiB, WS_WUP = 11 * MiB, WS_WDN = 22 * MiB;
constexpr size_t WS_ROPE = 28 * MiB;
constexpr size_t WS_SS1 = 30 * MiB;
constexpr size_t WS_LB = 30 * MiB + 96 * KiB;
constexpr size_t WS_DVP = 30 * MiB + 128 * KiB;
constexpr size_t WS_DVS = 30 * MiB + 640 * KiB;
constexpr size_t WS_XB = 32 * MiB;
constexpr size_t WS_PROJ = 66 * MiB;
constexpr size_t WS_OHAT = 202 * MiB;
constexpr size_t WS_RAW = 66 * MiB, WS_ACT = 160 * MiB;
constexpr size_t WS_SLAB = 96 * MiB;
constexpr size_t WS_END = 256 * MiB;
static_assert(WS_WDN + (size_t)D * DFF * 2 <= WS_ROPE && WS_ROPE + 2056 * 64 * 8 <= WS_SS1 && WS_SS1 + M * 4 <= WS_XB && WS_XB + (size_t)M * D * 2 <= WS_PROJ, "ws map 1");
static_assert(WS_PROJ + (size_t)M * INW * 2 <= WS_OHAT && WS_OHAT + (size_t)M * D * 2 <= WS_END && WS_RAW + (size_t)(M / 64) * 4 * UPW * 4 <= WS_ACT && WS_ACT + (size_t)M * DFF * 2 <= WS_END, "ws map 2");
static_assert(WS_RAW + (size_t)(M / 64) * 4 * UPW * 4 <= WS_SLAB && WS_SLAB + (size_t)11 * MS * D * 4 <= WS_ACT, "ws map 3");
constexpr int CW_TMO = 0, CW_CODE = 1, CW_BAR = 4096, CW_SUB = 8192;
constexpr int RING_OFF = 0, RING_BYTES = 131072;
constexpr int LDSCTL_OFF = RING_BYTES, MISC_OFF = LDSCTL_OFF + 320;
constexpr int LDS_BYTES = 163840;
constexpr int RQK_OFF = 0, RV_OFF = 98304, RP_OFF = MISC_OFF + 128, RP_STRIDE = 144, RP_BYTES = 64 * RP_STRIDE, RSTAT_OFF = RP_OFF + 2 * RP_BYTES, RSTAT_BYTES = 4096, RDVEC_OFF = RSTAT_OFF + 2 * RSTAT_BYTES, R_END = RDVEC_OFF + 1536;
static_assert(RP_OFF % 16 == 0 && R_END <= LDS_BYTES, "LDS map");
#define GAS __attribute__((address_space(1)))
#define LAS __attribute__((address_space(3)))
typedef unsigned short bf16;
typedef unsigned v4u __attribute__((ext_vector_type(4)));
typedef unsigned v2u __attribute__((ext_vector_type(2)));
typedef float f32x4 __attribute__((ext_vector_type(4)));
typedef GAS unsigned gu32;
#define RLX_AGENT __ATOMIC_RELAXED, __HIP_MEMORY_SCOPE_AGENT
#define LDS_WAIT() asm volatile("s_waitcnt lgkmcnt(0)" ::: "memory")
#define VM_WAIT() asm volatile("s_waitcnt vmcnt(0)" ::: "memory")
__device__ __forceinline__ unsigned f2bf(float f) { unsigned u = __builtin_bit_cast(unsigned, f); return (u + 0x7fffu + ((u >> 16) & 1u)) >> 16; }
__device__ __forceinline__ unsigned pk2(float lo, float hi) { return f2bf(lo) | (f2bf(hi) << 16); }
__device__ __forceinline__ float bf2f(unsigned short h) { return __builtin_bit_cast(float, (unsigned)h << 16); }
__device__ __forceinline__ float bflo(unsigned w) { return __builtin_bit_cast(float, w << 16); }
__device__ __forceinline__ float bfhi(unsigned w) { return __builtin_bit_cast(float, w & 0xffff0000u); }

#define XB_TMO      128
#define XB_XCNT(j)  (256  + 64 * (j))
#define XB_XSUB(j)  (1280 + 64 * (j))
#define XB_XGEN(j)  (2304 + 64 * (j))
#define XB_TOP      3328
#define XB_TOPGEN   3392
#define XCD_BAR_WORDS 3456
#define XB_SPIN_CAP (1u << 18)

__device__ __forceinline__ unsigned xb_ld(unsigned* p)              { return __hip_atomic_load(p, __ATOMIC_RELAXED, __HIP_MEMORY_SCOPE_AGENT); }
__device__ __forceinline__ unsigned xb_add(unsigned* p, unsigned v) { return __hip_atomic_fetch_add(p, v, __ATOMIC_RELAXED, __HIP_MEMORY_SCOPE_AGENT); }
__device__ __forceinline__ unsigned xb_xcc_id() { return (unsigned)__builtin_amdgcn_s_getreg((3 << 11) | 20) & 0xFu; }
#define XB_SPIN(cond, bar) do { unsigned _sp = 0; while (cond) { __builtin_amdgcn_s_sleep(1); \
    if ((++_sp & 255u) == 0u) { if (xb_ld(&(bar)[XB_TMO])) break; if (_sp > XB_SPIN_CAP) { atomicAdd(&(bar)[XB_TMO], 1u); break; } } } } while (0)

struct XcdBarrier {
    unsigned* bar; unsigned x;
    volatile LAS unsigned* st;
};

__device__ __forceinline__ XcdBarrier xcd_barrier_post(unsigned* bar, volatile LAS unsigned* st) {
    XcdBarrier b; b.bar = bar; b.x = xb_xcc_id(); b.st = st;
    if (threadIdx.x == 0) (void)xb_add(&bar[XB_XCNT(b.x)], 1u);
    return b;
}
__device__ __forceinline__ void xcd_barrier_complete(unsigned* bar, unsigned x, unsigned& nloc, unsigned& nx) {
    const unsigned G = gridDim.x * gridDim.y * gridDim.z;
    unsigned sum, cnt, mine, sp = 0u;
    for (;;) {
        sum = 0u; cnt = 0u; mine = 0u;
#pragma unroll
        for (unsigned j = 0; j < 16; ++j) { const unsigned c = xb_ld(&bar[XB_XCNT(j)]); sum += c; cnt += (c > 0u) ? 1u : 0u; mine = (j == x) ? c : mine; }
        if (sum == G) break;
        __builtin_amdgcn_s_sleep(1);
        if ((++sp & 255u) == 0u) { if (xb_ld(&bar[XB_TMO])) break; if (sp > XB_SPIN_CAP) { atomicAdd(&bar[XB_TMO], 1u); break; } }
    }
    nloc = mine > 0u ? mine : 1u; nx = cnt > 0u ? cnt : 1u;
}

__device__ __forceinline__ void xcd_barrier(const XcdBarrier& b) {
    asm volatile("s_waitcnt vmcnt(0)" ::: "memory");
    __syncthreads();
    if (threadIdx.x == 0) {
        unsigned* bar = b.bar;
        __builtin_amdgcn_s_waitcnt(0);
        unsigned nloc = b.st[0], nx = b.st[1];
        if (nloc == 0u) { xcd_barrier_complete(bar, b.x, nloc, nx); b.st[0] = nloc; b.st[1] = nx; }
        const unsigned old = xb_add(&bar[XB_XSUB(b.x)], 1u);
        const unsigned gen = old / nloc;
        if (old + 1u == (gen + 1u) * nloc) {
            __builtin_amdgcn_fence(__ATOMIC_RELEASE, "agent");
            asm volatile("s_waitcnt vmcnt(0)" ::: "memory");
            const unsigned og = xb_add(&bar[XB_TOP], 1u);
            const unsigned tg = og / nx;
            if (og + 1u == (tg + 1u) * nx) xb_add(&bar[XB_TOPGEN], 1u);
            else XB_SPIN(xb_ld(&bar[XB_TOPGEN]) == tg, bar);
            __builtin_amdgcn_fence(__ATOMIC_ACQUIRE, "agent");
            xb_add(&bar[XB_XGEN(b.x)], 1u);
            asm volatile("s_waitcnt vmcnt(0)" ::: "memory");
        } else {
            XB_SPIN(xb_ld(&bar[XB_XGEN(b.x)]) == gen, bar);
            __builtin_amdgcn_fence(__ATOMIC_ACQUIRE, "agent");
            asm volatile("s_waitcnt vmcnt(0)" ::: "memory");
        }
    }
    __syncthreads();
}
#ifndef PH_MASK
#define PH_MASK 127
#endif
#ifndef REP_MASK
#define REP_MASK 0
#endif
#define REPS(k) ((((REP_MASK) >> (k)) & 1) + 1)
#ifndef STAMP_PHASE
#define STAMP_PHASE -1
#endif
#define STAMP0(k) do { if (STAMP_PHASE == (k)) t_s0 = __builtin_amdgcn_s_memrealtime(); } while (0)
#define STAMP1(k) do { if (STAMP_PHASE == (k)) t_s1 = __builtin_amdgcn_s_memrealtime(); } while (0)
#ifndef REP_ABL
#define REP_ABL 0
#endif
#ifndef REP_SEL
#define REP_SEL 3
#endif
__device__ __forceinline__ float wave_sum(float v) {
#pragma unroll
    for (int o = 1; o < 64; o <<= 1) v += __shfl_xor(v, o);
    return v;
}
__device__ __forceinline__ float silu_f(float x) { return x / (1.0f + expf(-x)); }
__device__ __forceinline__ void sincos_acc(double ang, float& c, float& s) {
    const double TWO_OVER_PI = 0.63661977236758134308, PIO2_HI = 1.57079632679489655800e+00, PIO2_LO = 6.12323399573676603587e-17;
    const double q = rint(ang * TWO_OVER_PI);
    double r = fma(-q, PIO2_HI, ang); r = fma(-q, PIO2_LO, r);
    const int n = ((int)q) & 3;
    const double z = r * r;
    const double S1 = -1.66666666666666324348e-01, S2 = 8.33333333332248946124e-03, S3 = -1.98412698298579493134e-04, S4 = 2.75573137070700676789e-06, S5 = -2.50507602534068634195e-08, S6 = 1.58969099521155010221e-10;
    const double C1 = 4.16666666666666019037e-02, C2 = -1.38888888888741095749e-03, C3 = 2.48015872894767294178e-05, C4 = -2.75573143513906633035e-07, C5 = 2.08757232129817482790e-09, C6 = -1.13596475577881948265e-11;
    const double sn = r + r * z * (S1 + z * (S2 + z * (S3 + z * (S4 + z * (S5 + z * S6)))));
    const double cs = 1.0 - 0.5 * z + z * z * (C1 + z * (C2 + z * (C3 + z * (C4 + z * (C5 + z * C6)))));
    double sv, cv;
    if (n == 0) { sv = sn; cv = cs; } else if (n == 1) { sv = cs; cv = -sn; } else if (n == 2) { sv = -sn; cv = -cs; } else { sv = -cs; cv = sn; }
    c = (float)cv; s = (float)sv;
}
__device__ __forceinline__ int up_col_map(int n) { const int g = n >= DFF ? 1 : 0, ch = n - g * DFF; return (ch >> 7) * 256 + g * 128 + (ch & 127); }
__device__ __forceinline__ int in_col_map(int n) {
    const int grp = n >> 11, part = (n >> 9) & 3, h = (n >> 7) & 3, c = n & 127, hp = grp * 4 + h;
    if (part >= 2) return (2 * hp + 1) * 256 + (part - 2) * 128 + c;
    if (grp == 0) return (2 * hp) * 256 + part * 128 + c;
    return (2 * hp) * 256 + (c >> 6) * 128 + part * 64 + (c & 63);
}
struct TrItem { const float* W; const float* kscale; bf16* WT; int K, N, k0, n0, mode; };
__device__ __forceinline__ void tr_load(const TrItem& t, int lane, f32x4 (&v)[8]) {
    const float* p = t.W + (size_t)(t.k0 + (lane >> 3)) * t.N + t.n0 + (lane & 7) * 4;
#pragma unroll
    for (int i = 0; i < 8; ++i) v[i] = *(const f32x4*)(p + (size_t)(8 * i) * t.N);
}
__device__ __forceinline__ void tr_finish(const TrItem& t, int lane, f32x4 (&v)[8], LAS float* scr) {
#pragma unroll
    for (int i = 0; i < 8; ++i) { const int kk = 8 * i + (lane >> 3); const float sc = t.kscale ? t.kscale[t.k0 + kk] : 1.0f; LAS float* d = scr + kk * 33 + (lane & 7) * 4;
        d[0] = v[i][0] * sc; d[1] = v[i][1] * sc; d[2] = v[i][2] * sc; d[3] = v[i][3] * sc; }
    LDS_WAIT(); asm volatile("" ::: "memory");
    const int c = lane & 7;
    const int r0 = t.mode == 1 ? up_col_map(t.n0) : t.mode == 2 ? in_col_map(t.n0) : t.n0;
#pragma unroll
    for (int j = 0; j < 4; ++j) { const int n = (lane >> 3) + 8 * j; const LAS float* s = scr + (8 * c) * 33 + n;
        v4u o; o.x = pk2(s[0 * 33], s[1 * 33]); o.y = pk2(s[2 * 33], s[3 * 33]); o.z = pk2(s[4 * 33], s[5 * 33]); o.w = pk2(s[6 * 33], s[7 * 33]);
        *(GAS v4u*)(t.WT + (size_t)(r0 + n) * t.K + t.k0 + 8 * c) = o; }
    LDS_WAIT(); asm volatile("" ::: "memory");
}
__device__ __forceinline__ void x_row_to_bf16(const float* xrow, bf16* orow, float* ss, int lane) {
    const GAS f32x4* xr = (const GAS f32x4*)xrow + lane;
    f32x4 v[4]; float s = 0.f;
#pragma unroll
    for (int j = 0; j < 4; ++j) { v[j] = xr[64 * j]; s += (v[j].x * v[j].x + v[j].y * v[j].y) + (v[j].z * v[j].z + v[j].w * v[j].w); }
    s = wave_sum(s);
    if (lane == 0) *ss = s;
    GAS unsigned long long* o8 = (GAS unsigned long long*)orow + lane;
#pragma unroll
    for (int j = 0; j < 4; ++j) o8[64 * j] = (unsigned long long)pk2(v[j].x, v[j].y) | ((unsigned long long)pk2(v[j].z, v[j].w) << 32);
}

typedef short bf16x8 __attribute__((ext_vector_type(8)));
typedef short s16x4 __attribute__((ext_vector_type(4)));
template <int CTRL> __device__ __forceinline__ float dppf(float x) { return __builtin_bit_cast(float, __builtin_amdgcn_update_dpp(0, __builtin_bit_cast(int, x), CTRL, 0xf, 0xf, true)); }
__device__ __forceinline__ float row16_sum(float x) { x += dppf<0xB1>(x); x += dppf<0x4E>(x); x += dppf<0x141>(x); x += dppf<0x140>(x); return x; }
__device__ __forceinline__ unsigned off_b(unsigned row, unsigned ch) { return 2048u * (row >> 3) + 512u * (ch >> 2) + 64u * (row & 7) + 16u * ((ch & 3) ^ ((row >> 2) & 3)); }
__device__ __forceinline__ unsigned row_read_addr_16(unsigned lane, unsigned rb, unsigned s) { return off_b((lane & 15) + 16 * rb, 4 * s + (lane >> 4)); }
__device__ __forceinline__ unsigned tr_read_addr_16(unsigned lane, unsigned c, unsigned ks, unsigned t) {
    const unsigned g = lane >> 4, q = (lane & 15) >> 2, p = lane & 3; return off_b(32 * ks + 8 * g + 4 * t + q, 2 * c + (p >> 1)) + 8 * (p & 1); }
__device__ __forceinline__ s16x4 lds_tr(LAS unsigned char* p) { return __builtin_amdgcn_ds_read_tr16_b64_v4i16((LAS s16x4*)p); }
__device__ __forceinline__ bf16x8 cat8(s16x4 a, s16x4 b) { bf16x8 r; r[0] = a[0]; r[1] = a[1]; r[2] = a[2]; r[3] = a[3]; r[4] = b[0]; r[5] = b[1]; r[6] = b[2]; r[7] = b[3]; return r; }
__device__ __forceinline__ bf16x8 pack8(f32x4 a, f32x4 b) { v4u w; w.x = pg8::cvt_pk_bf16(a[0], a[1]); w.y = pg8::cvt_pk_bf16(a[2], a[3]); w.z = pg8::cvt_pk_bf16(b[0], b[1]); w.w = pg8::cvt_pk_bf16(b[2], b[3]); return __builtin_bit_cast(bf16x8, w); }
#define RBAR() do { asm volatile("s_waitcnt lgkmcnt(0)" ::: "memory"); __builtin_amdgcn_s_barrier(); asm volatile("" ::: "memory"); } while (0)

template <bool RET, bool SMP, int ABL = 0>
__device__ __forceinline__ void rec_core(LAS unsigned char* lds, const bf16* RB, const float* DV, const float* normw, const float* s_in, float* s_out, bf16* OHAT, bf16* dummy, int h, int first, int stride, int count) {
    constexpr int NT = SMP ? 1 : 4, NKS = SMP ? 1 : 2, NQK = SMP ? 1 : 4, NV = SMP ? 1 : 2;
    int tid = threadIdx.x; asm volatile("" : "+v"(tid));
    const int w = __builtin_amdgcn_readfirstlane(tid >> 6), l = tid & 63, g = l >> 4, c16 = l & 15;
    const int hp = (RET ? 4 : 0) + h;
    const float dconst = RET ? exp2f((SMP ? 8.0f : 64.0f) * log2f(1.0f - exp2f(-5.0f - (float)h))) : 1.0f;
    const f32x4 nw = *(const f32x4*)(normw + 16 * w + 4 * g);
    const unsigned q_ = c16 >> 2, p_l = c16 & 3, p1_ = p_l >> 1;
    unsigned KB[2][2], VB[2], QB[2];
#pragma unroll
    for (int t = 0; t < 2; ++t) {
#pragma unroll
        for (int ib = 0; ib < 2; ++ib) KB[t][ib] = 2048u * g + 64u * q_ + 8u * (p_l & 1) + 256u * t + 32u * (ib ^ (g & 1)) + 16u * (p1_ ^ t);
        VB[t] = 2048u * g + 64u * q_ + 8u * (p_l & 1) + 256u * t + 32u * ((w & 1) ^ (g & 1)) + 16u * (p1_ ^ t) + 512u * (w >> 1);
    }
    const unsigned RR = 2048u * (c16 >> 3) + 64u * (c16 & 7) + 16u * (g ^ ((c16 >> 2) & 3));
#pragma unroll
    for (int e = 0; e < 2; ++e) QB[e] = 2048u * (c16 >> 3) + 64u * (c16 & 7) + 16u * ((2 * e + (g >> 1)) ^ ((c16 >> 2) & 3)) + 8u * (g & 1);
    const unsigned WQ = 2048u * (tid >> 8) + 512u * ((tid & 15) >> 2) + 64u * ((tid >> 5) & 7) + 16u * ((tid & 3) ^ ((tid >> 7) & 3)) + 16384u * ((tid & 31) >> 4);
    const unsigned WV = 2048u * (tid >> 7) + 512u * ((tid & 15) >> 2) + 64u * ((tid >> 4) & 7) + 16u * ((tid & 3) ^ ((tid >> 6) & 3));
    const unsigned PW = RP_STRIDE * c16 + 8u * g, PR = RP_STRIDE * c16 + 16u * g;
#define REC_ROW0(c) (SMP ? MP + (((first) + (c) * (stride)) >> 2) * TS : (first) * TP + (c) * 64)
#define REC_HEAD(c) (SMP ? (((first) + (c) * (stride)) & 3) : h)
    v4u pq[NQK], pv[NV]; v2u pg[NT]; f32x4 pfd = {0.f, 0.f, 0.f, 0.f};
    const bool ldq = SMP ? tid < 256 : true, ldv = SMP ? tid < 128 : true;
    const unsigned qoff = ((unsigned)(SMP ? (tid >> 5) & 7 : tid >> 5) * INW + (tid & 31) * 8) * 2u, voff = ((unsigned)(SMP ? (tid >> 4) & 7 : tid >> 4) * INW + 256 + (tid & 15) * 8) * 2u;
    const unsigned goff = ((unsigned)(SMP ? (c16 & 7) : c16) * INW + 384 + 16 * w + 4 * g) * 2u, ooff = (unsigned)(2 * w + (g >> 1)) * 256u + (unsigned)c16 * 16u + (g & 1) * 8u;
#define REC_UB(c) ((const char*)RB + ((size_t)REC_ROW0(c) * INW + (RET ? 2048 : 0) + REC_HEAD(c) * 512) * 2)
#define REC_LOADQK(c) do { { const char* ub_ = REC_UB(c); \
        _Pragma("unroll") for (int i_ = 0; i_ < NQK; ++i_) pq[i_] = *(const v4u*)(ub_ + (size_t)i_ * (16 * INW * 2) + qoff); } \
        if (!RET) pfd = *(const f32x4*)(DV + (SMP ? (size_t)((first) + (c) * (stride)) : (size_t)(((first) * 32 + (c)) * 4 + h)) * 128 + (tid & 31) * 4); } while (0)
#define REC_STOREQK(c) do { if (ldq) { _Pragma("unroll") for (int i_ = 0; i_ < NQK; ++i_) *(LAS v4u*)(lds + RQK_OFF + ((c) % 3) * 32768 + WQ + 4096 * i_) = pq[i_]; } \
        if (!RET && tid < 32) *(LAS f32x4*)(lds + RDVEC_OFF + ((c) % 3) * 512 + tid * 16) = pfd; } while (0)
#define REC_LOADV(c) do { { const char* ub_ = REC_UB(c); \
        _Pragma("unroll") for (int i_ = 0; i_ < NV; ++i_) pv[i_] = *(const v4u*)(ub_ + (size_t)i_ * (32 * INW * 2) + voff); } } while (0)
#define REC_STOREV(c) do { if (ldv) { _Pragma("unroll") for (int i_ = 0; i_ < NV; ++i_) *(LAS v4u*)(lds + RV_OFF + ((c) & 1) * 16384 + WV + 8192 * i_) = pv[i_]; } } while (0)
#define REC_LOADG(c) do { const char* ub_ = REC_UB(c); \
        _Pragma("unroll") for (int ti_ = 0; ti_ < NT; ++ti_) pg[ti_] = *(const v2u*)(ub_ + (size_t)ti_ * (16 * INW * 2) + goff); } while (0)
#define REC_PTILE(slot, pb, ti, si) do { f32x4 a_ = {0.f, 0.f, 0.f, 0.f}; \
        _Pragma("unroll") for (int ks_ = 0; ks_ < 4; ++ks_) { const bf16x8 ak_ = *(const LAS bf16x8*)(lds + RQK_OFF + (slot) * 32768 + 16384 + RR + 4096 * (si) + 512 * ks_); \
            const bf16x8 bq_ = *(const LAS bf16x8*)(lds + RQK_OFF + (slot) * 32768 + RR + 4096 * (ti) + 512 * ks_); a_ = __builtin_amdgcn_mfma_f32_16x16x32_bf16(ak_, bq_, a_, 0, 0, 0); } \
        if ((si) == (ti)) { _Pragma("unroll") for (int r_ = 0; r_ < 4; ++r_) a_[r_] = (4 * g + r_ <= c16) ? a_[r_] : 0.f; } \
        v2u pw_; pw_.x = pg8::cvt_pk_bf16(a_[0], a_[1]); pw_.y = pg8::cvt_pk_bf16(a_[2], a_[3]); \
        *(LAS v2u*)(lds + RP_OFF + (pb) * RP_BYTES + PW + 2304 * (ti) + 32 * (si)) = pw_; } while (0)
#define REC_PHASE1(slot, pb) do { if (SMP) { if (w == 0) REC_PTILE(slot, pb, 0, 0); } else { switch (w) { case 0: REC_PTILE(slot, pb, 0, 0); REC_PTILE(slot, pb, 3, 2); break; case 1: REC_PTILE(slot, pb, 1, 0); REC_PTILE(slot, pb, 3, 3); break; \
        case 2: REC_PTILE(slot, pb, 1, 1); break; case 3: REC_PTILE(slot, pb, 2, 0); break; case 4: REC_PTILE(slot, pb, 2, 1); break; case 5: REC_PTILE(slot, pb, 2, 2); break; case 6: REC_PTILE(slot, pb, 3, 0); break; default: REC_PTILE(slot, pb, 3, 1); break; } } } while (0)
    f32x4 S[8], Sn[8];
    if (tid < 256) { const int t = tid >> 2, q4 = tid & 3; const int ti = t >> 4; if (ti == 0 || ti == 2) { *(LAS v2u*)(lds + RP_OFF + t * RP_STRIDE + (16 * (ti + 1) + 4 * q4) * 2) = (v2u){0u, 0u}; *(LAS v2u*)(lds + RP_OFF + RP_BYTES + t * RP_STRIDE + (16 * (ti + 1) + 4 * q4) * 2) = (v2u){0u, 0u}; } }
    if (SMP) { for (int q = tid; q < 8 * 24 * 16; q += 512) { const int slot = q / (24 * 16), rr = 8 + (q / 16) % 24, ch = q & 15;
            const int base = slot < 6 ? RQK_OFF + (slot >> 1) * 32768 + (slot & 1) * 16384 : RV_OFF + (slot - 6) * 16384; *(LAS v4u*)(lds + base + off_b(rr, ch)) = (v4u){0u, 0u, 0u, 0u}; } }
    if (!SMP) {
#pragma unroll
        for (int i = 0; i < 8; ++i) S[i] = (f32x4){0.f, 0.f, 0.f, 0.f};
    }
#define REC_LOADS(dst, c) do { const float* p_ = s_in + (size_t)((first) + (c) * (stride)) * HD * HD + (size_t)(4 * g) * HD + 16 * w + c16; \
        _Pragma("unroll") for (int i_ = 0; i_ < 8; ++i_) { _Pragma("unroll") for (int r_ = 0; r_ < 4; ++r_) dst[i_][r_] = p_[(16 * i_ + r_) * HD]; } } while (0)
    const int last = count - 1; const bool never = count > (1 << 20);
#define ABL_ON(bit) (!(ABL & (bit)) || never)
    REC_LOADQK(0); REC_LOADV(0); REC_STOREQK(0); REC_STOREV(0);
    { const int c1 = last < 1 ? last : 1; REC_LOADQK(c1); REC_STOREQK(1); }
    if (SMP) REC_LOADS(S, 0);
    RBAR();
    REC_PHASE1(0, 0);
    RBAR();
#pragma clang loop unroll(disable)
    for (int c = 0; c < count; ++c) {
        const int c1 = c + 1 < count ? c + 1 : last, c2 = c + 2 < count ? c + 2 : last;
        if (ABL_ON(4)) { REC_LOADQK(c2); REC_LOADV(c1); REC_LOADG(c); }
        if (SMP) REC_LOADS(Sn, c1);
        LAS unsigned char* qb = lds + RQK_OFF + (c % 3) * 32768; LAS unsigned char* vb = lds + RV_OFF + (c & 1) * 16384; LAS unsigned char* pb = lds + RP_OFF + (c & 1) * RP_BYTES;
        const float dcur = (RET && SMP) ? exp2f(8.0f * log2f(1.0f - exp2f(-5.0f - (float)REC_HEAD(c)))) : dconst;
        bf16x8 bv[NKS];
#pragma unroll
        for (int ks = 0; ks < NKS; ++ks) bv[ks] = cat8(lds_tr(vb + VB[0] + 8192 * ks), lds_tr(vb + VB[1] + 8192 * ks));
        f32x4 O[NT];
#pragma unroll
        for (int ti = 0; ti < NT; ++ti) O[ti] = (f32x4){0.f, 0.f, 0.f, 0.f};
        if (ABL_ON(16))
#pragma unroll
        for (int k4 = 0; k4 < 4; ++k4) {
            const bf16x8 as = pack8(S[2 * k4], S[2 * k4 + 1]);
#pragma unroll
            for (int ti = 0; ti < NT; ++ti) {
                const s16x4 lo = *(const LAS s16x4*)(qb + QB[0] + 4096 * ti + 512 * k4), hi = *(const LAS s16x4*)(qb + QB[1] + 4096 * ti + 512 * k4);
                O[ti] = __builtin_amdgcn_mfma_f32_16x16x32_bf16(as, cat8(lo, hi), O[ti], 0, 0, 0); }
        }
#pragma unroll
        for (int ti = 0; ti < NT; ++ti)
#pragma unroll
            for (int ks = 0; ks < NKS; ++ks) if (ks <= (ti >> 1)) {
                const bf16x8 bp = *(const LAS bf16x8*)(pb + PR + 2304 * ti + 64 * ks);
                O[ti] = __builtin_amdgcn_mfma_f32_16x16x32_bf16(bv[ks], bp, O[ti], 0, 0, 0); }
        if (ABL_ON(8))
#pragma unroll
        for (int i = 0; i < 8; ++i) {
#pragma unroll
            for (int ks = 0; ks < NKS; ++ks) { const bf16x8 ak = cat8(lds_tr(qb + 16384 + KB[0][i & 1] + 8192 * ks + 512 * (i >> 1)), lds_tr(qb + 16384 + KB[1][i & 1] + 8192 * ks + 512 * (i >> 1)));
                S[i] = __builtin_amdgcn_mfma_f32_16x16x32_bf16(ak, bv[ks], S[i], 0, 0, 0); }
            if (RET) S[i] = S[i] * dcur; else S[i] = S[i] * *(const LAS f32x4*)(lds + RDVEC_OFF + (c % 3) * 512 + (16 * i + 4 * g) * 4);
            if (i & 1) __builtin_amdgcn_sched_barrier(0);
        }
        if (SMP) {
            float* p_ = s_out + (size_t)(first + c * stride) * HD * HD + (size_t)(4 * g) * HD + 16 * w + c16;
#pragma unroll
            for (int i = 0; i < 8; ++i) {
#pragma unroll
                for (int r = 0; r < 4; ++r) p_[(16 * i + r) * HD] = S[i][r]; }
#pragma unroll
            for (int i = 0; i < 8; ++i) S[i] = Sn[i];
        }
        { LAS float* st = (LAS float*)(lds + RSTAT_OFF + (c & 1) * RSTAT_BYTES);
#pragma unroll
          for (int ti = 0; ti < NT; ++ti) { const f32x4 o = O[ti]; float s2 = (o[0] * o[0] + o[1] * o[1]) + (o[2] * o[2] + o[3] * o[3]), s1 = (o[0] + o[1]) + (o[2] + o[3]);
              s2 += __shfl_xor(s2, 16); s2 += __shfl_xor(s2, 32); if (RET) { s1 += __shfl_xor(s1, 16); s1 += __shfl_xor(s1, 32); }
              if (g == 0 && ABL_ON(1)) { st[512 + (16 * ti + c16) * 8 + w] = s2; if (RET) st[(16 * ti + c16) * 8 + w] = s1; } } }
        if (ABL_ON(32)) REC_PHASE1((c + 1) % 3, (c + 1) & 1);
        REC_STOREQK(c + 2);
        REC_STOREV(c + 1);
        RBAR();
        { LAS float* st = (LAS float*)(lds + RSTAT_OFF + (c & 1) * RSTAT_BYTES);
          const int row0_ = REC_ROW0(c);
          char* ob = (char*)OHAT + ((size_t)(row0_ >> 4) * 128 + (RET ? 64 : 0) + REC_HEAD(c) * 16) * 256 + (SMP ? (row0_ & 8) * 16 : 0);
          if (SMP && c16 >= 8) ob = (char*)dummy;
#pragma unroll
          for (int ti = 0; ti < NT; ++ti) {
              const f32x4 a2 = *(const LAS f32x4*)(st + 512 + (16 * ti + c16) * 8), b2 = *(const LAS f32x4*)(st + 512 + (16 * ti + c16) * 8 + 4);
              const float m2 = ((a2[0] + a2[1]) + (a2[2] + a2[3])) + ((b2[0] + b2[1]) + (b2[2] + b2[3])); float mu = 0.f, rs;
              if (RET) { const f32x4 a1 = *(const LAS f32x4*)(st + (16 * ti + c16) * 8), b1 = *(const LAS f32x4*)(st + (16 * ti + c16) * 8 + 4);
                  mu = (((a1[0] + a1[1]) + (a1[2] + a1[3])) + ((b1[0] + b1[1]) + (b1[2] + b1[3]))) * (1.0f / HD); rs = __builtin_amdgcn_rsqf(fmaxf(m2 * (1.0f / HD) - mu * mu, 0.f) + 1e-6f); }
              else rs = __builtin_amdgcn_rsqf(m2 * (1.0f / HD) + 1e-6f);
              const f32x4 o = (O[ti] - mu) * rs * nw;
              v2u ow; ow.x = pg8::cvt_pk_bf16(o[0] * bflo(pg[ti].x), o[1] * bfhi(pg[ti].x)); ow.y = pg8::cvt_pk_bf16(o[2] * bflo(pg[ti].y), o[3] * bfhi(pg[ti].y));
              if (ABL_ON(2)) *(v2u*)(ob + (size_t)ti * (128 * 256) + ooff) = ow; } }
    }
    if (!SMP) {
#pragma unroll
        for (int i = 0; i < 8; ++i)
#pragma unroll
            for (int r = 0; r < 4; ++r) s_out[(size_t)(16 * i + 4 * g + r) * HD + 16 * w + c16] = S[i][r];
    }
    RBAR();
#undef ABL_ON
#undef REC_ROW0
#undef REC_UB
#undef REC_HEAD
#undef REC_LOADQK
#undef REC_STOREQK
#undef REC_LOADV
#undef REC_STOREV
#undef REC_LOADG
#undef REC_LOADS
#undef REC_PTILE
#undef REC_PHASE1
}

__device__ __forceinline__ void sub_barrier(gu32* word, unsigned want) {
    VM_WAIT(); __syncthreads();
    if (threadIdx.x == 0) {
        __builtin_amdgcn_fence(__ATOMIC_RELEASE, "agent"); asm volatile("s_waitcnt vmcnt(0)" ::: "memory");
        __hip_atomic_fetch_add(word, 1u, RLX_AGENT);
        unsigned sp = 0; while (__hip_atomic_load(word, RLX_AGENT) < want) { __builtin_amdgcn_s_sleep(2); if (++sp > (1u << 22)) break; }
        __builtin_amdgcn_fence(__ATOMIC_ACQUIRE, "agent"); asm volatile("s_waitcnt vmcnt(0)" ::: "memory");
    }
    __syncthreads();
}
__device__ __forceinline__ void* ldptr(const volatile LAS unsigned long long* pt, int i) { const unsigned long long v = pt[i]; return (void*)(((unsigned long long)(unsigned)__builtin_amdgcn_readfirstlane((int)(v >> 32)) << 32) | (unsigned)__builtin_amdgcn_readfirstlane((int)v)); }
struct Args { const float* in[17]; float* out; unsigned char* wsb; };
__global__ void __launch_bounds__(NWAVES * 64, 2) hyb_fwd(Args args) {
    extern __shared__ __attribute__((aligned(16))) unsigned char lds_raw[];
    LAS unsigned char* lds = (LAS unsigned char*)lds_raw;
    volatile LAS unsigned* MISC = (volatile LAS unsigned*)(lds + MISC_OFF);
    const int tid = threadIdx.x, lane = tid & 63, wave = __builtin_amdgcn_readfirstlane(tid >> 6);
    const int G = gridDim.x; const int bx = blockIdx.x; const int vcu = (G % 8 == 0) ? (bx % 8) * (G / 8) + bx / 8 : bx;
#define ws ((unsigned char*)ldptr(PT, 18))
#define ctl ((gu32*)(ws + WS_CTL))
#define x_prompt ((const float*)ldptr(PT, 0))
#define x_sample ((const float*)ldptr(PT, 1))
#define state_hgrn ((const float*)ldptr(PT, 2))
#define state_ret ((const float*)ldptr(PT, 3))
#define state_conv ((const float*)ldptr(PT, 4))
#define w_norm1 ((const float*)ldptr(PT, 5))
#define w_in ((const float*)ldptr(PT, 6))
#define hgrn_lb ((const float*)ldptr(PT, 7))
#define hgrn_norm_w ((const float*)ldptr(PT, 8))
#define ret_norm_w ((const float*)ldptr(PT, 9))
#define w_out ((const float*)ldptr(PT, 10))
#define w_norm2 ((const float*)ldptr(PT, 11))
#define w_ffn_in ((const float*)ldptr(PT, 12))
#define conv_w ((const float*)ldptr(PT, 13))
#define conv_b ((const float*)ldptr(PT, 14))
#define w_ffn_out ((const float*)ldptr(PT, 15))
#define w_norm_f ((const float*)ldptr(PT, 16))
#define out_y ((float*)ldptr(PT, 17))
#define out_hgp (out_y + (size_t)M * D)
#define out_rtp (out_hgp + (size_t)NBP * NH * HD * HD)
#define out_cvp (out_rtp + (size_t)NBP * NH * HD * HD)
#define out_hgs (out_cvp + (size_t)NBP * 2 * UPW)
#define out_rts (out_hgs + (size_t)NBS * NH * HD * HD)
#define out_cvs (out_rts + (size_t)NBS * NH * HD * HD)
#define WIN ((bf16*)(ws + WS_WIN))
#define WOUT ((bf16*)(ws + WS_WOUT))
#define WUP ((bf16*)(ws + WS_WUP))
#define WDN ((bf16*)(ws + WS_WDN))
#define ROPE ((float2*)(ws + WS_ROPE))
#define LBT ((float*)(ws + WS_LB))
#define DVP ((float*)(ws + WS_DVP))
#define DVS ((float*)(ws + WS_DVS))
#define SS1 ((float*)(ws + WS_SS1))
#define SS2 ((float*)(ws + WS_SS2))
#define XB ((bf16*)(ws + WS_XB))
#define PROJ ((bf16*)(ws + WS_PROJ))
#define OHAT ((bf16*)(ws + WS_OHAT))
#define RAW ((float*)(ws + WS_RAW))
#define ACT ((bf16*)(ws + WS_ACT))
#define SLAB ((float*)(ws + WS_SLAB))
#define SLAB2 ((float*)(ws + 240 * MiB))
    for (int u = tid; u < (LDS_BYTES - LDSCTL_OFF) / 4; u += NWAVES * 64) ((LAS unsigned*)(lds + LDSCTL_OFF))[u] = 0u;
    __syncthreads();
    volatile LAS unsigned long long* PT = (volatile LAS unsigned long long*)(lds + LDSCTL_OFF);
    if (tid == 0) {
#pragma unroll
        for (int i = 0; i < 17; ++i) PT[i] = (unsigned long long)args.in[i];
        PT[17] = (unsigned long long)args.out; PT[18] = (unsigned long long)args.wsb;
    }
    __syncthreads();
    XcdBarrier bar = xcd_barrier_post((unsigned*)(ctl + CW_BAR), MISC + 8);
    const int gw = vcu * NWAVES + wave, NGW = G * NWAVES;
    unsigned long long t_s0 = 0, t_s1 = 0;

#if PH_MASK & 1
    STAMP0(0);
    _Pragma("unroll") for (int rep_ = 0; rep_ < REPS(0); ++rep_) {
    {
        LAS float* scr = (LAS float*)(lds + RING_OFF + wave * 16384);
        constexpr int I_IN = (D / 64) * (INW / 32);
        {
            f32x4 va[8], vb[8]; int it = gw;
            auto mk = [&](int r) { TrItem t; t.W = w_in; t.kscale = w_norm1; t.WT = WIN; t.K = D; t.N = INW; t.k0 = 64 * (r / (INW / 32)); t.n0 = 32 * (r % (INW / 32)); t.mode = 2; return t; };
            if (it < I_IN) { TrItem cur = mk(it); tr_load(cur, lane, va);
                for (;;) { const int nx = it + NGW; const bool more = nx < I_IN; TrItem nxt = mk(more ? nx : it); tr_load(nxt, lane, vb); tr_finish(cur, lane, va, scr); if (!more) break;
                           it = nx; cur = nxt; const int n2 = it + NGW; const bool more2 = n2 < I_IN; TrItem nn = mk(more2 ? n2 : it); tr_load(nn, lane, va); tr_finish(cur, lane, vb, scr); if (!more2) break; it = n2; cur = nn; } }
        }
        for (int m = gw; m < M; m += 4 * NGW) {
            const float* src[4]; int mm[4];
#pragma unroll
            for (int q = 0; q < 4; ++q) { mm[q] = m + q * NGW < M ? m + q * NGW : m; src[q] = mm[q] < MP ? x_prompt + (size_t)mm[q] * D : x_sample + (size_t)(mm[q] - MP) * D; }
            f32x4 v[4][4];
#pragma unroll
            for (int q = 0; q < 4; ++q)
#pragma unroll
                for (int j = 0; j < 4; ++j) v[q][j] = ((const GAS f32x4*)src[q] + lane)[64 * j];
#pragma unroll
            for (int q = 0; q < 4; ++q) { float sq = 0.f;
#pragma unroll
                for (int j = 0; j < 4; ++j) sq += (v[q][j].x * v[q][j].x + v[q][j].y * v[q][j].y) + (v[q][j].z * v[q][j].z + v[q][j].w * v[q][j].w);
                sq = wave_sum(sq); if (lane == 0) SS1[mm[q]] = sq;
                GAS unsigned long long* o8 = (GAS unsigned long long*)(XB + (size_t)mm[q] * D) + lane;
#pragma unroll
                for (int j = 0; j < 4; ++j) o8[64 * j] = (unsigned long long)pk2(v[q][j].x, v[q][j].y) | ((unsigned long long)pk2(v[q][j].z, v[q][j].w) << 32); }
        }
        if (bx == 0) { const float a0 = hgrn_lb[tid], a1 = hgrn_lb[512 + tid]; const float mx = fmaxf(a0, a1), e0 = expf(a0 - mx), e1 = expf(a1 - mx); LBT[tid] = e0 / (e0 + e1); }
        for (int i = vcu * 512 + tid; i < 2056 * 64; i += G * 512) {
            const int p = i >> 6, j = i & 63; const int pos = p < 2048 ? p : PAST + (p - 2048);
            const double inv = exp2(-(double)j * (13.287712379549449 / 64.0));
            float c, s; sincos_acc((double)pos * inv, c, s); ROPE[i] = make_float2(c, s);
        }
    }
    xcd_barrier(bar);

    }
#endif
#if PH_MASK & 2
    STAMP1(0);
    STAMP0(1);
    _Pragma("unroll") for (int rep_ = 0; rep_ < REPS(1); ++rep_) {
    {
        pg8::Gemm g{XB, WIN, MP, INW, D, D}; pg8::StaticOrder S; S.init(MP, INW, G, bx);
        pg8::EpiPrep E{PROJ, SS1, LBT, (const float*)ROPE, DVP, DVS};
        pg8::gemm_phase<pg8::EpiPrep, pg8::StaticOrder, true, true>(lds + RING_OFF, g, S, E);
    }
    xcd_barrier(bar);

    }
#endif
#if PH_MASK & 4
    STAMP1(1);
    STAMP0(2);
    _Pragma("unroll") for (int rep_ = 0; rep_ < REPS(2); ++rep_) {
    {
        if (bx < 64) { if (rep_ == 0) {
            const int b = (bx >> 2) & 7, h = bx & 3;
            STAMP0(7);
            if (bx < 32) rec_core<false, false>(lds, PROJ, DVP, hgrn_norm_w, nullptr, out_hgp + (size_t)(b * 4 + h) * HD * HD, OHAT, (bf16*)(ws + 239 * MiB + 512 * KiB), h, b, 0, 32);
            else rec_core<true, false>(lds, PROJ, DVP, ret_norm_w, nullptr, out_rtp + (size_t)(b * 4 + h) * HD * HD, OHAT, (bf16*)(ws + 239 * MiB + 512 * KiB), h, b, 0, 32);
            STAMP1(7);
        } else if (REP_SEL & 1) {
            const int b = (bx >> 2) & 7, h = bx & 3; float* sdum = (float*)(ws + 236 * MiB) + (size_t)bx * HD * HD;
            if (bx < 32) rec_core<false, false, REP_ABL>(lds, PROJ, DVP, hgrn_norm_w, nullptr, sdum, XB, (bf16*)SS1, h, b, 0, 32);
            else rec_core<true, false, REP_ABL>(lds, PROJ, DVP, ret_norm_w, nullptr, sdum, XB, (bf16*)SS1, h, b, 0, 32);
        } } else if (rep_ == 0) {
            const int idx = bx - 64, nw_ = G - 64;
            STAMP0(8); STAMP0(9);
            if (idx >= 64) {
                LAS float* scr = (LAS float*)(lds + RING_OFF + wave * 16384);
                constexpr int I_OUT = (D / 64) * (D / 32), I_UP = (D / 64) * (UPW / 32), I_DN = (DFF / 64) * (D / 32), I_ALL = I_OUT + I_UP + I_DN;
                const int step = (nw_ - 64) * NWAVES;
                auto mk = [&](int r) { TrItem t;
                    if (r < I_OUT) { t.W = w_out; t.kscale = nullptr; t.WT = WOUT; t.K = D; t.N = D; t.mode = 0; }
                    else if (r < I_OUT + I_UP) { r -= I_OUT; t.W = w_ffn_in; t.kscale = w_norm2; t.WT = WUP; t.K = D; t.N = UPW; t.mode = 1; }
                    else { r -= I_OUT + I_UP; t.W = w_ffn_out; t.kscale = nullptr; t.WT = WDN; t.K = DFF; t.N = D; t.mode = 0; }
                    const int nblk = t.N / 32; t.k0 = 64 * (r / nblk); t.n0 = 32 * (r % nblk); return t; };
                f32x4 va[8], vb[8]; int it = (idx - 64) * NWAVES + wave;
                if (it < I_ALL) { TrItem cur = mk(it); tr_load(cur, lane, va);
                    for (;;) { const int nx = it + step; const bool more = nx < I_ALL; TrItem nxt = mk(more ? nx : it); tr_load(nxt, lane, vb); tr_finish(cur, lane, va, scr); if (!more) break;
                               it = nx; cur = nxt; const int n2 = it + step; const bool more2 = n2 < I_ALL; TrItem nn = mk(more2 ? n2 : it); tr_load(nn, lane, va); tr_finish(cur, lane, vb, scr); if (!more2) break; it = n2; cur = nn; } }
                __syncthreads();
            } else {
                pg8::Gemm g{XB, WIN, M, INW, D, D}; pg8::SplitKOrder S{64, 4, 16, 1, 64, idx};
                pg8::EpiPrep E{PROJ, SS1, LBT, (const float*)ROPE, DVP, DVS};
                pg8::gemm_phase<pg8::EpiPrep, pg8::SplitKOrder, true, true>(lds + RING_OFF, g, S, E);
            }
            STAMP1(9); STAMP0(10);
            sub_barrier(ctl + CW_SUB, (unsigned)nw_);
            STAMP0(13);
            {
                const int cnt = idx < 512 ? (512 - idx + nw_ - 1) / nw_ : 0;
                if (cnt > 0) { rec_core<false, true>(lds, PROJ, DVS, hgrn_norm_w, state_hgrn, out_hgs, OHAT, (bf16*)(ws + 239 * MiB + 512 * KiB), 0, idx, nw_, cnt);
                               rec_core<true, true>(lds, PROJ, DVS, ret_norm_w, state_ret, out_rts, OHAT, (bf16*)(ws + 239 * MiB + 512 * KiB), 0, idx, nw_, cnt); }
            }
            STAMP1(10); STAMP1(13); STAMP0(11);
            sub_barrier(ctl + CW_SUB, 2u * (unsigned)nw_);
            {
                pg8::Gemm g{OHAT, WOUT, M, D, 256, D}; pg8::SplitKOrder S{64, 4, 4, 4, nw_, idx};
                pg8::EpiSlab E{SLAB2, 64, D, (size_t)MS * D};
                pg8::gemm_phase<pg8::EpiSlab, pg8::SplitKOrder, true, true, true>(lds + RING_OFF, g, S, E);
            }
            STAMP1(11); STAMP0(12);
            sub_barrier(ctl + CW_SUB, 3u * (unsigned)nw_);
            for (int m = idx * NWAVES + wave; m < MS; m += nw_ * NWAVES) {
                const GAS f32x4* xr = (const GAS f32x4*)(x_sample + (size_t)m * D) + lane;
                f32x4 v[4]; float sq = 0.f;
#pragma unroll
                for (int j = 0; j < 4; ++j) v[j] = xr[64 * j];
#pragma unroll
                for (int ks = 0; ks < 4; ++ks) { const GAS f32x4* sl = (const GAS f32x4*)(SLAB2 + (size_t)ks * MS * D + (size_t)m * D) + lane;
#pragma unroll
                    for (int j = 0; j < 4; ++j) v[j] += sl[64 * j]; }
                GAS f32x4* orow = (GAS f32x4*)(out_y + (size_t)(MP + m) * D) + lane; GAS unsigned long long* o8 = (GAS unsigned long long*)(XB + (size_t)(MP + m) * D) + lane;
#pragma unroll
                for (int j = 0; j < 4; ++j) { orow[64 * j] = v[j]; sq += (v[j].x * v[j].x + v[j].y * v[j].y) + (v[j].z * v[j].z + v[j].w * v[j].w);
                    o8[64 * j] = (unsigned long long)pk2(v[j].x, v[j].y) | ((unsigned long long)pk2(v[j].z, v[j].w) << 32); }
                sq = wave_sum(sq); if (lane == 0) SS2[MP + m] = sq;
            }
            STAMP1(8); STAMP1(12);
        }
    }
    xcd_barrier(bar);

    }
#endif
#if PH_MASK & 8
    STAMP1(2);
    STAMP0(3);
    {
        pg8::Gemm g{OHAT, WOUT, MP, D, D, D}; pg8::StaticOrder S; S.init(MP, D, G, bx);
        pg8::EpiResF32 E{x_prompt, x_sample, out_y, XB, SS2};
        pg8::gemm_phase<pg8::EpiResF32, pg8::StaticOrder, true, true, true>(lds + RING_OFF, g, S, E);
    }
    xcd_barrier(bar);
#if REP_MASK & 8
    {
        pg8::Gemm g{OHAT, WOUT, M, D, D, D}; pg8::StaticOrder S; S.init(M, D, G, bx);
        pg8::EpiResF32 E{x_prompt, x_sample, (float*)(ws + WS_PROJ), nullptr, nullptr};
        pg8::gemm_phase<pg8::EpiResF32, pg8::StaticOrder, true, true, true>(lds + RING_OFF, g, S, E);
    }
    xcd_barrier(bar);
#endif

#endif
#if PH_MASK & 16
    STAMP1(3);
    STAMP0(4);
    _Pragma("unroll") for (int rep_ = 0; rep_ < REPS(4); ++rep_) {
    {
        pg8::Gemm g{XB, WUP, M, UPW, D, D}; pg8::StaticOrder S; S.init(M, UPW, G, bx);
        pg8::EpiConvAct E{ACT, SS2, conv_w, conv_b, state_conv, RAW, out_cvp, out_cvs};
        pg8::gemm_phase<pg8::EpiConvAct, pg8::StaticOrder, true, true>(lds + RING_OFF, g, S, E);
    }
    xcd_barrier(bar);
    }

#endif
#if PH_MASK & 32
    STAMP1(4);
    STAMP0(5);
    {
        pg8::Gemm g{ACT, WDN, MP, D, DFF, DFF}; pg8::StaticOrder S; S.init(MP, D, G, bx);
        {
            pg8::Unit u0; const bool has = S.next(0, u0);
            if (has && u0.pm < 64) {
                for (int it = tid; it < 8 * 704; it += NWAVES * 64) {
                    const int cgp = it % 704, kj = it / 704, k = kj >> 1, j = kj & 1, blk = u0.pm * 4 + k;
                    const int tile = cgp >> 5, c4 = (cgp & 31) * 4, pcol = tile * 256 + c4, ch = tile * 128 + c4;
                    const bool first = (blk & 31) == 0;
                    const float* cur = RAW + (size_t)(blk * 4 + j) * UPW + pcol;
                    const float* p1 = first ? cur : (j == 0 ? RAW + (size_t)((blk - 1) * 4 + 3) * UPW + pcol : RAW + (size_t)(blk * 4) * UPW + pcol);
                    const float* p2 = first ? cur : (j == 0 ? RAW + (size_t)((blk - 1) * 4 + 2) * UPW + pcol : RAW + (size_t)((blk - 1) * 4 + 3) * UPW + pcol);
                    if (first && j == 1) p1 = RAW + (size_t)(blk * 4) * UPW + pcol;
                    const float z1 = (first && j == 0) ? 0.f : 1.f, z2 = first ? 0.f : 1.f;
                    const f32x4 cu_ = *(const f32x4*)cur, cg_ = *(const f32x4*)(cur + 128), u1 = *(const f32x4*)p1 * z1, g1 = *(const f32x4*)(p1 + 128) * z1, u2 = *(const f32x4*)p2 * z2, g2 = *(const f32x4*)(p2 + 128) * z2;
                    const f32x4 cu = *(const f32x4*)(conv_b + ch) + *(const f32x4*)(conv_w + ch) * u2 + *(const f32x4*)(conv_w + UPW + ch) * u1 + *(const f32x4*)(conv_w + 2 * UPW + ch) * cu_;
                    const f32x4 cg = *(const f32x4*)(conv_b + DFF + ch) + *(const f32x4*)(conv_w + DFF + ch) * g2 + *(const f32x4*)(conv_w + UPW + DFF + ch) * g1 + *(const f32x4*)(conv_w + 2 * UPW + DFF + ch) * cg_;
                    v2u ow; ow.x = pk2(silu_f(cg[0]) * cu[0], silu_f(cg[1]) * cu[1]); ow.y = pk2(silu_f(cg[2]) * cu[2], silu_f(cg[3]) * cu[3]);
                    *(v2u*)(ACT + (size_t)(blk * 64 + j) * DFF + ch) = ow;
                }
            }
            VM_WAIT(); __syncthreads();
        }
        pg8::EpiResF32 E{out_y, out_y + (size_t)MP * D, out_y, nullptr, nullptr};
        pg8::gemm_phase<pg8::EpiResF32, pg8::StaticOrder, true, true>(lds + RING_OFF, g, S, E);
    }
    {
        pg8::Gemm g{ACT, WDN, M, D, 256, DFF}; pg8::SplitKOrder S{64, 4, 4, 11, G, bx};
        pg8::EpiSlab E{SLAB, 64, D, (size_t)MS * D};
        pg8::gemm_phase<pg8::EpiSlab, pg8::SplitKOrder, true, true>(lds + RING_OFF, g, S, E);
    }
    xcd_barrier(bar);
#if REP_MASK & 32
    {
        pg8::Gemm g{ACT, WDN, MP, D, DFF, DFF}; pg8::StaticOrder S; S.init(MP, D, G, bx);
        pg8::EpiResF32 E{out_y, out_y + (size_t)MP * D, (float*)(ws + WS_XB), nullptr, nullptr};
        pg8::gemm_phase<pg8::EpiResF32, pg8::StaticOrder, true, true>(lds + RING_OFF, g, S, E);
    }
    xcd_barrier(bar);
#endif
#if REP_MASK & 64
    {
        pg8::Gemm g{ACT, WDN, M, D, 256, DFF}; pg8::SplitKOrder S{64, 4, 4, 11, G, bx};
        pg8::EpiSlab E{SLAB, 64, D, (size_t)MS * D};
        pg8::gemm_phase<pg8::EpiSlab, pg8::SplitKOrder, true, true>(lds + RING_OFF, g, S, E);
    }
    xcd_barrier(bar);
#endif

#endif
#if PH_MASK & 64
    STAMP1(5);
    STAMP0(6);
    for (int m = gw; m < M; m += NGW) {
        GAS f32x4* xr = (GAS f32x4*)(out_y + (size_t)m * D) + lane; const GAS f32x4* wf = (const GAS f32x4*)w_norm_f + lane;
        f32x4 v[4]; float s = 0.f;
#pragma unroll
        for (int j = 0; j < 4; ++j) v[j] = xr[64 * j];
        if (m >= MP) {
#pragma unroll
            for (int ks = 0; ks < 11; ++ks) { const GAS f32x4* sl = (const GAS f32x4*)(SLAB + (size_t)ks * MS * D + (size_t)(m - MP) * D) + lane;
#pragma unroll
                for (int j = 0; j < 4; ++j) v[j] += sl[64 * j]; } }
#pragma unroll
        for (int j = 0; j < 4; ++j) s += (v[j].x * v[j].x + v[j].y * v[j].y) + (v[j].z * v[j].z + v[j].w * v[j].w);
        const float r = 1.0f / sqrtf(wave_sum(s) * (1.0f / D) + 1e-6f);
#pragma unroll
        for (int j = 0; j < 4; ++j) xr[64 * j] = v[j] * r * wf[64 * j];
    }
#endif
    STAMP1(6);
    if (STAMP_PHASE >= 0 && bx == (STAMP_PHASE >= 8 ? 64 : 0) && threadIdx.x == 0) { const unsigned long long te = __builtin_amdgcn_s_memrealtime(), dt = (t_s1 - t_s0) * 4; while (__builtin_amdgcn_s_memrealtime() - te < dt) __builtin_amdgcn_s_sleep(8); }
}

#undef x_prompt
#undef x_sample
#undef state_hgrn
#undef state_ret
#undef state_conv
#undef w_norm1
#undef w_in
#undef hgrn_lb
#undef hgrn_norm_w
#undef ret_norm_w
#undef w_out
#undef w_norm2
#undef w_ffn_in
#undef conv_w
#undef conv_b
#undef w_ffn_out
#undef w_norm_f
#undef out_y
#undef out_hgp
#undef out_rtp
#undef out_cvp
#undef out_hgs
#undef out_rts
#undef out_cvs
#undef WIN
#undef WOUT
#undef WUP
#undef WDN
#undef ROPE
#undef LBT
#undef DVP
#undef DVS
#undef SS1
#undef SS2
#undef XB
#undef PROJ
#undef OHAT
#undef RAW
#undef ACT
#undef SLAB
#undef SLAB2
#undef ws
#undef ctl
extern "C" void kernel_launch(void* const* d_in, const int* in_sizes, int n_in, void* d_out, int out_size, void* d_ws, size_t ws_size, hipStream_t stream) {
    static int grid = 0;
    if (grid == 0) {
        if (n_in != 17 || ws_size < WS_END) { fprintf(stderr, "kernel_launch: unexpected inputs (n_in %d, ws %zu); nothing launched\n", n_in, ws_size); grid = -1; return; }
        int dev = 0, cus = 0, per_cu = 0;
        if (hipGetDevice(&dev) != hipSuccess || hipDeviceGetAttribute(&cus, hipDeviceAttributeMultiprocessorCount, dev) != hipSuccess) { grid = -1; return; }
        if (hipFuncSetAttribute((const void*)hyb_fwd, hipFuncAttributeMaxDynamicSharedMemorySize, LDS_BYTES) != hipSuccess) { fprintf(stderr, "kernel_launch: hipFuncSetAttribute failed\n"); grid = -1; return; }
        if (hipOccupancyMaxActiveBlocksPerMultiprocessor(&per_cu, (const void*)hyb_fwd, NWAVES * 64, LDS_BYTES) != hipSuccess || per_cu < 1)
            fprintf(stderr, "kernel_launch: note: occupancy query reports %d workgroups per CU\n", per_cu);
        (void)hipGetLastError();
        grid = cus;
    }
    if (grid < 0) return;
    if (hipMemsetAsync((char*)d_ws + WS_CTL, 0, CTL_ZERO_BYTES, stream) != hipSuccess) return;
    Args a{};
    for (int i = 0; i < 17; ++i) a.in[i] = (const float*)d_in[i];
    a.out = (float*)d_out; a.wsb = (unsigned char*)d_ws;
    hipLaunchKernelGGL(hyb_fwd, dim3(grid), dim3(NWAVES * 64), LDS_BYTES, stream, a);
}
```
